# Optimizing an MI355X kernel written in HIP

```python
import jax
import jax.numpy as jnp
from jax import lax
import numpy as np

D_MODEL = 1024
BATCH = 8
SEQ = 2048
DEPTH = 4

N_MEM = 256
EPS = 1e-6
CHUNK = 64
CONV_W = 4
GLA_HEADS = 4
GLA_DK = 64
GLA_DV = 128
GLA_KEY = GLA_HEADS * GLA_DK
GLA_VAL = GLA_HEADS * GLA_DV
GLA_GATE_RANK = 16
GLA_GATE_NORM = 16.0
LRU_WIDTH = D_MODEL // 2
LRU_BLOCKS = 4
LRU_BLOCK = LRU_WIDTH // LRU_BLOCKS
LRU_C = 8.0
AB_IN = 2 * GLA_KEY + 2 * GLA_VAL + GLA_GATE_RANK + 2 * LRU_WIDTH
AB_MIX = GLA_VAL + LRU_WIDTH
GDN_HEADS = 8
GDN_DK = 128
GDN_DV = 128
GDN_KEY = GDN_HEADS * GDN_DK
GDN_VAL = GDN_HEADS * GDN_DV
GDN_CONV_CH = 2 * GDN_KEY + GDN_VAL
GDN_IN = GDN_CONV_CH + GDN_VAL + 2 * GDN_HEADS
XA_HEADS = 4
XA_DH = D_MODEL // XA_HEADS
D_FF = 4 * D_MODEL
N_EVEN = (DEPTH + 1) // 2
N_ODD = DEPTH // 2

kernel_name = "hybrid_gla_rglru_gdn_memxattn_block"

F32 = jnp.float32


def rms_norm(x, g):
    xf = x.astype(F32)
    y = xf * lax.rsqrt(jnp.mean(xf * xf, axis=-1, keepdims=True) + EPS)
    return (y * g.astype(F32)).astype(x.dtype)


def l2_norm(x):
    xf = x.astype(F32)
    return xf * lax.rsqrt(jnp.sum(xf * xf, axis=-1, keepdims=True) + EPS)


def causal_dwconv(x, w, b=None):
    K = w.shape[0]
    T = x.shape[1]
    xp = jnp.pad(x, ((0, 0), (K - 1, 0), (0, 0)))
    y = xp[:, 0:T] * w[0]
    for kk in range(1, K):
        y = y + xp[:, kk:kk + T] * w[kk]
    if b is not None:
        y = y + b
    return y


def gla_chunked(q, k, v, gk):
    B, T, H, dk = q.shape
    dv = v.shape[-1]
    N = T // CHUNK

    def to_chunks(t):
        return t.astype(F32).reshape(B, N, CHUNK, H, t.shape[-1]).transpose(1, 0, 3, 2, 4)

    qc_all = to_chunks(q) * (dk ** -0.5)
    kc_all = to_chunks(k)
    vc_all = to_chunks(v)
    bc_all = jnp.cumsum(to_chunks(gk), axis=-2)
    causal = jnp.tril(jnp.ones((CHUNK, CHUNK), dtype=bool))

    def step(S, inp):
        qc, kc, vc, bc = inp
        diff = bc[..., :, None, :] - bc[..., None, :, :]
        decay = jnp.exp(jnp.where(causal[:, :, None], diff, -jnp.inf))
        A = jnp.einsum('bhid,bhijd,bhjd->bhij', qc, decay, kc)
        o = jnp.einsum('bhij,bhjv->bhiv', A, vc) + jnp.einsum('bhid,bhdv->bhiv', qc * jnp.exp(bc), S)
        blast = bc[..., -1:, :]
        S = S * jnp.exp(blast[..., 0, :])[..., None] + jnp.einsum('bhjd,bhjv->bhdv', kc * jnp.exp(blast - bc), vc)
        return S, o

    S0 = jnp.zeros((B, H, dk, dv), F32)
    _, o = lax.scan(step, S0, (qc_all, kc_all, vc_all, bc_all))
    return o.transpose(1, 0, 3, 2, 4).reshape(B, T, H, dv)


def rglru(x, w_a, b_a, w_x, b_x, lam):
    B, T, W = x.shape
    xf = x.astype(F32)
    xb = xf.reshape(B, T, LRU_BLOCKS, LRU_BLOCK)
    r = jax.nn.sigmoid(jnp.einsum('btni,nij->btnj', xb, w_a.astype(F32)).reshape(B, T, W) + b_a.astype(F32))
    i_g = jax.nn.sigmoid(jnp.einsum('btni,nij->btnj', xb, w_x.astype(F32)).reshape(B, T, W) + b_x.astype(F32))
    log_a = -LRU_C * r * jax.nn.softplus(-lam.astype(F32))
    a = jnp.exp(log_a)
    u = jnp.sqrt(-jnp.expm1(2.0 * log_a)) * (i_g * xf)

    def combine(left, right):
        return (left[0] * right[0], right[0] * left[1] + right[1])

    _, h = lax.associative_scan(combine, (a, u), axis=1)
    return h


def gated_delta_chunked(q, k, v, g, beta):
    B, T, H, dk = q.shape
    dv = v.shape[-1]
    N = T // CHUNK

    def to_chunks(t):
        return t.astype(F32).reshape(B, N, CHUNK, H, t.shape[-1]).transpose(0, 3, 1, 2, 4)

    qc = to_chunks(q) * (dk ** -0.5)
    kc = to_chunks(k)
    vc = to_chunks(v)
    gcum = jnp.cumsum(g.astype(F32).reshape(B, N, CHUNK, H).transpose(0, 3, 1, 2), axis=-1)
    bt = beta.astype(F32).reshape(B, N, CHUNK, H).transpose(0, 3, 1, 2)[..., None]
    incl = jnp.tril(jnp.ones((CHUNK, CHUNK), dtype=bool))
    strict = jnp.tril(jnp.ones((CHUNK, CHUNK), dtype=bool), k=-1)
    L = jnp.exp(jnp.where(incl, gcum[..., :, None] - gcum[..., None, :], -jnp.inf))
    kb = kc * bt
    vb = vc * bt
    M = jnp.where(strict, jnp.einsum('bhnid,bhnjd->bhnij', kb, kc) * L, 0.0)
    IM = M + jnp.eye(CHUNK, dtype=F32)
    rhs = jnp.concatenate([vb, kb * jnp.exp(gcum)[..., None]], axis=-1)
    sol = lax.linalg.triangular_solve(IM, rhs, left_side=True, lower=True, unit_diagonal=True)
    u_all = sol[..., :dv]
    w_all = sol[..., dv:]
    Aqk = jnp.where(incl, jnp.einsum('bhnid,bhnjd->bhnij', qc, kc) * L, 0.0)

    def nfirst(t):
        return jnp.moveaxis(t, 2, 0)

    def step(S, inp):
        qn, kn, un, wn, an, gn = inp
        v_new = un - jnp.einsum('bhcd,bhdv->bhcv', wn, S)
        o = jnp.einsum('bhcd,bhdv->bhcv', qn * jnp.exp(gn)[..., None], S) + jnp.einsum('bhij,bhjv->bhiv', an, v_new)
        glast = gn[..., -1]
        S = S * jnp.exp(glast)[..., None, None] + jnp.einsum('bhcd,bhcv->bhdv', kn * jnp.exp(glast[..., None] - gn)[..., None], v_new)
        return S, o

    S0 = jnp.zeros((B, H, dk, dv), F32)
    _, o = lax.scan(step, S0, (nfirst(qc), nfirst(kc), nfirst(u_all), nfirst(w_all), nfirst(Aqk), nfirst(gcum)))
    return o.transpose(1, 0, 3, 2, 4).reshape(B, T, H, dv)


def gla_lru_mixer(h, w_in, gk_w2, gk_b, gla_g, conv_w, conv_b, w_a, b_a, w_x, b_x, lam, w_out):
    B, T, _ = h.shape
    proj = h @ w_in
    o1 = GLA_KEY
    o2 = o1 + GLA_KEY
    o3 = o2 + GLA_VAL
    o4 = o3 + GLA_VAL
    o5 = o4 + GLA_GATE_RANK
    o6 = o5 + LRU_WIDTH
    q, k, v, g_out, gk_lr, lru_x, lru_gate = jnp.split(proj, [o1, o2, o3, o4, o5, o6], axis=-1)
    gk = jax.nn.log_sigmoid((gk_lr @ gk_w2 + gk_b).astype(F32)) / GLA_GATE_NORM
    o = gla_chunked(q.reshape(B, T, GLA_HEADS, GLA_DK), k.reshape(B, T, GLA_HEADS, GLA_DK),
                    v.reshape(B, T, GLA_HEADS, GLA_DV), gk.reshape(B, T, GLA_HEADS, GLA_DK))
    o = rms_norm(o, gla_g) * jax.nn.silu(g_out.reshape(B, T, GLA_HEADS, GLA_DV).astype(F32))
    xr = causal_dwconv(lru_x, conv_w, conv_b)
    y = rglru(xr, w_a, b_a, w_x, b_x, lam) * jax.nn.gelu(lru_gate.astype(F32))
    mixed = jnp.concatenate([o.reshape(B, T, GLA_VAL), y], axis=-1).astype(h.dtype)
    return mixed @ w_out


def gdn_mixer(h, w_in, conv_w, a_log, dt_bias, norm_g, w_out):
    B, T, _ = h.shape
    proj = h @ w_in
    p1 = GDN_CONV_CH
    p2 = p1 + GDN_VAL
    p3 = p2 + GDN_HEADS
    qkv, z, b_logit, a_logit = jnp.split(proj, [p1, p2, p3], axis=-1)
    qkv = jax.nn.silu(causal_dwconv(qkv, conv_w))
    q, k, v = jnp.split(qkv, [GDN_KEY, 2 * GDN_KEY], axis=-1)
    q = l2_norm(q.reshape(B, T, GDN_HEADS, GDN_DK))
    k = l2_norm(k.reshape(B, T, GDN_HEADS, GDN_DK))
    beta = jax.nn.sigmoid(b_logit.astype(F32))
    g = -jnp.exp(a_log.astype(F32)) * jax.nn.softplus(a_logit.astype(F32) + dt_bias.astype(F32))
    o = gated_delta_chunked(q, k, v.reshape(B, T, GDN_HEADS, GDN_DV), g, beta)
    o = rms_norm(o, norm_g) * jax.nn.silu(z.reshape(B, T, GDN_HEADS, GDN_DV).astype(F32))
    return o.reshape(B, T, GDN_VAL).astype(h.dtype) @ w_out


def mem_cross_attn(h, mem_n, w_q, w_kv, w_o):
    B, T, _ = h.shape
    M = mem_n.shape[1]
    q = (h @ w_q).reshape(B, T, XA_HEADS, XA_DH).astype(F32)
    kv = mem_n @ w_kv
    k = kv[..., :D_MODEL].reshape(B, M, XA_HEADS, XA_DH).astype(F32)
    v = kv[..., D_MODEL:].reshape(B, M, XA_HEADS, XA_DH).astype(F32)
    s = jnp.einsum('bthd,bmhd->bhtm', q, k) * (XA_DH ** -0.5)
    p = jax.nn.softmax(s, axis=-1)
    o = jnp.einsum('bhtm,bmhd->bthd', p, v).reshape(B, T, D_MODEL).astype(h.dtype)
    return o @ w_o


def sq_relu_mlp(h, w1, w2):
    return jnp.square(jax.nn.relu(h @ w1)) @ w2


def setup_inputs(seed: int = 0) -> dict:
    key = jax.random.key(seed)
    ks = iter(jax.random.split(key, 64))

    def nrm(shape, fan_in):
        return jax.random.normal(next(ks), shape, F32) * (fan_in ** -0.5)

    def gain(shape):
        return 1.0 + 0.02 * jax.random.normal(next(ks), shape, F32)

    def small(shape):
        return 0.01 * jax.random.normal(next(ks), shape, F32)

    x = jax.random.normal(next(ks), (BATCH, SEQ, D_MODEL), F32)
    mem = jax.random.normal(next(ks), (BATCH, N_MEM, D_MODEL), F32)
    u = jax.random.uniform(next(ks), (N_EVEN, LRU_WIDTH), F32, minval=0.9, maxval=0.999)
    p = u ** (1.0 / LRU_C)
    lru_lambda = jnp.log(p) - jnp.log1p(-p)
    gdn_a_log = jnp.log(jax.random.uniform(next(ks), (N_ODD, GDN_HEADS), F32, minval=1.0, maxval=16.0))
    dt = jnp.exp(jax.random.uniform(next(ks), (N_ODD, GDN_HEADS), F32, minval=float(np.log(1e-3)), maxval=float(np.log(1e-1))))
    gdn_dt_bias = dt + jnp.log(-jnp.expm1(-dt))
    return {
        "x": x,
        "mem": mem,
        "mix_pre_g": gain((DEPTH, D_MODEL)),
        "mix_post_g": gain((DEPTH, D_MODEL)),
        "ab_w_in": nrm((N_EVEN, D_MODEL, AB_IN), D_MODEL),
        "gla_gk_w2": nrm((N_EVEN, GLA_GATE_RANK, GLA_KEY), GLA_GATE_RANK),
        "gla_gk_b": small((N_EVEN, GLA_KEY)),
        "gla_norm_g": gain((N_EVEN, GLA_DV)),
        "lru_conv_w": nrm((N_EVEN, CONV_W, LRU_WIDTH), CONV_W),
        "lru_conv_b": small((N_EVEN, LRU_WIDTH)),
        "lru_w_a": nrm((N_EVEN, LRU_BLOCKS, LRU_BLOCK, LRU_BLOCK), LRU_BLOCK),
        "lru_b_a": small((N_EVEN, LRU_WIDTH)),
        "lru_w_x": nrm((N_EVEN, LRU_BLOCKS, LRU_BLOCK, LRU_BLOCK), LRU_BLOCK),
        "lru_b_x": small((N_EVEN, LRU_WIDTH)),
        "lru_lambda": lru_lambda,
        "ab_w_out": nrm((N_EVEN, AB_MIX, D_MODEL), AB_MIX),
        "gdn_w_in": nrm((N_ODD, D_MODEL, GDN_IN), D_MODEL),
        "gdn_conv_w": nrm((N_ODD, CONV_W, GDN_CONV_CH), CONV_W),
        "gdn_a_log": gdn_a_log,
        "gdn_dt_bias": gdn_dt_bias,
        "gdn_norm_g": gain((N_ODD, GDN_DV)),
        "gdn_w_out": nrm((N_ODD, GDN_VAL, D_MODEL), GDN_VAL),
        "xa_pre_g": gain((DEPTH, D_MODEL)),
        "xa_mem_g": gain((DEPTH, D_MODEL)),
        "xa_post_g": gain((DEPTH, D_MODEL)),
        "xa_w_q": nrm((DEPTH, D_MODEL, D_MODEL), D_MODEL),
        "xa_w_kv": nrm((DEPTH, D_MODEL, 2 * D_MODEL), D_MODEL),
        "xa_w_o": nrm((DEPTH, D_MODEL, D_MODEL), D_MODEL),
        "mlp_pre_g": gain((DEPTH, D_MODEL)),
        "mlp_post_g": gain((DEPTH, D_MODEL)),
        "mlp_w1": nrm((DEPTH, D_MODEL, D_FF), D_MODEL),
        "mlp_w2": nrm((DEPTH, D_FF, D_MODEL), D_FF),
    }


def reference(x, mem, mix_pre_g, mix_post_g, ab_w_in, gla_gk_w2, gla_gk_b, gla_norm_g, lru_conv_w, lru_conv_b,
              lru_w_a, lru_b_a, lru_w_x, lru_b_x, lru_lambda, ab_w_out, gdn_w_in, gdn_conv_w, gdn_a_log, gdn_dt_bias,
              gdn_norm_g, gdn_w_out, xa_pre_g, xa_mem_g, xa_post_g, xa_w_q, xa_w_kv, xa_w_o, mlp_pre_g, mlp_post_g,
              mlp_w1, mlp_w2):
    h = x
    for i in range(DEPTH):
        j = i // 2
        hn = rms_norm(h, mix_pre_g[i])
        if i % 2 == 0:
            m = gla_lru_mixer(hn, ab_w_in[j], gla_gk_w2[j], gla_gk_b[j], gla_norm_g[j], lru_conv_w[j], lru_conv_b[j],
                              lru_w_a[j], lru_b_a[j], lru_w_x[j], lru_b_x[j], lru_lambda[j], ab_w_out[j])
        else:
            m = gdn_mixer(hn, gdn_w_in[j], gdn_conv_w[j], gdn_a_log[j], gdn_dt_bias[j], gdn_norm_g[j], gdn_w_out[j])
        h = h + rms_norm(m, mix_post_g[i])
        c = mem_cross_attn(rms_norm(h, xa_pre_g[i]), rms_norm(mem, xa_mem_g[i]), xa_w_q[i], xa_w_kv[i], xa_w_o[i])
        h = h + rms_norm(c, xa_post_g[i])
        f = sq_relu_mlp(rms_norm(h, mlp_pre_g[i]), mlp_w1[i], mlp_w2[i])
        h = h + rms_norm(f, mlp_post_g[i])
    return h
```

```cpp
#include <hip/hip_runtime.h>
#include <cstdio>
#include <cstdint>
namespace pg8 {
#define PG8_LAS __attribute__((address_space(3)))
typedef unsigned short bf16_t;
typedef short bf16x8 __attribute__((ext_vector_type(8)));
typedef float f32x4 __attribute__((ext_vector_type(4)));
typedef unsigned u32x4 __attribute__((ext_vector_type(4)));
constexpr int BM = 256, BK = 64, HALF = 128, HTB = HALF * BK * 2  , STAGE_BYTES = 8 * HTB, NXCD = 8, WGM = 8;

__host__ __device__ __forceinline__ int lds_byte(int r, int c) { const int st = (r >> 4) * 2 + (c >> 5), rr = r & 15, cc = c & 31, ob = rr * 64 + cc * 2; return st * 1024 + (ob ^ (((ob >> 9) & 1) << 5)); }
__host__ __device__ __forceinline__ void stage_rc(int b, int& R, int& C) { const int st = b / 1024, sb = b % 1024, swz = sb ^ (((sb >> 9) & 1) << 5); R = (st >> 1) * 16 + swz / 64; C = (st & 1) * 32 + (swz % 64) / 2; }
__host__ __device__ __forceinline__ int perm32(int rho) { const int n = rho >> 4, i = rho & 15; return 8 * (i >> 2) + 4 * n + (i & 3); }

struct Unit { int pm, pn; };
struct Gemm { const bf16_t* A; const bf16_t* Bt; int M, N, K; };

struct StaticOrder {
    int nM, nN, nwg, G, c;
    __host__ __device__ void init(int M, int N, int G_, int c_) { nM = M / BM; nN = N / BM; nwg = nM * nN; G = G_; c = c_; }
    __host__ __device__ bool next(int i, Unit& u) const {
        const long L = (long)i * G + c; if (L >= nwg) return false;
        int wgid = (int)L; { const int q = nwg / NXCD, r = nwg % NXCD, xcd = wgid % NXCD, off = wgid / NXCD; wgid = (xcd < r ? xcd * (q + 1) : r * (q + 1) + (xcd - r) * q) + off; }
        const int nig = WGM * nN, gid = wgid / nig, fm = gid * WGM, gsz = (nM - fm) < WGM ? (nM - fm) : WGM;
        u.pm = fm + ((wgid % nig) % gsz); u.pn = (wgid % nig) / gsz; return true;
    }
    __device__ __forceinline__ void a_ready(const Unit&) const {}
    __device__ __forceinline__ void done(const Unit&) const {}
};

__device__ __forceinline__ unsigned cvt_pk_bf16(float lo, float hi) { unsigned r; asm volatile("v_cvt_pk_bf16_f32 %0, %1, %2" : "=v"(r) : "v"(lo), "v"(hi)); return r; }
typedef float f32x2 __attribute__((ext_vector_type(2)));
__device__ __forceinline__ f32x2 gelu_pk(f32x2 v) {
    const f32x2 av = __builtin_elementwise_abs(v), d = av * 0.2316418882f + 1.0f;
    f32x2 t; t.x = __builtin_amdgcn_rcpf(d.x); t.y = __builtin_amdgcn_rcpf(d.y);
    f32x2 q = t * 0.5307027145f + (-0.7265760135f); q = q * t + 0.7107068705f; q = q * t + (-0.142248368f); q = q * t + 0.127414796f; q = q * t;
    const f32x2 s = (v * v) * (-0.72134752044f);
    f32x2 e; e.x = __builtin_amdgcn_exp2f(s.x); e.y = __builtin_amdgcn_exp2f(s.y);
    const f32x2 m = v * (q * e), r = v - m;
    f32x2 o; o.x = v.x < 0.f ? m.x : r.x; o.y = v.y < 0.f ? m.y : r.y; return o;
}

template <int ACT  > struct EpiBf16 {
    static constexpr bool PERM = true, AFTER_DRAIN = false; static_assert(ACT == 0 || ACT == 1, "EpiBf16: ACT is 0 (none) or 1 (gelu_pk)");
    bf16_t* O; int ldc; const float* bias; int split_cols; size_t split_stride; float scale0;
    __device__ __forceinline__ void operator()(const f32x4 (&acc)[2][2][4][2], const Unit& u, int wr, int wc, int fr, int fq) const {
        const int row0 = u.pm * BM + wr * 64 + fr; int colt = u.pn * BM; bf16_t* base = O;
        float sc = 1.f; if (split_cols) { const int t = colt / split_cols; base += (size_t)t * split_stride; colt -= t * split_cols; if (t == 0) sc = scale0; }
        const int col0 = colt + wc * 32 + 8 * fq, bcol0 = u.pn * BM + wc * 32 + 8 * fq;
        f32x4 bv[2][2];
#pragma unroll
        for (int bj = 0; bj < 2; ++bj)
#pragma unroll
            for (int n = 0; n < 2; ++n) bv[bj][n] = bias ? *(const f32x4*)(bias + bcol0 + bj * HALF + 4 * n) : (f32x4){0.f, 0.f, 0.f, 0.f};
#pragma unroll
        for (int ai = 0; ai < 2; ++ai)
#pragma unroll
            for (int m = 0; m < 4; ++m) { bf16_t* rowp = base + (size_t)(row0 + ai * HALF + m * 16) * ldc + col0;
#pragma unroll
                for (int bj = 0; bj < 2; ++bj) { f32x4 v0 = acc[ai][bj][m][0] + bv[bj][0], v1 = acc[ai][bj][m][1] + bv[bj][1];
                    if (ACT == 1) { f32x2 a = gelu_pk((f32x2){v0[0], v0[1]}), b = gelu_pk((f32x2){v0[2], v0[3]}), c = gelu_pk((f32x2){v1[0], v1[1]}), d = gelu_pk((f32x2){v1[2], v1[3]});
                        v0 = (f32x4){a.x, a.y, b.x, b.y}; v1 = (f32x4){c.x, c.y, d.x, d.y}; }
                    v0 = v0 * sc; v1 = v1 * sc; u32x4 w; w.x = cvt_pk_bf16(v0[0], v0[1]); w.y = cvt_pk_bf16(v0[2], v0[3]); w.z = cvt_pk_bf16(v1[0], v1[1]); w.w = cvt_pk_bf16(v1[2], v1[3]);
                    *(u32x4*)(rowp + bj * HALF) = w; } }
    }
};

struct PanelStats {
    unsigned* xbuf;
    unsigned* cnt;
    unsigned* tmo;
    int ntn; float eps;
    unsigned code;
    __device__ __forceinline__ bool run(const f32x4 (&v)[2][2][4][2], const Unit& u, int wr, int wc, int fr, int fq, PG8_LAS unsigned char* lds, int wid, int lane) const {
        typedef float f32x2v __attribute__((ext_vector_type(2)));
        PG8_LAS f32x2v* P = (PG8_LAS f32x2v*)lds;
        PG8_LAS f32x2v* S = (PG8_LAS f32x2v*)(lds + 8192);
        PG8_LAS unsigned* flag = (PG8_LAS unsigned*)(lds + 8192 + 2048);
#pragma unroll
        for (int ai = 0; ai < 2; ++ai)
#pragma unroll
            for (int m = 0; m < 4; ++m) {
                float s = 0.f;
#pragma unroll
                for (int bj = 0; bj < 2; ++bj)
#pragma unroll
                    for (int n = 0; n < 2; ++n) { const f32x4 x = v[ai][bj][m][n]; s += (x[0] + x[1]) + (x[2] + x[3]); }
                s += __shfl_xor(s, 16); s += __shfl_xor(s, 32);
                const float mw = s * (1.0f / 64.0f); float q = 0.f;
#pragma unroll
                for (int bj = 0; bj < 2; ++bj)
#pragma unroll
                    for (int n = 0; n < 2; ++n) { const f32x4 d = v[ai][bj][m][n] - mw; q += (d[0] * d[0] + d[1] * d[1]) + (d[2] * d[2] + d[3] * d[3]); }
                q += __shfl_xor(q, 16); q += __shfl_xor(q, 32);
                if (fq == 0) P[(ai * HALF + wr * 64 + m * 16 + fr) * 4 + wc] = (f32x2v){mw, q};
            }
        asm volatile("s_waitcnt lgkmcnt(0)" ::: "memory"); __builtin_amdgcn_s_barrier(); asm volatile("" ::: "memory");
#if defined(BROKEN_EXCHANGE_NO_WAIT)
#warning BROKEN CONTROL BUILD: the row-statistics exchange does not wait; results are wrong by design
        if (blockIdx.x >= 64) { const long long t0_ = clock64(); while (clock64() - t0_ < 60000) __builtin_amdgcn_s_sleep(8); }
#endif
        const int row = wid * 32 + (lane & 31);
        if (lane < 32) {
            const f32x2v a = P[row * 4 + 0], b = P[row * 4 + 1], c = P[row * 4 + 2], d = P[row * 4 + 3];
            const float mt = (a.x + b.x + c.x + d.x) * 0.25f;
            const float da = a.x - mt, db = b.x - mt, dc = c.x - mt, dd = d.x - mt;
            const float m2 = (a.y + b.y) + (c.y + d.y) + 64.0f * ((da * da + db * db) + (dc * dc + dd * dd));
            unsigned long long* slot = (unsigned long long*)xbuf + ((size_t)(u.pm * BM + row) * 4 + u.pn);
            __hip_atomic_store(slot, ((unsigned long long)__float_as_uint(m2) << 32) | __float_as_uint(mt), __ATOMIC_RELAXED, __HIP_MEMORY_SCOPE_AGENT);
        }
        asm volatile("s_waitcnt vmcnt(0)" ::: "memory");
        if (lane == 0) __hip_atomic_fetch_add(cnt + 64 * u.pm, 1u, __ATOMIC_RELAXED, __HIP_MEMORY_SCOPE_AGENT);
        if (wid == 0) {
            bool dead = false; const unsigned long long t0 = __builtin_amdgcn_s_memrealtime(); const unsigned want = 8u * (unsigned)ntn;
            for (;;) {
#if defined(BROKEN_EXCHANGE_NO_WAIT)
                break;
#endif
                if ((unsigned)__builtin_amdgcn_readfirstlane(__hip_atomic_load(cnt + 64 * u.pm, __ATOMIC_RELAXED, __HIP_MEMORY_SCOPE_AGENT)) >= want) break;
                if (__builtin_amdgcn_s_memrealtime() - t0 > 2000000ull) {
                    if (lane == 0) { unsigned expect = 0u; __hip_atomic_compare_exchange_strong(tmo + 1, &expect, code | (unsigned)(u.pm & 0xff), __ATOMIC_RELAXED, __ATOMIC_RELAXED, __HIP_MEMORY_SCOPE_AGENT);
                                     __hip_atomic_store(tmo, 1u, __ATOMIC_RELAXED, __HIP_MEMORY_SCOPE_AGENT); }
                    dead = true; break; }
                __builtin_amdgcn_s_sleep(2);
            }
            __builtin_amdgcn_fence(__ATOMIC_ACQUIRE, "agent");
            if (lane == 0) flag[0] = dead ? 1u : 0u;
        }
        asm volatile("s_waitcnt vmcnt(0) lgkmcnt(0)" ::: "memory"); __builtin_amdgcn_s_barrier(); asm volatile("" ::: "memory");
        const bool bad = flag[0] != 0u;
        if (lane < 32) {
            const unsigned long long* slot = (const unsigned long long*)xbuf + (size_t)(u.pm * BM + row) * 4; float mt[4], m2[4]; float ms = 0.f;
#pragma unroll
            for (int t = 0; t < 4; ++t) { if (t < ntn) { const unsigned long long w = __hip_atomic_load(slot + t, __ATOMIC_RELAXED, __HIP_MEMORY_SCOPE_AGENT); mt[t] = __uint_as_float((unsigned)w); m2[t] = __uint_as_float((unsigned)(w >> 32)); } else { mt[t] = 0.f; m2[t] = 0.f; } ms += mt[t]; }
            const float mean = ms / (float)ntn; float q = 0.f;
#pragma unroll
            for (int t = 0; t < 4; ++t) if (t < ntn) { const float dm = mt[t] - mean; q += m2[t] + 256.0f * dm * dm; }
            S[row] = (f32x2v){mean, 1.0f / sqrtf(q / (256.0f * (float)ntn) + eps)};
        }
        asm volatile("s_waitcnt lgkmcnt(0)" ::: "memory"); __builtin_amdgcn_s_barrier(); asm volatile("" ::: "memory");
        return bad;
    }
};
struct EpiLnRes {
    static constexpr bool PERM = false, AFTER_DRAIN = true;
    const float* base; float* out; int ldc; const float* bias; PanelStats st; unsigned poison;
    __device__ __forceinline__ void fused(f32x4 (&acc)[2][2][4][2], const Unit& u, int wr, int wc, int fr, int fq, PG8_LAS unsigned char* lds, int wid, int lane) const {
        typedef float f32x2v __attribute__((ext_vector_type(2)));
        const PG8_LAS f32x2v* S = (const PG8_LAS f32x2v*)(lds + 8192);
        const int col0 = u.pn * BM + wc * 32 + 4 * fq;
#pragma unroll
        for (int bj = 0; bj < 2; ++bj)
#pragma unroll
            for (int n = 0; n < 2; ++n) { const f32x4 bv = bias ? *(const f32x4*)(bias + col0 + bj * HALF + n * 16) : (f32x4){0.f, 0.f, 0.f, 0.f};
#pragma unroll
                for (int ai = 0; ai < 2; ++ai)
#pragma unroll
                    for (int m = 0; m < 4; ++m) acc[ai][bj][m][n] += bv; }
        f32x4 pre[4][2][2];
#pragma unroll
        for (int m = 0; m < 4; ++m) { const size_t off = (size_t)(u.pm * BM + wr * 64 + m * 16 + fr) * ldc + col0;
#pragma unroll
            for (int bj = 0; bj < 2; ++bj)
#pragma unroll
                for (int n = 0; n < 2; ++n) pre[m][bj][n] = *(const f32x4*)(base + off + bj * HALF + n * 16); }
        const bool bad = st.run(acc, u, wr, wc, fr, fq, lds, wid, lane) || poison != 0u;
        const float qnan = __builtin_nanf("");
#pragma unroll
        for (int ai = 0; ai < 2; ++ai)
#pragma unroll
            for (int m = 0; m < 4; ++m) { const int r = ai * HALF + wr * 64 + m * 16 + fr; const f32x2v sr = S[r]; const size_t off = (size_t)(u.pm * BM + r) * ldc + col0;
#pragma unroll
                for (int bj = 0; bj < 2; ++bj)
#pragma unroll
                    for (int n = 0; n < 2; ++n) { const f32x4 bs = ai == 0 ? pre[m][bj][n] : *(const f32x4*)(base + off + bj * HALF + n * 16); f32x4 o = bs + (acc[ai][bj][m][n] - sr.x) * sr.y;
                        if (bad) o = (f32x4){qnan, qnan, qnan, qnan}; *(f32x4*)(out + off + bj * HALF + n * 16) = o; }
                if (m & 1) asm volatile("" ::: "memory"); }
    }
};
struct EpiLnResLn {
    static constexpr bool PERM = false, AFTER_DRAIN = true;
    const float* base; float* out; bf16_t* xn; int ldc; const float* bias; PanelStats st1, st2; unsigned poison;
    __device__ __forceinline__ void fused(f32x4 (&acc)[2][2][4][2], const Unit& u, int wr, int wc, int fr, int fq, PG8_LAS unsigned char* lds, int wid, int lane) const {
        typedef float f32x2v __attribute__((ext_vector_type(2))); typedef unsigned u32x2v __attribute__((ext_vector_type(2)));
        const PG8_LAS f32x2v* S = (const PG8_LAS f32x2v*)(lds + 8192);
        const int col0 = u.pn * BM + wc * 32 + 4 * fq;
#pragma unroll
        for (int bj = 0; bj < 2; ++bj)
#pragma unroll
            for (int n = 0; n < 2; ++n) { const f32x4 bv = bias ? *(const f32x4*)(bias + col0 + bj * HALF + n * 16) : (f32x4){0.f, 0.f, 0.f, 0.f};
#pragma unroll
                for (int ai = 0; ai < 2; ++ai)
#pragma unroll
                    for (int m = 0; m < 4; ++m) acc[ai][bj][m][n] += bv; }
        bool bad = st1.run(acc, u, wr, wc, fr, fq, lds, wid, lane) || poison != 0u;
        const float qnan = __builtin_nanf("");
#pragma unroll
        for (int ai = 0; ai < 2; ++ai)
#pragma unroll
            for (int m = 0; m < 4; ++m) { const int r = ai * HALF + wr * 64 + m * 16 + fr; const f32x2v sr = S[r]; const size_t off = (size_t)(u.pm * BM + r) * ldc + col0;
#pragma unroll
                for (int bj = 0; bj < 2; ++bj)
#pragma unroll
                    for (int n = 0; n < 2; ++n) { const f32x4 bs = *(const f32x4*)(base + off + bj * HALF + n * 16); acc[ai][bj][m][n] = bs + (acc[ai][bj][m][n] - sr.x) * sr.y; }
                asm volatile("" : "+v"(acc[ai][0][m][0]), "+v"(acc[ai][0][m][1]), "+v"(acc[ai][1][m][0]), "+v"(acc[ai][1][m][1]));
                if (m & 1) asm volatile("" ::: "memory"); }
        const bool bad1 = bad;
        bad = st2.run(acc, u, wr, wc, fr, fq, lds, wid, lane) || bad;
#pragma unroll
        for (int ai = 0; ai < 2; ++ai)
#pragma unroll
            for (int m = 0; m < 4; ++m) { const int r = ai * HALF + wr * 64 + m * 16 + fr; const f32x2v sr = S[r]; const size_t off = (size_t)(u.pm * BM + r) * ldc + col0;
#pragma unroll
                for (int bj = 0; bj < 2; ++bj)
#pragma unroll
                    for (int n = 0; n < 2; ++n) { const f32x4 x1 = acc[ai][bj][m][n]; *(f32x4*)(out + off + bj * HALF + n * 16) = bad1 ? (f32x4){qnan, qnan, qnan, qnan} : x1;
                        const f32x4 o = (x1 - sr.x) * sr.y; u32x2v w; w.x = cvt_pk_bf16(o[0], o[1]); w.y = cvt_pk_bf16(o[2], o[3]);
                        if (bad) { w.x = 0x7fc07fc0u; w.y = 0x7fc07fc0u; } *(u32x2v*)(xn + off + bj * HALF + n * 16) = w; }
                asm volatile("" ::: "memory"); }
    }
};

template <class Epi, class Sched, bool ALIGN_EPI = false, bool SP2 = false>
__device__ __forceinline__ void gemm_phase(PG8_LAS unsigned char* lds, const Gemm g, const Sched& S, const Epi& E) {
    int tid_ = threadIdx.x; asm volatile("" : "+v"(tid_));
    const int tid = tid_, wid = __builtin_amdgcn_readfirstlane(tid >> 6), lane = tid & 63, wr = wid >> 2, wc = wid & 3, fr = lane & 15, fq = lane >> 4;
    const int K = g.K, nt = K / BK;
    unsigned voffA[2], voffB[2];
#pragma unroll
    for (int i = 0; i < 2; ++i) { int R, C; stage_rc(tid * 16 + i * 8192, R, C); const int Rb = Epi::PERM ? ((R & ~31) + perm32(R & 31)) : R;
        voffA[i] = (unsigned)(R * K + C) * 2u; voffB[i] = (unsigned)(Rb * K + C) * 2u; }
    const size_t kstep = (size_t)(BK * 2);
    const size_t hstep = (size_t)HALF * K * 2;
    const size_t tstep = 2 * hstep;
    const unsigned ldsw = (unsigned)wid * 1024u;
    const int aoff = lds_byte(wr * 64 + fr, fq * 8), boff = lds_byte(wc * 32 + fr, fq * 8);
#define PG8_SA(b, h) (((b) * 2 + (h)) * HTB)
#define PG8_SB(b, h) ((4 + (b) * 2 + (h)) * HTB)
#define PG8_STAGE(bufoff, gbase, voff) do { _Pragma("unroll") for (int _i = 0; _i < 2; ++_i) \
        __builtin_amdgcn_global_load_lds((const unsigned*)((const char*)(gbase) + (voff)[_i]), (PG8_LAS unsigned*)(lds + (bufoff) + ldsw + _i * 8192), 16, 0, 0); } while (0)
#define PG8_LDA(dst, b, h) do { _Pragma("unroll") for (int m = 0; m < 4; ++m) _Pragma("unroll") for (int k = 0; k < 2; ++k) dst[m][k] = *(const PG8_LAS bf16x8*)(lds + PG8_SA(b, h) + aoff + m * 2048 + k * 1024); } while (0)
#define PG8_LDB(dst, b, h) do { _Pragma("unroll") for (int n = 0; n < 2; ++n) _Pragma("unroll") for (int k = 0; k < 2; ++k) dst[n][k] = *(const PG8_LAS bf16x8*)(lds + PG8_SB(b, h) + boff + n * 2048 + k * 1024); } while (0)
#define PG8_MMA(ai, bj, At, Bt) do { __builtin_amdgcn_s_setprio(1); _Pragma("unroll") for (int m = 0; m < 4; ++m) _Pragma("unroll") for (int n = 0; n < 2; ++n) _Pragma("unroll") for (int k = 0; k < 2; ++k) \
        acc[ai][bj][m][n] = __builtin_amdgcn_mfma_f32_16x16x32_bf16(Bt[n][k], At[m][k], acc[ai][bj][m][n], 0, 0, 0); __builtin_amdgcn_s_setprio(0); } while (0)
#define PG8_WAIT_V(n) asm volatile("s_waitcnt vmcnt(" #n ")" ::: "memory")
#define PG8_WAIT_L(n) asm volatile("s_waitcnt lgkmcnt(" #n ")" ::: "memory")
#define PG8_BAR __builtin_amdgcn_s_barrier()
#define PG8_SCHED __builtin_amdgcn_sched_barrier(0)
    Unit cur, nxt; int ui = 0;
    if (!S.next(0, cur)) return;
    f32x4 acc[2][2][4][2];
#pragma unroll
    for (int a = 0; a < 2; ++a)
#pragma unroll
        for (int b = 0; b < 2; ++b)
#pragma unroll
            for (int m = 0; m < 4; ++m)
#pragma unroll
                for (int n = 0; n < 2; ++n) acc[a][b][m][n] = (f32x4){0.f, 0.f, 0.f, 0.f};
    bf16x8 At[4][2], B0[2][2], B1[2][2];
    const char* cA = (const char*)g.A + (size_t)cur.pm * tstep; const char* cB = (const char*)g.Bt + (size_t)cur.pn * tstep;
    S.a_ready(cur);
    if constexpr (SP2) {
        PG8_STAGE(PG8_SB(0, 0), cB, voffB); PG8_STAGE(PG8_SB(0, 1), cB + hstep, voffB); PG8_STAGE(PG8_SA(0, 0), cA, voffA); PG8_STAGE(PG8_SA(0, 1), cA + hstep, voffA);
        if (wr == 1) PG8_BAR;
        PG8_WAIT_V(2); PG8_BAR;
        PG8_STAGE(PG8_SB(1, 0), cB + kstep, voffB); PG8_STAGE(PG8_SA(1, 0), cA + kstep, voffA); PG8_STAGE(PG8_SB(1, 1), cB + hstep + kstep, voffB);
        PG8_WAIT_V(6); PG8_BAR;
    } else {
        PG8_STAGE(PG8_SB(0, 0), cB, voffB); PG8_STAGE(PG8_SA(0, 0), cA, voffA); PG8_STAGE(PG8_SB(0, 1), cB + hstep, voffB); PG8_STAGE(PG8_SA(0, 1), cA + hstep, voffA);
        if (wr == 1) PG8_BAR;
        PG8_WAIT_V(4); PG8_BAR;
        PG8_STAGE(PG8_SB(1, 0), cB + kstep, voffB); PG8_STAGE(PG8_SA(1, 0), cA + kstep, voffA); PG8_STAGE(PG8_SB(1, 1), cB + hstep + kstep, voffB);
        PG8_WAIT_V(6); PG8_BAR;
    }
    for (;;) {
        const bool has_next = S.next(ui + 1, nxt);
        const char* nA = has_next ? (const char*)g.A + (size_t)nxt.pm * tstep : cA; const char* nB = has_next ? (const char*)g.Bt + (size_t)nxt.pn * tstep : cB;
        for (int t = 0; t < nt; t += 2) {
            const bool last = (t == nt - 2);
            const char* a1 = cA + (size_t)(t + 1) * kstep;
            const char* a2 = last ? nA : cA + (size_t)(t + 2) * kstep; const char* b2 = last ? nB : cB + (size_t)(t + 2) * kstep;
            const char* a3 = a2 + kstep; const char* b3 = b2 + kstep;
            if (last && has_next) S.a_ready(nxt);
            if constexpr (SP2) {
            PG8_LDB(B0, 0, 0); PG8_LDB(B1, 0, 1); PG8_SCHED; PG8_LDA(At, 0, 0); PG8_STAGE(PG8_SA(1, 1), a1 + hstep, voffA);
            PG8_WAIT_V(8); PG8_WAIT_L(0); PG8_BAR; PG8_MMA(0, 0, At, B0); PG8_MMA(0, 1, At, B1); PG8_BAR; PG8_SCHED;
            PG8_LDA(At, 0, 1); PG8_STAGE(PG8_SB(0, 0), b2, voffB); PG8_STAGE(PG8_SB(0, 1), b2 + hstep, voffB); PG8_STAGE(PG8_SA(0, 0), a2, voffA);
            PG8_WAIT_V(8); PG8_WAIT_L(0); PG8_BAR; PG8_MMA(1, 0, At, B0); PG8_MMA(1, 1, At, B1); PG8_BAR; PG8_SCHED;
            PG8_LDB(B0, 1, 0); PG8_LDB(B1, 1, 1); PG8_SCHED; PG8_LDA(At, 1, 0); PG8_STAGE(PG8_SA(0, 1), a2 + hstep, voffA);
            PG8_WAIT_V(8); PG8_WAIT_L(0); PG8_BAR; PG8_MMA(0, 0, At, B0); PG8_MMA(0, 1, At, B1); PG8_BAR; PG8_SCHED;
            PG8_LDA(At, 1, 1); PG8_STAGE(PG8_SB(1, 0), b3, voffB); PG8_STAGE(PG8_SB(1, 1), b3 + hstep, voffB); PG8_STAGE(PG8_SA(1, 0), a3, voffA);
            PG8_WAIT_V(8); PG8_WAIT_L(0); PG8_BAR; PG8_MMA(1, 0, At, B0); PG8_MMA(1, 1, At, B1); PG8_BAR; PG8_SCHED;
            } else {
            PG8_LDB(B0, 0, 0); PG8_SCHED; PG8_LDA(At, 0, 0); PG8_STAGE(PG8_SA(1, 1), a1 + hstep, voffA);
            PG8_WAIT_L(8); PG8_BAR; PG8_WAIT_L(0); PG8_MMA(0, 0, At, B0); PG8_BAR; PG8_SCHED;
            PG8_LDB(B1, 0, 1); PG8_STAGE(PG8_SB(0, 0), b2, voffB);
            PG8_BAR; PG8_WAIT_L(0); PG8_MMA(0, 1, At, B1); PG8_BAR;
            PG8_LDA(At, 0, 1); PG8_STAGE(PG8_SA(0, 0), a2, voffA);
            PG8_BAR; PG8_WAIT_L(0); PG8_MMA(1, 0, At, B0); PG8_BAR; PG8_SCHED;
            PG8_STAGE(PG8_SB(0, 1), b2 + hstep, voffB);
            PG8_WAIT_V(6); PG8_BAR; PG8_MMA(1, 1, At, B1); PG8_BAR;
            PG8_LDB(B0, 1, 0); PG8_SCHED; PG8_LDA(At, 1, 0); PG8_STAGE(PG8_SA(0, 1), a2 + hstep, voffA);
            PG8_WAIT_L(8); PG8_BAR; PG8_WAIT_L(0); PG8_MMA(0, 0, At, B0); PG8_BAR; PG8_SCHED;
            PG8_LDB(B1, 1, 1); PG8_STAGE(PG8_SB(1, 0), b3, voffB);
            PG8_BAR; PG8_WAIT_L(0); PG8_MMA(0, 1, At, B1); PG8_BAR;
            PG8_LDA(At, 1, 1); PG8_STAGE(PG8_SA(1, 0), a3, voffA);
            PG8_BAR; PG8_WAIT_L(0); PG8_MMA(1, 0, At, B0); PG8_BAR; PG8_SCHED;
            PG8_STAGE(PG8_SB(1, 1), b3 + hstep, voffB);
            PG8_WAIT_V(6); PG8_BAR; PG8_MMA(1, 1, At, B1); PG8_BAR;
            }
        }
        if constexpr (ALIGN_EPI) { if (wr == 0) PG8_BAR; }
        if constexpr (!Epi::AFTER_DRAIN) { E(acc, cur, wr, wc, fr, fq); S.done(cur); }
        if (!has_next) break;
#pragma unroll
        for (int a = 0; a < 2; ++a)
#pragma unroll
            for (int b = 0; b < 2; ++b)
#pragma unroll
                for (int m = 0; m < 4; ++m)
#pragma unroll
                    for (int n = 0; n < 2; ++n) acc[a][b][m][n] = (f32x4){0.f, 0.f, 0.f, 0.f};
        cur = nxt; cA = nA; cB = nB; ++ui;
        if constexpr (ALIGN_EPI) { if (wr == 1) PG8_BAR; }
    }
    PG8_WAIT_V(0);
    if constexpr (!ALIGN_EPI) { if (wr == 0) PG8_BAR; }
    PG8_BAR;
    if constexpr (Epi::AFTER_DRAIN) { E.fused(acc, cur, wr, wc, fr, fq, lds, wid, lane); S.done(cur); }
#undef PG8_SA
#undef PG8_SB
#undef PG8_STAGE
#undef PG8_LDA
#undef PG8_LDB
#undef PG8_MMA
#undef PG8_WAIT_V
#undef PG8_WAIT_L
#undef PG8_BAR
#undef PG8_SCHED
}
}

namespace pg8 {
typedef __bf16 bf16x2v __attribute__((ext_vector_type(2)));
typedef float f32x2w __attribute__((ext_vector_type(2)));
__device__ __forceinline__ unsigned pk_bf16(float lo, float hi) { f32x2w v = {lo, hi}; bf16x2v b = __builtin_convertvector(v, bf16x2v); return __builtin_bit_cast(unsigned, b); }
template <int ACT> struct EpiBf16A {
    static constexpr bool PERM = true, AFTER_DRAIN = false;
    bf16_t* O; int ldc;
    __device__ __forceinline__ void operator()(const f32x4 (&acc)[2][2][4][2], const Unit& u, int wr, int wc, int fr, int fq) const {
        const int row0 = u.pm * BM + wr * 64 + fr; const int col0 = u.pn * BM + wc * 32 + 8 * fq;
#pragma unroll
        for (int ai = 0; ai < 2; ++ai)
#pragma unroll
            for (int m = 0; m < 4; ++m) { bf16_t* rowp = O + (size_t)(row0 + ai * HALF + m * 16) * ldc + col0;
#pragma unroll
                for (int bj = 0; bj < 2; ++bj) { f32x4 v0 = acc[ai][bj][m][0], v1 = acc[ai][bj][m][1];
                    if (ACT == 1) {
#pragma unroll
                        for (int j = 0; j < 4; ++j) { const float a = fmaxf(v0[j], 0.f), b = fmaxf(v1[j], 0.f); v0[j] = a * a; v1[j] = b * b; } }
                    u32x4 w; w.x = pk_bf16(v0[0], v0[1]); w.y = pk_bf16(v0[2], v0[3]); w.z = pk_bf16(v1[0], v1[1]); w.w = pk_bf16(v1[2], v1[3]);
                    *(u32x4*)(rowp + bj * HALF) = w; } }
    }
};
struct EpiF32A {
    static constexpr bool PERM = false, AFTER_DRAIN = false;
    float* C; int ldc;
    __device__ __forceinline__ void operator()(const f32x4 (&acc)[2][2][4][2], const Unit& u, int wr, int wc, int fr, int fq) const {
        const int row0 = u.pm * BM + wr * 64 + fr, col0 = u.pn * BM + wc * 32 + 4 * fq;
#pragma unroll
        for (int ai = 0; ai < 2; ++ai)
#pragma unroll
            for (int m = 0; m < 4; ++m) { float* rowp = C + (size_t)(row0 + ai * HALF + m * 16) * ldc + col0;
#pragma unroll
                for (int bj = 0; bj < 2; ++bj)
#pragma unroll
                    for (int n = 0; n < 2; ++n) *(f32x4*)(rowp + bj * HALF + n * 16) = acc[ai][bj][m][n]; }
    }
};
}

#define GAS __attribute__((address_space(1)))
#define LAS __attribute__((address_space(3)))
typedef unsigned short bf16;
typedef unsigned v4u __attribute__((ext_vector_type(4)));
typedef unsigned v2u __attribute__((ext_vector_type(2)));
typedef float f32x4 __attribute__((ext_vector_type(4)));
typedef float f32x16 __attribute__((ext_vector_type(16)));
typedef short bf16x8 __attribute__((ext_vector_type(8)));
typedef short s16x4 __attribute__((ext_vector_type(4)));
typedef GAS unsigned gu32;
typedef GAS unsigned long long gu64;
#define RLX_AGENT __ATOMIC_RELAXED, __HIP_MEMORY_SCOPE_AGENT
#define LDS_WAIT() asm volatile("s_waitcnt lgkmcnt(0)" ::: "memory")
#define VM_WAIT() asm volatile("s_waitcnt vmcnt(0)" ::: "memory")
__device__ __forceinline__ unsigned pk2(float lo, float hi) { return pg8::pk_bf16(lo, hi); }
__device__ __forceinline__ bf16 f2bf(float f) { return (bf16)(pk2(f, 0.f) & 0xffffu); }
__device__ __forceinline__ float bf2f(bf16 h) { return __uint_as_float((unsigned)h << 16); }
__device__ __forceinline__ float bflo(unsigned w) { return __uint_as_float(w << 16); }
__device__ __forceinline__ float bfhi(unsigned w) { return __uint_as_float(w & 0xffff0000u); }

#define XB_TMO      128
#define XB_XCNT(j)  (256  + 64 * (j))
#define XB_XSUB(j)  (1280 + 64 * (j))
#define XB_XGEN(j)  (2304 + 64 * (j))
#define XB_TOP      3328
#define XB_TOPGEN   3392
#define XCD_BAR_WORDS 3456
#define XB_SPIN_CAP (1u << 18)

__device__ __forceinline__ unsigned xb_ld(unsigned* p)              { return __hip_atomic_load(p, __ATOMIC_RELAXED, __HIP_MEMORY_SCOPE_AGENT); }
__device__ __forceinline__ unsigned xb_add(unsigned* p, unsigned v) { return __hip_atomic_fetch_add(p, v, __ATOMIC_RELAXED, __HIP_MEMORY_SCOPE_AGENT); }
__device__ __forceinline__ unsigned xb_xcc_id() { return (unsigned)__builtin_amdgcn_s_getreg((3 << 11) | 20) & 0xFu; }
#define XB_SPIN(cond, bar) do { unsigned _sp = 0; while (cond) { __builtin_amdgcn_s_sleep(1); \
    if ((++_sp & 255u) == 0u) { if (xb_ld(&(bar)[XB_TMO])) break; if (_sp > XB_SPIN_CAP) { atomicAdd(&(bar)[XB_TMO], 1u); break; } } } } while (0)

struct XcdBarrier {
    unsigned* bar; unsigned x;
    volatile LAS unsigned* st;
};

__device__ __forceinline__ XcdBarrier xcd_barrier_post(unsigned* bar, volatile LAS unsigned* st) {
    XcdBarrier b; b.bar = bar; b.x = xb_xcc_id(); b.st = st;
    if (threadIdx.x == 0) (void)xb_add(&bar[XB_XCNT(b.x)], 1u);
    return b;
}
__device__ __forceinline__ void xcd_barrier_complete(unsigned* bar, unsigned x, unsigned& nloc, unsigned& nx) {
    const unsigned G = gridDim.x * gridDim.y * gridDim.z;
    unsigned sum, cnt, mine, sp = 0u;
    for (;;) {
        sum = 0u; cnt = 0u; mine = 0u;
#pragma unroll
        for (unsigned j = 0; j < 16; ++j) { const unsigned c = xb_ld(&bar[XB_XCNT(j)]); sum += c; cnt += (c > 0u) ? 1u : 0u; mine = (j == x) ? c : mine; }
        if (sum == G) break;
        __builtin_amdgcn_s_sleep(1);
        if ((++sp & 255u) == 0u) { if (xb_ld(&bar[XB_TMO])) break; if (sp > XB_SPIN_CAP) { atomicAdd(&bar[XB_TMO], 1u); break; } }
    }
    nloc = mine > 0u ? mine : 1u; nx = cnt > 0u ? cnt : 1u;
}

__device__ __forceinline__ void xcd_barrier(const XcdBarrier& b) {
    asm volatile("s_waitcnt vmcnt(0)" ::: "memory");
    __syncthreads();
    if (threadIdx.x == 0) {
        unsigned* bar = b.bar;
        __builtin_amdgcn_s_waitcnt(0);
        unsigned nloc = b.st[0], nx = b.st[1];
        if (nloc == 0u) { xcd_barrier_complete(bar, b.x, nloc, nx); b.st[0] = nloc; b.st[1] = nx; }
        const unsigned old = xb_add(&bar[XB_XSUB(b.x)], 1u);
        const unsigned gen = old / nloc;
        if (old + 1u == (gen + 1u) * nloc) {
            __builtin_amdgcn_fence(__ATOMIC_RELEASE, "agent");
            asm volatile("s_waitcnt vmcnt(0)" ::: "memory");
            const unsigned og = xb_add(&bar[XB_TOP], 1u);
            const unsigned tg = og / nx;
            if (og + 1u == (tg + 1u) * nx) xb_add(&bar[XB_TOPGEN], 1u);
            else XB_SPIN(xb_ld(&bar[XB_TOPGEN]) == tg, bar);
            __builtin_amdgcn_fence(__ATOMIC_ACQUIRE, "agent");
            xb_add(&bar[XB_XGEN(b.x)], 1u);
            asm volatile("s_waitcnt vmcnt(0)" ::: "memory");
        } else {
            XB_SPIN(xb_ld(&bar[XB_XGEN(b.x)]) == gen, bar);
            __builtin_amdgcn_fence(__ATOMIC_ACQUIRE, "agent");
            asm volatile("s_waitcnt vmcnt(0)" ::: "memory");
        }
    }
    __syncthreads();
}

constexpr int NWAVES = 8, NTHR = 512;
constexpr int BATCH = 8, T = 2048, D = 1024, M = BATCH * T, NMEM = 256, MMEM = BATCH * NMEM, FF = 4096, DEPTH = 4;
constexpr int AB_IN = 2576, GDN_IN = 4112, NIN_E = 2816, NIN_O = 4096;
constexpr float EPS = 1e-6f;
enum InIdx { I_X = 0, I_MEM, I_MIX_PRE_G, I_MIX_POST_G, I_AB_W_IN, I_GK_W2, I_GK_B, I_GLA_NORM_G, I_LRU_CONV_W, I_LRU_CONV_B, I_LRU_W_A, I_LRU_B_A, I_LRU_W_X, I_LRU_B_X,
             I_LRU_LAMBDA, I_AB_W_OUT, I_GDN_W_IN, I_GDN_CONV_W, I_GDN_A_LOG, I_GDN_DT_BIAS, I_GDN_NORM_G, I_GDN_W_OUT, I_XA_PRE_G, I_XA_MEM_G, I_XA_POST_G, I_XA_W_Q,
             I_XA_W_KV, I_XA_W_O, I_MLP_PRE_G, I_MLP_POST_G, I_MLP_W1, I_MLP_W2, N_IN };

constexpr size_t MiB = 1u << 20;
constexpr size_t WS_CTL = 0, CTL_ZERO_BYTES = 65536;
constexpr size_t WS_BA = 1 * MiB;
constexpr size_t WS_W = 2 * MiB, WL_STRIDE = 31 * MiB;
constexpr size_t WO_IN = 0, WO_OUT = 8 * MiB, WO_Q = 10 * MiB, WO_O = 12 * MiB, WO_W1 = 14 * MiB, WO_W2 = 22 * MiB, WO_BA = 30 * MiB;
constexpr size_t WS_KALL = 126 * MiB, WS_VT = 142 * MiB;
constexpr size_t WS_ACT = 158 * MiB;
constexpr size_t WS_R = 190 * MiB, WS_END = 318 * MiB;
constexpr size_t WS_WK = WS_R, WS_WV = WS_R + 8 * MiB, WS_MEMN = WS_R + 16 * MiB, WS_QO = WS_R + 64 * MiB;
constexpr int CW_BAR = 4096;
constexpr int RING_BYTES = 131072, LDSCTL_OFF = RING_BYTES, MISC_OFF = LDSCTL_OFF + 320, LDS_BYTES = 147456;

struct Args { const float* in[N_IN]; float* out; unsigned char* ws; int ph_lo, ph_hi; };

__device__ __forceinline__ float wave_sum(float v) {
#pragma unroll
    for (int o = 1; o < 64; o <<= 1) v += __shfl_xor(v, o);
    return v;
}
__device__ __forceinline__ float sigmoidf_(float x) { return 1.0f / (1.0f + __expf(-x)); }
__device__ __forceinline__ float siluf_(float x) { return x / (1.0f + __expf(-x)); }
__device__ __forceinline__ float softplusf_(float x) { return fmaxf(x, 0.f) + log1pf(__expf(-fabsf(x))); }
__device__ __forceinline__ float gelu_tanh(float x) { const float u = 0.7978845608028654f * (x + 0.044715f * x * x * x); return 0.5f * x * (1.0f + tanhf(u)); }

struct Job { const float* W; int ldw, c0, ncols, k_lo, Kr; bf16* WT; int dstK, r0; const float* gain; int gmask; float sc; };
__device__ __forceinline__ bf16* wl(unsigned char* ws, int i, size_t off) { return (bf16*)(ws + WS_W + (size_t)i * WL_STRIDE + off); }
__device__ __forceinline__ void get_job(const Args& a, int jid, Job& J) {
    const int i = jid / 10, s = jid % 10, j = i >> 1; const bool even = !(i & 1);
    unsigned char* ws = a.ws;
    J.c0 = 0; J.k_lo = 0; J.Kr = 1024; J.dstK = 1024; J.r0 = 0; J.gain = nullptr; J.gmask = 1023; J.sc = 1.f; J.ncols = 1024; J.ldw = 1024; J.W = nullptr; J.WT = nullptr;
    switch (s) {
    case 0: J.W = even ? a.in[I_AB_W_IN] + (size_t)j * 1024 * AB_IN : a.in[I_GDN_W_IN] + (size_t)j * 1024 * GDN_IN; J.ldw = even ? AB_IN : GDN_IN; J.ncols = even ? 1536 : 4096;
            J.WT = wl(ws, i, WO_IN); J.gain = a.in[I_MIX_PRE_G] + i * 1024; break;
    case 1: J.W = a.in[I_AB_W_IN] + (size_t)j * 1024 * AB_IN; J.ldw = AB_IN; J.c0 = 1552; J.ncols = even ? 1024 : 0; J.WT = wl(ws, i, WO_IN); J.r0 = 1536; J.gain = a.in[I_MIX_PRE_G] + i * 1024; break;
    case 2: J.W = even ? a.in[I_AB_W_OUT] + (size_t)j * 1024 * 1024 : a.in[I_GDN_W_OUT] + (size_t)j * 1024 * 1024; J.Kr = 512; J.WT = wl(ws, i, WO_OUT);
            J.gain = even ? a.in[I_GLA_NORM_G] + j * 128 : a.in[I_GDN_NORM_G] + j * 128; J.gmask = 127; break;
    case 3: J.W = even ? a.in[I_AB_W_OUT] + (size_t)j * 1024 * 1024 : a.in[I_GDN_W_OUT] + (size_t)j * 1024 * 1024; J.k_lo = 512; J.Kr = 512; J.WT = wl(ws, i, WO_OUT);
            J.gain = even ? nullptr : a.in[I_GDN_NORM_G] + j * 128; J.gmask = 127; break;
    case 4: J.W = a.in[I_XA_W_Q] + (size_t)i * 1024 * 1024; J.WT = wl(ws, i, WO_Q); J.gain = a.in[I_XA_PRE_G] + i * 1024; J.sc = 0.0625f; break;
    case 5: J.W = a.in[I_XA_W_KV] + (size_t)i * 1024 * 2048; J.ldw = 2048; J.WT = (bf16*)(ws + WS_WK); J.r0 = i * 1024; J.gain = a.in[I_XA_MEM_G] + i * 1024; break;
    case 6: J.W = a.in[I_XA_W_KV] + (size_t)i * 1024 * 2048; J.ldw = 2048; J.c0 = 1024; J.WT = (bf16*)(ws + WS_WV); J.r0 = i * 1024; J.gain = a.in[I_XA_MEM_G] + i * 1024; break;
    case 7: J.W = a.in[I_XA_W_O] + (size_t)i * 1024 * 1024; J.WT = wl(ws, i, WO_O); break;
    case 8: J.W = a.in[I_MLP_W1] + (size_t)i * 1024 * 4096; J.ldw = 4096; J.ncols = 4096; J.WT = wl(ws, i, WO_W1); J.gain = a.in[I_MLP_PRE_G] + i * 1024; break;
    default: J.W = a.in[I_MLP_W2] + (size_t)i * 4096 * 1024; J.Kr = 4096; J.dstK = 4096; J.WT = wl(ws, i, WO_W2); break;
    }
}
__device__ __forceinline__ void transpose_item(const Job& J, LAS float* scr, int item, int lane) {
    const int nblk = J.ncols / 32, kb = item / nblk, nb = item % nblk, k0 = J.k_lo + 64 * kb, n0 = 32 * nb;
#pragma unroll 8
    for (int i = 0; i < 32; ++i) { const int kk = 2 * i + (lane >> 5); const int k = k0 + kk;
        float v = J.W[(size_t)k * J.ldw + J.c0 + n0 + (lane & 31)];
        const float g = J.gain ? J.gain[k & J.gmask] : 1.0f;
        scr[kk * 33 + (lane & 31)] = v * g * J.sc; }
    LDS_WAIT(); asm volatile("" ::: "memory");
    const int c = lane & 7;
#pragma unroll
    for (int jj = 0; jj < 4; ++jj) { const int n = (lane >> 3) + 8 * jj; const LAS float* s = scr + (8 * c) * 33 + n;
        v4u o; o.x = pk2(s[0 * 33], s[1 * 33]); o.y = pk2(s[2 * 33], s[3 * 33]); o.z = pk2(s[4 * 33], s[5 * 33]); o.w = pk2(s[6 * 33], s[7 * 33]);
        *(GAS v4u*)(J.WT + (size_t)(J.r0 + n0 + n) * J.dstK + k0 + 8 * c) = o; }
    LDS_WAIT(); asm volatile("" ::: "memory");
}
__device__ __forceinline__ void rms_row_to_bf16(const float* xrow, bf16* orow, int lane) {
    const GAS f32x4* xr = (const GAS f32x4*)xrow + lane;
    f32x4 v[4]; float s = 0.f;
#pragma unroll
    for (int j = 0; j < 4; ++j) { v[j] = xr[64 * j]; s += (v[j].x * v[j].x + v[j].y * v[j].y) + (v[j].z * v[j].z + v[j].w * v[j].w); }
    const float r = 1.0f / sqrtf(wave_sum(s) * (1.f / 1024.f) + EPS);
    GAS v2u* o8 = (GAS v2u*)orow + lane;
#pragma unroll
    for (int j = 0; j < 4; ++j) { v2u w; w.x = pk2(v[j].x * r, v[j].y * r); w.y = pk2(v[j].z * r, v[j].w * r); o8[64 * j] = w; }
}
__device__ __forceinline__ void phase_prologue(const Args& a, LAS unsigned char* lds, int bid, int G, int wave, int lane, int tid) {
    LAS float* scr = (LAS float*)(lds + wave * 16384);
    const int gw = bid * NWAVES + wave, NGW = G * NWAVES;
    {
        int jid = 0; Job J; get_job(a, 0, J); int jstart = 0, jn = (J.Kr / 64) * (J.ncols / 32);
        constexpr int NJOBS = DEPTH * 10;
        for (int it = gw;; it += NGW) {
            while (jid < NJOBS && it >= jstart + jn) { jstart += jn; ++jid; if (jid < NJOBS) { get_job(a, jid, J); jn = (J.Kr / 64) * (J.ncols / 32); } }
            if (jid >= NJOBS) break;
            transpose_item(J, scr, it - jstart, lane);
        }
    }
    for (int m = gw; m < M + MMEM; m += NGW) {
        if (m < M) rms_row_to_bf16(a.in[I_X] + (size_t)m * D, (bf16*)(a.ws + WS_ACT) + (size_t)m * D, lane);
        else rms_row_to_bf16(a.in[I_MEM] + (size_t)(m - M) * D, (bf16*)(a.ws + WS_MEMN) + (size_t)(m - M) * D, lane);
    }
    for (int it = gw; it < 2 * 256 * 16; it += NGW) {
        const int j = it / 4096, n = (it / 16) & 255, k = (it & 15) * 64 + lane, i = 2 * j;
        const float* wrow = a.in[I_AB_W_IN] + (size_t)j * 1024 * AB_IN + (size_t)k * AB_IN + 1536;
        const float* w2 = a.in[I_GK_W2] + j * 16 * 256 + n;
        float s = 0.f;
#pragma unroll
        for (int r = 0; r < 16; ++r) s += wrow[r] * w2[r * 256];
        s *= a.in[I_MIX_PRE_G][i * 1024 + k];
        wl(a.ws, i, WO_IN)[(size_t)(2560 + n) * 1024 + k] = f2bf(s);
    }
    for (int it = gw * 64 + lane; it < 2 * 16 * 1024; it += NGW * 64) {
        const int j = it / 16384, o = (it / 1024) & 15, k = it & 1023, i = 2 * j + 1;
        ((float*)wl(a.ws, i, WO_BA))[o * 1024 + k] = a.in[I_GDN_W_IN][(size_t)j * 1024 * GDN_IN + (size_t)k * GDN_IN + 4096 + o] * a.in[I_MIX_PRE_G][i * 1024 + k];
    }
    (void)tid;
}

template <bool MBF16>
__device__ __forceinline__ void phase_res(const void* mptr, const float* base, const float* gpost, float* out, bf16* xn, int gw, int NGW, int lane) {
    for (int row = gw; row < M; row += NGW) {
        f32x4 mv[4], hv[4], gv[4];
#pragma unroll
        for (int j = 0; j < 4; ++j) {
            const int idx = 4 * lane + 256 * j;
            if (MBF16) { const v2u w = *(const GAS v2u*)((const bf16*)mptr + (size_t)row * D + idx); mv[j] = (f32x4){bflo(w.x), bfhi(w.x), bflo(w.y), bfhi(w.y)}; }
            else mv[j] = *(const GAS f32x4*)((const float*)mptr + (size_t)row * D + idx);
            hv[j] = *(const GAS f32x4*)(base + (size_t)row * D + idx);
            gv[j] = *(const GAS f32x4*)(gpost + idx);
        }
        float s = 0.f;
#pragma unroll
        for (int j = 0; j < 4; ++j) s += (mv[j].x * mv[j].x + mv[j].y * mv[j].y) + (mv[j].z * mv[j].z + mv[j].w * mv[j].w);
        const float r1 = 1.0f / sqrtf(wave_sum(s) * (1.f / 1024.f) + EPS);
        float s2 = 0.f;
#pragma unroll
        for (int j = 0; j < 4; ++j) { hv[j] = hv[j] + mv[j] * gv[j] * r1; s2 += (hv[j].x * hv[j].x + hv[j].y * hv[j].y) + (hv[j].z * hv[j].z + hv[j].w * hv[j].w); }
        const float r2 = 1.0f / sqrtf(wave_sum(s2) * (1.f / 1024.f) + EPS);
#pragma unroll
        for (int j = 0; j < 4; ++j) {
            const int idx = 4 * lane + 256 * j;
            *(GAS f32x4*)(out + (size_t)row * D + idx) = hv[j];
            v2u w; w.x = pk2(hv[j].x * r2, hv[j].y * r2); w.y = pk2(hv[j].z * r2, hv[j].w * r2);
            *(GAS v2u*)(xn + (size_t)row * D + idx) = w;
        }
    }
}

__device__ __forceinline__ void phase_ba(const bf16* xn, const float* Wba, float* BA, LAS unsigned char* lds, int bid, int G, int wave, int lane, int tid) {
    LAS float* sw = (LAS float*)lds;
    for (int i = tid; i < 16 * 1024 / 4; i += NTHR) ((LAS f32x4*)sw)[i] = ((const GAS f32x4*)Wba)[i];
    __syncthreads();
    const int gw = bid * NWAVES + wave, NGW = G * NWAVES;
    for (int row = gw; row < M; row += NGW) {
        const v4u w0 = *(const GAS v4u*)(xn + (size_t)row * D + 8 * lane), w1 = *(const GAS v4u*)(xn + (size_t)row * D + 512 + 8 * lane);
        float xv[16] = {bflo(w0.x), bfhi(w0.x), bflo(w0.y), bfhi(w0.y), bflo(w0.z), bfhi(w0.z), bflo(w0.w), bfhi(w0.w),
                        bflo(w1.x), bfhi(w1.x), bflo(w1.y), bfhi(w1.y), bflo(w1.z), bfhi(w1.z), bflo(w1.w), bfhi(w1.w)};
        float res = 0.f;
#pragma unroll 1
        for (int o = 0; o < 16; ++o) {
            const LAS f32x4* p0 = (const LAS f32x4*)(sw + o * 1024 + 8 * lane); const LAS f32x4* p1 = (const LAS f32x4*)(sw + o * 1024 + 512 + 8 * lane);
            const f32x4 a0 = p0[0], a1 = p0[1], b0 = p1[0], b1 = p1[1];
            float s = xv[0] * a0.x + xv[1] * a0.y + xv[2] * a0.z + xv[3] * a0.w + xv[4] * a1.x + xv[5] * a1.y + xv[6] * a1.z + xv[7] * a1.w
                    + xv[8] * b0.x + xv[9] * b0.y + xv[10] * b0.z + xv[11] * b0.w + xv[12] * b1.x + xv[13] * b1.y + xv[14] * b1.z + xv[15] * b1.w;
            s = wave_sum(s);
            res = (lane == o) ? s : res;
        }
        if (lane < 16) BA[(size_t)row * 16 + lane] = res;
    }
    __syncthreads();
}

__device__ __forceinline__ void gla_seq_unit(const Args& a, int jl, int b, int h, const bf16* proj, bf16* mixed, LAS unsigned char* lds, int tid) {
    LAS float* sq = (LAS float*)lds; LAS float* sk = sq + 64; LAS float* se = sk + 64; LAS float* red = se + 64; LAS float* wss = red + 4 * 128;
    const int c = tid & 127, kq = tid >> 7, d0 = kq * 16, lane = tid & 63, wave = tid >> 6;
    float S[16];
#pragma unroll
    for (int i = 0; i < 16; ++i) S[i] = 0.f;
    const float gkb = (tid < 64) ? a.in[I_GK_B][jl * 256 + h * 64 + tid] : 0.f;
    const bf16* prow = proj + (size_t)b * T * NIN_E;
    bf16 nq = 0, nk = 0, ng = 0, nv, ngo = 0;
    if (tid < 64) { nq = prow[h * 64 + tid]; nk = prow[256 + h * 64 + tid]; ng = prow[2560 + h * 64 + tid]; }
    nv = prow[512 + h * 128 + c]; if (kq == 0) ngo = prow[1024 + h * 128 + c];
    for (int t = 0; t < T; ++t) {
        if (tid < 64) { const float x = bf2f(ng) + gkb; const float gk = -softplusf_(-x) * (1.f / 16.f); sq[tid] = bf2f(nq) * 0.125f; sk[tid] = bf2f(nk); se[tid] = __expf(gk); }
        const float v = bf2f(nv), go = bf2f(ngo);
        if (t + 1 < T) { const bf16* pn = prow + (size_t)(t + 1) * NIN_E;
            if (tid < 64) { nq = pn[h * 64 + tid]; nk = pn[256 + h * 64 + tid]; ng = pn[2560 + h * 64 + tid]; }
            nv = pn[512 + h * 128 + c]; if (kq == 0) ngo = pn[1024 + h * 128 + c]; }
        __syncthreads();
        float part = 0.f;
#pragma unroll
        for (int i = 0; i < 16; ++i) { S[i] = se[d0 + i] * S[i] + sk[d0 + i] * v; part += sq[d0 + i] * S[i]; }
        red[kq * 128 + c] = part;
        __syncthreads();
        float o = 0.f;
        if (kq == 0) { o = (red[c] + red[128 + c]) + (red[256 + c] + red[384 + c]); const float ss = wave_sum(o * o); if (lane == 0) wss[wave] = ss; }
        __syncthreads();
        if (kq == 0) { const float tot = wss[0] + wss[1]; const float r = 1.0f / sqrtf(tot * (1.f / 128.f) + EPS);
            mixed[(size_t)(b * T + t) * D + h * 128 + c] = f2bf(o * r * siluf_(go)); }
    }
    __syncthreads();
}
__device__ __forceinline__ void lru_seq_unit(const Args& a, int jl, int b, int n, const bf16* proj, bf16* mixed, LAS unsigned char* lds, int tid) {
    LAS float* sxr = (LAS float*)lds; LAS float* sig = sxr + 128;
    const bool act = tid < 256; const int j = tid & 127, gsel = (tid >> 7) & 1, ch = n * 128 + j;
    float w[128];
    {
        const float* wp = (gsel ? a.in[I_LRU_W_X] : a.in[I_LRU_W_A]) + ((size_t)(jl * 4 + n) * 128) * 128 + j;
#pragma unroll
        for (int i = 0; i < 128; ++i) w[i] = act ? wp[i * 128] : 0.f;
    }
    const float bias = (gsel ? a.in[I_LRU_B_X] : a.in[I_LRU_B_A])[jl * 512 + ch];
    const float cw0 = a.in[I_LRU_CONV_W][(jl * 4 + 0) * 512 + ch], cw1 = a.in[I_LRU_CONV_W][(jl * 4 + 1) * 512 + ch], cw2 = a.in[I_LRU_CONV_W][(jl * 4 + 2) * 512 + ch], cw3 = a.in[I_LRU_CONV_W][(jl * 4 + 3) * 512 + ch];
    const float cb = a.in[I_LRU_CONV_B][jl * 512 + ch];
    const float sp8 = 8.0f * softplusf_(-a.in[I_LRU_LAMBDA][jl * 512 + ch]);
    float x1 = 0.f, x2 = 0.f, x3 = 0.f, hst = 0.f;
    const bf16* prow = proj + (size_t)b * T * NIN_E;
    bf16 nx = 0, ngt = 0;
    if (tid < 128) { nx = prow[1536 + ch]; ngt = prow[2048 + ch]; }
    for (int t = 0; t < T; ++t) {
        float xr = 0.f, gate = 0.f;
        if (tid < 128) { const float x0 = bf2f(nx); gate = bf2f(ngt); xr = cw0 * x3 + cw1 * x2 + cw2 * x1 + cw3 * x0 + cb; x3 = x2; x2 = x1; x1 = x0; sxr[tid] = xr;
            if (t + 1 < T) { const bf16* pn = prow + (size_t)(t + 1) * NIN_E; nx = pn[1536 + ch]; ngt = pn[2048 + ch]; } }
        __syncthreads();
        float dot = bias;
        if (act) {
#pragma unroll
            for (int i4 = 0; i4 < 32; ++i4) { const f32x4 xv = ((const LAS f32x4*)sxr)[i4]; dot += xv.x * w[4 * i4] + xv.y * w[4 * i4 + 1] + xv.z * w[4 * i4 + 2] + xv.w * w[4 * i4 + 3]; }
        }
        const float sg = sigmoidf_(dot);
        if (act && gsel == 1) sig[j] = sg;
        __syncthreads();
        if (tid < 128) { const float ig = sig[j]; const float log_a = -sp8 * sg; const float av = __expf(log_a); const float u = sqrtf(-expm1f(2.0f * log_a)) * (ig * xr);
            hst = av * hst + u; mixed[(size_t)(b * T + t) * D + 512 + ch] = f2bf(hst * gelu_tanh(gate)); }
    }
    __syncthreads();
}
__device__ __forceinline__ void gdn_seq_unit(const Args& a, int jl, int b, int h, const bf16* proj, const float* BA, bf16* mixed, LAS unsigned char* lds, int tid) {
    LAS float* sq = (LAS float*)lds; LAS float* sk = sq + 128; LAS float* sv = sk + 128; LAS float* red = sv + 128; LAS float* red2 = red + 512; LAS float* wss = red2 + 512; LAS float* wss2 = wss + 8;
    const int c = tid & 127, kq = tid >> 7, d0 = kq * 32, lane = tid & 63, wave = tid >> 6;
    float S[32];
#pragma unroll
    for (int i = 0; i < 32; ++i) S[i] = 0.f;
    const int col = (kq < 3 ? kq : 3) * 1024 + h * 128 + c;
    float cw0 = 0.f, cw1 = 0.f, cw2 = 0.f, cw3 = 0.f;
    if (kq < 3) { const float* cwp = a.in[I_GDN_CONV_W] + (size_t)jl * 4 * 3072 + col; cw0 = cwp[0]; cw1 = cwp[3072]; cw2 = cwp[2 * 3072]; cw3 = cwp[3 * 3072]; }
    const float Aneg = -__expf(a.in[I_GDN_A_LOG][jl * 8 + h]), dtb = a.in[I_GDN_DT_BIAS][jl * 8 + h];
    float x1 = 0.f, x2 = 0.f, x3 = 0.f;
    const bf16* prow = proj + (size_t)b * T * NIN_O; const float* barow = BA + (size_t)b * T * 16;
    bf16 nx = prow[col]; float nb = barow[h], na = barow[8 + h];
    for (int t = 0; t < T; ++t) {
        const float x0 = bf2f(nx); const float beta = sigmoidf_(nb); const float eg = __expf(Aneg * softplusf_(na + dtb));
        if (t + 1 < T) { nx = prow[(size_t)(t + 1) * NIN_O + col]; nb = barow[(t + 1) * 16 + h]; na = barow[(t + 1) * 16 + 8 + h]; }
        float y = 0.f;
        if (kq < 3) { y = cw0 * x3 + cw1 * x2 + cw2 * x1 + cw3 * x0; x3 = x2; x2 = x1; x1 = x0; y = siluf_(y); }
        if (kq == 0) sq[c] = y; else if (kq == 1) sk[c] = y; else if (kq == 2) sv[c] = y;
        { const float ss = wave_sum(y * y); if (lane == 0) wss[wave] = ss; }
        __syncthreads();
        const float nqf = (1.0f / sqrtf(wss[0] + wss[1] + EPS)) * 0.08838834764831845f, nkf = 1.0f / sqrtf(wss[2] + wss[3] + EPS);
        float part = 0.f;
#pragma unroll
        for (int i = 0; i < 32; ++i) { S[i] *= eg; part += sk[d0 + i] * S[i]; }
        red[kq * 128 + c] = part * nkf;
        __syncthreads();
        const float kS = (red[c] + red[128 + c]) + (red[256 + c] + red[384 + c]);
        const float vnew = beta * (sv[c] - kS) * nkf;
        float opart = 0.f;
#pragma unroll
        for (int i = 0; i < 32; ++i) { S[i] += sk[d0 + i] * vnew; opart += sq[d0 + i] * S[i]; }
        red2[kq * 128 + c] = opart * nqf;
        __syncthreads();
        float o = 0.f;
        if (kq == 3) { o = (red2[c] + red2[128 + c]) + (red2[256 + c] + red2[384 + c]); const float ss = wave_sum(o * o); if (lane == 0) wss2[wave - 6] = ss; }
        __syncthreads();
        if (kq == 3) { const float tot = wss2[0] + wss2[1]; const float r = 1.0f / sqrtf(tot * (1.f / 128.f) + EPS);
            mixed[(size_t)(b * T + t) * D + h * 128 + c] = f2bf(o * r * siluf_(x0)); }
    }
    __syncthreads();
}

#define MFMA32(a_, b_, c_) __builtin_amdgcn_mfma_f32_32x32x16_bf16((a_), (b_), (c_), 0, 0, 0)
__device__ __forceinline__ bf16x8 pack8(const f32x16& x, int s) {
    v4u p; p.x = pk2(x[8 * s], x[8 * s + 1]); p.y = pk2(x[8 * s + 2], x[8 * s + 3]); p.z = pk2(x[8 * s + 4], x[8 * s + 5]); p.w = pk2(x[8 * s + 6], x[8 * s + 7]);
    return __builtin_bit_cast(bf16x8, p);
}
__device__ __forceinline__ void attn_unit(int l, int pm, int h, bf16* QO, const bf16* Kall, const bf16* Vt, int wave, int lane) {
    const int b = pm >> 3, r = lane & 31, hh = lane >> 5, row = pm * 256 + wave * 32 + r;
    bf16* qrow = QO + (size_t)row * D + h * 256;
    bf16x8 qf[16];
#pragma unroll
    for (int s = 0; s < 16; ++s) qf[s] = *(const GAS bf16x8*)(qrow + 16 * s + 8 * hh);
    f32x16 st[8];
    const bf16* kbase = Kall + (size_t)(b * 256 + r) * 4096 + l * 1024 + h * 256 + 8 * hh;
#pragma unroll
    for (int kb = 0; kb < 8; ++kb) {
        f32x16 acc;
#pragma unroll
        for (int i = 0; i < 16; ++i) acc[i] = 0.f;
#pragma unroll
        for (int s = 0; s < 16; ++s) { const bf16x8 kf = *(const GAS bf16x8*)(kbase + (size_t)(32 * kb) * 4096 + 16 * s); acc = MFMA32(kf, qf[s], acc); }
        st[kb] = acc;
    }
    float mx = -3.0e38f;
#pragma unroll
    for (int kb = 0; kb < 8; ++kb)
#pragma unroll
        for (int i = 0; i < 16; ++i) mx = fmaxf(mx, st[kb][i]);
    mx = fmaxf(mx, __shfl_xor(mx, 32));
    float sum = 0.f;
#pragma unroll
    for (int kb = 0; kb < 8; ++kb)
#pragma unroll
        for (int i = 0; i < 16; ++i) { const float p = __expf(st[kb][i] - mx); st[kb][i] = p; sum += p; }
    sum += __shfl_xor(sum, 32);
    const float inv = 1.0f / sum;
    bf16x8 pf[8][2];
#pragma unroll
    for (int kb = 0; kb < 8; ++kb) { pf[kb][0] = pack8(st[kb], 0); pf[kb][1] = pack8(st[kb], 1); }
    const bf16* vbase = Vt + (size_t)(l * 1024 + h * 256 + r) * MMEM + b * 256 + 4 * hh;
#pragma unroll
    for (int db = 0; db < 8; ++db) {
        f32x16 y;
#pragma unroll
        for (int i = 0; i < 16; ++i) y[i] = 0.f;
#pragma unroll
        for (int kb = 0; kb < 8; ++kb)
#pragma unroll
            for (int s = 0; s < 2; ++s) {
                const bf16* vp = vbase + (size_t)(32 * db) * MMEM + 32 * kb + 16 * s;
                const s16x4 lo = *(const GAS s16x4*)vp, hi = *(const GAS s16x4*)(vp + 8);
                const bf16x8 va = __builtin_shufflevector(lo, hi, 0, 1, 2, 3, 4, 5, 6, 7);
                y = MFMA32(va, pf[kb][s], y);
            }
#pragma unroll
        for (int g = 0; g < 4; ++g) { v2u w; w.x = pk2(y[4 * g] * inv, y[4 * g + 1] * inv); w.y = pk2(y[4 * g + 2] * inv, y[4 * g + 3] * inv);
            *(GAS v2u*)(qrow + 32 * db + 8 * g + 4 * hh) = w; }
    }
}

#ifndef EN_MASK
#define EN_MASK 0xFFFF
#endif
#define EN(k) (((EN_MASK) >> (k)) & 1)
enum Kind { K_PRO = 0, K_KV = 1, K_IN = 2, K_MIX = 3, K_OUT = 4, K_RES1 = 5, K_Q = 6, K_ATT = 7, K_O = 8, K_RES2 = 9, K_UP = 10, K_DOWN = 11, K_RES3 = 12 };
constexpr int NPH = 2 + 11 * DEPTH;

__global__ void __launch_bounds__(NTHR, 2) mk_fwd(Args a) {
    extern __shared__ __attribute__((aligned(16))) unsigned char lds_raw[];
    LAS unsigned char* lds = (LAS unsigned char*)lds_raw;
    volatile LAS unsigned* MISC = (volatile LAS unsigned*)(lds + MISC_OFF);
    const int tid0 = threadIdx.x;
    const int G = gridDim.x, bid = blockIdx.x;
    unsigned char* ws = a.ws;
    for (int u = tid0; u < (LDS_BYTES - LDSCTL_OFF) / 4; u += NTHR) ((LAS unsigned*)(lds + LDSCTL_OFF))[u] = 0u;
    __syncthreads();
    const int lo = a.ph_lo, hi = a.ph_hi;
    XcdBarrier bar; bar.bar = (unsigned*)(ws + WS_CTL) + CW_BAR; bar.x = 0; bar.st = nullptr;
    if (hi - lo > 1) bar = xcd_barrier_post((unsigned*)(ws + WS_CTL) + CW_BAR, MISC + 8);
    const int NGW = G * NWAVES;

    for (int ph = lo; ph < hi; ++ph) {
        int tid = threadIdx.x; asm volatile("" : "+v"(tid));
        const int lane = tid & 63, wave = __builtin_amdgcn_readfirstlane(tid >> 6), gw = bid * NWAVES + wave;
        int kind, l;
        if (ph == 0) { kind = K_PRO; l = 0; } else if (ph == 1) { kind = K_KV; l = 0; } else { const int r = ph - 2; l = r / 11; kind = 2 + r % 11; }
        const bool even = !(l & 1); const int jl = l >> 1;
        bf16* ACT = (bf16*)(ws + WS_ACT);
        if (EN(K_PRO) && kind == K_PRO) {
            phase_prologue(a, lds, bid, G, wave, lane, tid);
        } else if (EN(K_KV) && (kind == K_KV || kind == K_IN || kind == K_Q)) {
#ifndef NOBA
            if (kind == K_IN && !even) phase_ba(ACT, (const float*)wl(ws, l, WO_BA), (float*)(ws + WS_BA), lds, bid, G, wave, lane, tid);
#endif
            const int nrep = (kind == K_KV) ? 2 : 1;
            for (int rep = 0; rep < nrep; ++rep) {
                const bf16* A; const bf16* Bt; int Mg, Ng; bf16* O;
                if (kind == K_KV) {
                    if (rep == 0) { A = (const bf16*)(ws + WS_MEMN); Bt = (const bf16*)(ws + WS_WK); Mg = MMEM; Ng = 4096; O = (bf16*)(ws + WS_KALL); }
                    else { A = (const bf16*)(ws + WS_WV); Bt = (const bf16*)(ws + WS_MEMN); Mg = 4096; Ng = MMEM; O = (bf16*)(ws + WS_VT); }
                } else if (kind == K_IN) { A = ACT; Bt = wl(ws, l, WO_IN); Mg = M; Ng = even ? NIN_E : NIN_O; O = (bf16*)(ws + WS_R); }
                else { A = ACT; Bt = wl(ws, l, WO_Q); Mg = M; Ng = 1024; O = (bf16*)(ws + WS_QO); }
                pg8::Gemm g{A, Bt, Mg, Ng, 1024}; pg8::StaticOrder S; S.init(Mg, Ng, G, bid);
                pg8::EpiBf16A<0> E{O, Ng};
                pg8::gemm_phase<pg8::EpiBf16A<0>, pg8::StaticOrder, true, true>(lds, g, S, E);
            }
        } else if (EN(K_DOWN) && kind == K_DOWN) {
            pg8::Gemm g{(const bf16*)(ws + WS_R), wl(ws, l, WO_W2), M, 1024, FF}; pg8::StaticOrder S; S.init(M, 1024, G, bid);
            pg8::EpiBf16A<0> E{ACT, 1024};
            pg8::gemm_phase<pg8::EpiBf16A<0>, pg8::StaticOrder, true, true>(lds, g, S, E);
        } else if (EN(K_UP) && kind == K_UP) {
            pg8::Gemm g{ACT, wl(ws, l, WO_W1), M, FF, 1024}; pg8::StaticOrder S; S.init(M, FF, G, bid);
            pg8::EpiBf16A<1> E{(bf16*)(ws + WS_R), FF};
            pg8::gemm_phase<pg8::EpiBf16A<1>, pg8::StaticOrder, true, true>(lds, g, S, E);
        } else if (EN(K_OUT) && (kind == K_OUT || kind == K_O)) {
            const bf16* A = (kind == K_OUT) ? ACT : (const bf16*)(ws + WS_QO); const bf16* Bt = (kind == K_OUT) ? wl(ws, l, WO_OUT) : wl(ws, l, WO_O);
            pg8::Gemm g{A, Bt, M, 1024, 1024}; pg8::StaticOrder S; S.init(M, 1024, G, bid);
            pg8::EpiF32A E{(float*)(ws + WS_R), 1024};
            pg8::gemm_phase<pg8::EpiF32A, pg8::StaticOrder, true, true>(lds, g, S, E);
        } else if (EN(K_RES1) && (kind == K_RES1 || kind == K_RES2)) {
            const float* base = (kind == K_RES1 && l == 0) ? a.in[I_X] : a.out;
            const float* gp = ((kind == K_RES1) ? a.in[I_MIX_POST_G] : a.in[I_XA_POST_G]) + l * 1024;
            phase_res<false>(ws + WS_R, base, gp, a.out, ACT, gw, NGW, lane);
        } else if (EN(K_RES3) && kind == K_RES3) {
            phase_res<true>(ACT, a.out, a.in[I_MLP_POST_G] + l * 1024, a.out, ACT, gw, NGW, lane);
        } else if (EN(K_MIX) && kind == K_MIX) {
            const bf16* proj = (const bf16*)(ws + WS_R);
            if (even) {
                for (int u = bid; u < 64; u += G) {
                    if (u < 32) gla_seq_unit(a, jl, u >> 2, u & 3, proj, ACT, lds, tid);
                    else lru_seq_unit(a, jl, (u - 32) >> 2, (u - 32) & 3, proj, ACT, lds, tid);
                }
            } else {
                for (int u = bid; u < 64; u += G) gdn_seq_unit(a, jl, u >> 3, u & 7, proj, (const float*)(ws + WS_BA), ACT, lds, tid);
            }
        } else if (EN(K_ATT) && kind == K_ATT) {
            for (int u = bid; u < 256; u += G) attn_unit(l, u >> 2, u & 3, (bf16*)(ws + WS_QO), (const bf16*)(ws + WS_KALL), (const bf16*)(ws + WS_VT), wave, lane);
        }
        if (ph + 1 < hi) xcd_barrier(bar);
    }
}

#ifndef MK_PER_PHASE
#define MK_PER_PHASE 0
#endif
extern "C" void kernel_launch(void* const* d_in, const int* in_sizes, int n_in, void* d_out, int out_size, void* d_ws, size_t ws_size, hipStream_t stream) {
    static int grid = 0;
    if (grid == 0) {
        if (n_in != N_IN || out_size != M * D || ws_size < WS_END) { fprintf(stderr, "kernel_launch: unexpected shapes (n_in %d out %d ws %zu)\n", n_in, out_size, ws_size); grid = -1; return; }
        int dev = 0, cus = 0, per_cu = 0;
        if (hipGetDevice(&dev) != hipSuccess || hipDeviceGetAttribute(&cus, hipDeviceAttributeMultiprocessorCount, dev) != hipSuccess) { grid = -1; return; }
        if (hipFuncSetAttribute((const void*)mk_fwd, hipFuncAttributeMaxDynamicSharedMemorySize, LDS_BYTES) != hipSuccess) { fprintf(stderr, "kernel_launch: hipFuncSetAttribute failed\n"); grid = -1; return; }
        if (hipOccupancyMaxActiveBlocksPerMultiprocessor(&per_cu, (const void*)mk_fwd, NTHR, LDS_BYTES) != hipSuccess || per_cu < 1) { fprintf(stderr, "kernel_launch: occupancy query says %d blocks per CU\n", per_cu); }
        (void)hipGetLastError();
        grid = cus;
    }
    if (grid < 0) return;
    (void)in_sizes;
    if (hipMemsetAsync((char*)d_ws + WS_CTL, 0, CTL_ZERO_BYTES, stream) != hipSuccess) { fprintf(stderr, "kernel_launch: memset failed\n"); return; }
    Args a{};
    for (int i = 0; i < N_IN; ++i) a.in[i] = (const float*)d_in[i];
    a.out = (float*)d_out; a.ws = (unsigned char*)d_ws;
#if MK_PER_PHASE
    for (int ph = 0; ph < NPH; ++ph) { a.ph_lo = ph; a.ph_hi = ph + 1; hipLaunchKernelGGL(mk_fwd, dim3(grid), dim3(NTHR), LDS_BYTES, stream, a); }
#else
    a.ph_lo = 0; a.ph_hi = NPH;
    hipLaunchKernelGGL(mk_fwd, dim3(grid), dim3(NTHR), LDS_BYTES, stream, a);
#endif
}
```

```cpp
#include <hip/hip_runtime.h>
#include <cstdio>
#include <cstdint>
namespace pg8 {
#define PG8_LAS __attribute__((address_space(3)))
typedef unsigned short bf16_t;
typedef short bf16x8 __attribute__((ext_vector_type(8)));
typedef float f32x4 __attribute__((ext_vector_type(4)));
typedef unsigned u32x4 __attribute__((ext_vector_type(4)));
constexpr int BM = 256, BK = 64, HALF = 128, HTB = HALF * BK * 2  , STAGE_BYTES = 8 * HTB, NXCD = 8, WGM = 8;

__host__ __device__ __forceinline__ int lds_byte(int r, int c) { const int st = (r >> 4) * 2 + (c >> 5), rr = r & 15, cc = c & 31, ob = rr * 64 + cc * 2; return st * 1024 + (ob ^ (((ob >> 9) & 1) << 5)); }
__host__ __device__ __forceinline__ void stage_rc(int b, int& R, int& C) { const int st = b / 1024, sb = b % 1024, swz = sb ^ (((sb >> 9) & 1) << 5); R = (st >> 1) * 16 + swz / 64; C = (st & 1) * 32 + (swz % 64) / 2; }
__host__ __device__ __forceinline__ int perm32(int rho) { const int n = rho >> 4, i = rho & 15; return 8 * (i >> 2) + 4 * n + (i & 3); }

struct Unit { int pm, pn; };
struct Gemm { const bf16_t* A; const bf16_t* Bt; int M, N, K; };

struct StaticOrder {
    int nM, nN, nwg, G, c;
    __host__ __device__ void init(int M, int N, int G_, int c_) { nM = M / BM; nN = N / BM; nwg = nM * nN; G = G_; c = c_; }
    __host__ __device__ bool next(int i, Unit& u) const {
        const long L = (long)i * G + c; if (L >= nwg) return false;
        int wgid = (int)L; { const int q = nwg / NXCD, r = nwg % NXCD, xcd = wgid % NXCD, off = wgid / NXCD; wgid = (xcd < r ? xcd * (q + 1) : r * (q + 1) + (xcd - r) * q) + off; }
        const int nig = WGM * nN, gid = wgid / nig, fm = gid * WGM, gsz = (nM - fm) < WGM ? (nM - fm) : WGM;
        u.pm = fm + ((wgid % nig) % gsz); u.pn = (wgid % nig) / gsz; return true;
    }
    __device__ __forceinline__ void a_ready(const Unit&) const {}
    __device__ __forceinline__ void done(const Unit&) const {}
};

__device__ __forceinline__ unsigned cvt_pk_bf16(float lo, float hi) { unsigned r; asm volatile("v_cvt_pk_bf16_f32 %0, %1, %2" : "=v"(r) : "v"(lo), "v"(hi)); return r; }
typedef float f32x2 __attribute__((ext_vector_type(2)));
__device__ __forceinline__ f32x2 gelu_pk(f32x2 v) {
    const f32x2 av = __builtin_elementwise_abs(v), d = av * 0.2316418882f + 1.0f;
    f32x2 t; t.x = __builtin_amdgcn_rcpf(d.x); t.y = __builtin_amdgcn_rcpf(d.y);
    f32x2 q = t * 0.5307027145f + (-0.7265760135f); q = q * t + 0.7107068705f; q = q * t + (-0.142248368f); q = q * t + 0.127414796f; q = q * t;
    const f32x2 s = (v * v) * (-0.72134752044f);
    f32x2 e; e.x = __builtin_amdgcn_exp2f(s.x); e.y = __builtin_amdgcn_exp2f(s.y);
    const f32x2 m = v * (q * e), r = v - m;
    f32x2 o; o.x = v.x < 0.f ? m.x : r.x; o.y = v.y < 0.f ? m.y : r.y; return o;
}

template <int ACT  > struct EpiBf16 {
    static constexpr bool PERM = true, AFTER_DRAIN = false; static_assert(ACT == 0 || ACT == 1, "EpiBf16: ACT is 0 (none) or 1 (gelu_pk)");
    bf16_t* O; int ldc; const float* bias; int split_cols; size_t split_stride; float scale0;
    __device__ __forceinline__ void operator()(const f32x4 (&acc)[2][2][4][2], const Unit& u, int wr, int wc, int fr, int fq) const {
        const int row0 = u.pm * BM + wr * 64 + fr; int colt = u.pn * BM; bf16_t* base = O;
        float sc = 1.f; if (split_cols) { const int t = colt / split_cols; base += (size_t)t * split_stride; colt -= t * split_cols; if (t == 0) sc = scale0; }
        const int col0 = colt + wc * 32 + 8 * fq, bcol0 = u.pn * BM + wc * 32 + 8 * fq;
        f32x4 bv[2][2];
#pragma unroll
        for (int bj = 0; bj < 2; ++bj)
#pragma unroll
            for (int n = 0; n < 2; ++n) bv[bj][n] = bias ? *(const f32x4*)(bias + bcol0 + bj * HALF + 4 * n) : (f32x4){0.f, 0.f, 0.f, 0.f};
#pragma unroll
        for (int ai = 0; ai < 2; ++ai)
#pragma unroll
            for (int m = 0; m < 4; ++m) { bf16_t* rowp = base + (size_t)(row0 + ai * HALF + m * 16) * ldc + col0;
#pragma unroll
                for (int bj = 0; bj < 2; ++bj) { f32x4 v0 = acc[ai][bj][m][0] + bv[bj][0], v1 = acc[ai][bj][m][1] + bv[bj][1];
                    if (ACT == 1) { f32x2 a = gelu_pk((f32x2){v0[0], v0[1]}), b = gelu_pk((f32x2){v0[2], v0[3]}), c = gelu_pk((f32x2){v1[0], v1[1]}), d = gelu_pk((f32x2){v1[2], v1[3]});
                        v0 = (f32x4){a.x, a.y, b.x, b.y}; v1 = (f32x4){c.x, c.y, d.x, d.y}; }
                    v0 = v0 * sc; v1 = v1 * sc; u32x4 w; w.x = cvt_pk_bf16(v0[0], v0[1]); w.y = cvt_pk_bf16(v0[2], v0[3]); w.z = cvt_pk_bf16(v1[0], v1[1]); w.w = cvt_pk_bf16(v1[2], v1[3]);
                    *(u32x4*)(rowp + bj * HALF) = w; } }
    }
};

struct PanelStats {
    unsigned* xbuf;
    unsigned* cnt;
    unsigned* tmo;
    int ntn; float eps;
    unsigned code;
    __device__ __forceinline__ bool run(const f32x4 (&v)[2][2][4][2], const Unit& u, int wr, int wc, int fr, int fq, PG8_LAS unsigned char* lds, int wid, int lane) const {
        typedef float f32x2v __attribute__((ext_vector_type(2)));
        PG8_LAS f32x2v* P = (PG8_LAS f32x2v*)lds;
        PG8_LAS f32x2v* S = (PG8_LAS f32x2v*)(lds + 8192);
        PG8_LAS unsigned* flag = (PG8_LAS unsigned*)(lds + 8192 + 2048);
#pragma unroll
        for (int ai = 0; ai < 2; ++ai)
#pragma unroll
            for (int m = 0; m < 4; ++m) {
                float s = 0.f;
#pragma unroll
                for (int bj = 0; bj < 2; ++bj)
#pragma unroll
                    for (int n = 0; n < 2; ++n) { const f32x4 x = v[ai][bj][m][n]; s += (x[0] + x[1]) + (x[2] + x[3]); }
                s += __shfl_xor(s, 16); s += __shfl_xor(s, 32);
                const float mw = s * (1.0f / 64.0f); float q = 0.f;
#pragma unroll
                for (int bj = 0; bj < 2; ++bj)
#pragma unroll
                    for (int n = 0; n < 2; ++n) { const f32x4 d = v[ai][bj][m][n] - mw; q += (d[0] * d[0] + d[1] * d[1]) + (d[2] * d[2] + d[3] * d[3]); }
                q += __shfl_xor(q, 16); q += __shfl_xor(q, 32);
                if (fq == 0) P[(ai * HALF + wr * 64 + m * 16 + fr) * 4 + wc] = (f32x2v){mw, q};
            }
        asm volatile("s_waitcnt lgkmcnt(0)" ::: "memory"); __builtin_amdgcn_s_barrier(); asm volatile("" ::: "memory");
#if defined(BROKEN_EXCHANGE_NO_WAIT)
#warning BROKEN CONTROL BUILD: the row-statistics exchange does not wait; results are wrong by design
        if (blockIdx.x >= 64) { const long long t0_ = clock64(); while (clock64() - t0_ < 60000) __builtin_amdgcn_s_sleep(8); }
#endif
        const int row = wid * 32 + (lane & 31);
        if (lane < 32) {
            const f32x2v a = P[row * 4 + 0], b = P[row * 4 + 1], c = P[row * 4 + 2], d = P[row * 4 + 3];
            const float mt = (a.x + b.x + c.x + d.x) * 0.25f;
            const float da = a.x - mt, db = b.x - mt, dc = c.x - mt, dd = d.x - mt;
            const float m2 = (a.y + b.y) + (c.y + d.y) + 64.0f * ((da * da + db * db) + (dc * dc + dd * dd));
            unsigned long long* slot = (unsigned long long*)xbuf + ((size_t)(u.pm * BM + row) * 4 + u.pn);
            __hip_atomic_store(slot, ((unsigned long long)__float_as_uint(m2) << 32) | __float_as_uint(mt), __ATOMIC_RELAXED, __HIP_MEMORY_SCOPE_AGENT);
        }
        asm volatile("s_waitcnt vmcnt(0)" ::: "memory");
        if (lane == 0) __hip_atomic_fetch_add(cnt + 64 * u.pm, 1u, __ATOMIC_RELAXED, __HIP_MEMORY_SCOPE_AGENT);
        if (wid == 0) {
            bool dead = false; const unsigned long long t0 = __builtin_amdgcn_s_memrealtime(); const unsigned want = 8u * (unsigned)ntn;
            for (;;) {
#if defined(BROKEN_EXCHANGE_NO_WAIT)
                break;
#endif
                if ((unsigned)__builtin_amdgcn_readfirstlane(__hip_atomic_load(cnt + 64 * u.pm, __ATOMIC_RELAXED, __HIP_MEMORY_SCOPE_AGENT)) >= want) break;
                if (__builtin_amdgcn_s_memrealtime() - t0 > 2000000ull) {
                    if (lane == 0) { unsigned expect = 0u; __hip_atomic_compare_exchange_strong(tmo + 1, &expect, code | (unsigned)(u.pm & 0xff), __ATOMIC_RELAXED, __ATOMIC_RELAXED, __HIP_MEMORY_SCOPE_AGENT);
                                     __hip_atomic_store(tmo, 1u, __ATOMIC_RELAXED, __HIP_MEMORY_SCOPE_AGENT); }
                    dead = true; break; }
                __builtin_amdgcn_s_sleep(2);
            }
            __builtin_amdgcn_fence(__ATOMIC_ACQUIRE, "agent");
            if (lane == 0) flag[0] = dead ? 1u : 0u;
        }
        asm volatile("s_waitcnt vmcnt(0) lgkmcnt(0)" ::: "memory"); __builtin_amdgcn_s_barrier(); asm volatile("" ::: "memory");
        const bool bad = flag[0] != 0u;
        if (lane < 32) {
            const unsigned long long* slot = (const unsigned long long*)xbuf + (size_t)(u.pm * BM + row) * 4; float mt[4], m2[4]; float ms = 0.f;
#pragma unroll
            for (int t = 0; t < 4; ++t) { if (t < ntn) { const unsigned long long w = __hip_atomic_load(slot + t, __ATOMIC_RELAXED, __HIP_MEMORY_SCOPE_AGENT); mt[t] = __uint_as_float((unsigned)w); m2[t] = __uint_as_float((unsigned)(w >> 32)); } else { mt[t] = 0.f; m2[t] = 0.f; } ms += mt[t]; }
            const float mean = ms / (float)ntn; float q = 0.f;
#pragma unroll
            for (int t = 0; t < 4; ++t) if (t < ntn) { const float dm = mt[t] - mean; q += m2[t] + 256.0f * dm * dm; }
            S[row] = (f32x2v){mean, 1.0f / sqrtf(q / (256.0f * (float)ntn) + eps)};
        }
        asm volatile("s_waitcnt lgkmcnt(0)" ::: "memory"); __builtin_amdgcn_s_barrier(); asm volatile("" ::: "memory");
        return bad;
    }
};
struct EpiLnRes {
    static constexpr bool PERM = false, AFTER_DRAIN = true;
    const float* base; float* out; int ldc; const float* bias; PanelStats st; unsigned poison;
    __device__ __forceinline__ void fused(f32x4 (&acc)[2][2][4][2], const Unit& u, int wr, int wc, int fr, int fq, PG8_LAS unsigned char* lds, int wid, int lane) const {
        typedef float f32x2v __attribute__((ext_vector_type(2)));
        const PG8_LAS f32x2v* S = (const PG8_LAS f32x2v*)(lds + 8192);
        const int col0 = u.pn * BM + wc * 32 + 4 * fq;
#pragma unroll
        for (int bj = 0; bj < 2; ++bj)
#pragma unroll
            for (int n = 0; n < 2; ++n) { const f32x4 bv = bias ? *(const f32x4*)(bias + col0 + bj * HALF + n * 16) : (f32x4){0.f, 0.f, 0.f, 0.f};
#pragma unroll
                for (int ai = 0; ai < 2; ++ai)
#pragma unroll
                    for (int m = 0; m < 4; ++m) acc[ai][bj][m][n] += bv; }
        f32x4 pre[4][2][2];
#pragma unroll
        for (int m = 0; m < 4; ++m) { const size_t off = (size_t)(u.pm * BM + wr * 64 + m * 16 + fr) * ldc + col0;
#pragma unroll
            for (int bj = 0; bj < 2; ++bj)
#pragma unroll
                for (int n = 0; n < 2; ++n) pre[m][bj][n] = *(const f32x4*)(base + off + bj * HALF + n * 16); }
        const bool bad = st.run(acc, u, wr, wc, fr, fq, lds, wid, lane) || poison != 0u;
        const float qnan = __builtin_nanf("");
#pragma unroll
        for (int ai = 0; ai < 2; ++ai)
#pragma unroll
            for (int m = 0; m < 4; ++m) { const int r = ai * HALF + wr * 64 + m * 16 + fr; const f32x2v sr = S[r]; const size_t off = (size_t)(u.pm * BM + r) * ldc + col0;
#pragma unroll
                for (int bj = 0; bj < 2; ++bj)
#pragma unroll
                    for (int n = 0; n < 2; ++n) { const f32x4 bs = ai == 0 ? pre[m][bj][n] : *(const f32x4*)(base + off + bj * HALF + n * 16); f32x4 o = bs + (acc[ai][bj][m][n] - sr.x) * sr.y;
                        if (bad) o = (f32x4){qnan, qnan, qnan, qnan}; *(f32x4*)(out + off + bj * HALF + n * 16) = o; }
                if (m & 1) asm volatile("" ::: "memory"); }
    }
};
struct EpiLnResLn {
    static constexpr bool PERM = false, AFTER_DRAIN = true;
    const float* base; float* out; bf16_t* xn; int ldc; const float* bias; PanelStats st1, st2; unsigned poison;
    __device__ __forceinline__ void fused(f32x4 (&acc)[2][2][4][2], const Unit& u, int wr, int wc, int fr, int fq, PG8_LAS unsigned char* lds, int wid, int lane) const {
        typedef float f32x2v __attribute__((ext_vector_type(2))); typedef unsigned u32x2v __attribute__((ext_vector_type(2)));
        const PG8_LAS f32x2v* S = (const PG8_LAS f32x2v*)(lds + 8192);
        const int col0 = u.pn * BM + wc * 32 + 4 * fq;
#pragma unroll
        for (int bj = 0; bj < 2; ++bj)
#pragma unroll
            for (int n = 0; n < 2; ++n) { const f32x4 bv = bias ? *(const f32x4*)(bias + col0 + bj * HALF + n * 16) : (f32x4){0.f, 0.f, 0.f, 0.f};
#pragma unroll
                for (int ai = 0; ai < 2; ++ai)
#pragma unroll
                    for (int m = 0; m < 4; ++m) acc[ai][bj][m][n] += bv; }
        bool bad = st1.run(acc, u, wr, wc, fr, fq, lds, wid, lane) || poison != 0u;
        const float qnan = __builtin_nanf("");
#pragma unroll
        for (int ai = 0; ai < 2; ++ai)
#pragma unroll
            for (int m = 0; m < 4; ++m) { const int r = ai * HALF + wr * 64 + m * 16 + fr; const f32x2v sr = S[r]; const size_t off = (size_t)(u.pm * BM + r) * ldc + col0;
#pragma unroll
                for (int bj = 0; bj < 2; ++bj)
#pragma unroll
                    for (int n = 0; n < 2; ++n) { const f32x4 bs = *(const f32x4*)(base + off + bj * HALF + n * 16); acc[ai][bj][m][n] = bs + (acc[ai][bj][m][n] - sr.x) * sr.y; }
                asm volatile("" : "+v"(acc[ai][0][m][0]), "+v"(acc[ai][0][m][1]), "+v"(acc[ai][1][m][0]), "+v"(acc[ai][1][m][1]));
                if (m & 1) asm volatile("" ::: "memory"); }
        const bool bad1 = bad;
        bad = st2.run(acc, u, wr, wc, fr, fq, lds, wid, lane) || bad;
#pragma unroll
        for (int ai = 0; ai < 2; ++ai)
#pragma unroll
            for (int m = 0; m < 4; ++m) { const int r = ai * HALF + wr * 64 + m * 16 + fr; const f32x2v sr = S[r]; const size_t off = (size_t)(u.pm * BM + r) * ldc + col0;
#pragma unroll
                for (int bj = 0; bj < 2; ++bj)
#pragma unroll
                    for (int n = 0; n < 2; ++n) { const f32x4 x1 = acc[ai][bj][m][n]; *(f32x4*)(out + off + bj * HALF + n * 16) = bad1 ? (f32x4){qnan, qnan, qnan, qnan} : x1;
                        const f32x4 o = (x1 - sr.x) * sr.y; u32x2v w; w.x = cvt_pk_bf16(o[0], o[1]); w.y = cvt_pk_bf16(o[2], o[3]);
                        if (bad) { w.x = 0x7fc07fc0u; w.y = 0x7fc07fc0u; } *(u32x2v*)(xn + off + bj * HALF + n * 16) = w; }
                asm volatile("" ::: "memory"); }
    }
};

template <class Epi, class Sched, bool ALIGN_EPI = false, bool SP2 = false>
__device__ __forceinline__ void gemm_phase(PG8_LAS unsigned char* lds, const Gemm g, const Sched& S, const Epi& E) {
    int tid_ = threadIdx.x; asm volatile("" : "+v"(tid_));
    const int tid = tid_, wid = __builtin_amdgcn_readfirstlane(tid >> 6), lane = tid & 63, wr = wid >> 2, wc = wid & 3, fr = lane & 15, fq = lane >> 4;
    const int K = g.K, nt = K / BK;
    unsigned voffA[2], voffB[2];
#pragma unroll
    for (int i = 0; i < 2; ++i) { int R, C; stage_rc(tid * 16 + i * 8192, R, C); const int Rb = Epi::PERM ? ((R & ~31) + perm32(R & 31)) : R;
        voffA[i] = (unsigned)(R * K + C) * 2u; voffB[i] = (unsigned)(Rb * K + C) * 2u; }
    const size_t kstep = (size_t)(BK * 2);
    const size_t hstep = (size_t)HALF * K * 2;
    const size_t tstep = 2 * hstep;
    const unsigned ldsw = (unsigned)wid * 1024u;
    const int aoff = lds_byte(wr * 64 + fr, fq * 8), boff = lds_byte(wc * 32 + fr, fq * 8);
#define PG8_SA(b, h) (((b) * 2 + (h)) * HTB)
#define PG8_SB(b, h) ((4 + (b) * 2 + (h)) * HTB)
#define PG8_STAGE(bufoff, gbase, voff) do { _Pragma("unroll") for (int _i = 0; _i < 2; ++_i) \
        __builtin_amdgcn_global_load_lds((const unsigned*)((const char*)(gbase) + (voff)[_i]), (PG8_LAS unsigned*)(lds + (bufoff) + ldsw + _i * 8192), 16, 0, 0); } while (0)
#define PG8_LDA(dst, b, h) do { _Pragma("unroll") for (int m = 0; m < 4; ++m) _Pragma("unroll") for (int k = 0; k < 2; ++k) dst[m][k] = *(const PG8_LAS bf16x8*)(lds + PG8_SA(b, h) + aoff + m * 2048 + k * 1024); } while (0)
#define PG8_LDB(dst, b, h) do { _Pragma("unroll") for (int n = 0; n < 2; ++n) _Pragma("unroll") for (int k = 0; k < 2; ++k) dst[n][k] = *(const PG8_LAS bf16x8*)(lds + PG8_SB(b, h) + boff + n * 2048 + k * 1024); } while (0)
#define PG8_MMA(ai, bj, At, Bt) do { __builtin_amdgcn_s_setprio(1); _Pragma("unroll") for (int m = 0; m < 4; ++m) _Pragma("unroll") for (int n = 0; n < 2; ++n) _Pragma("unroll") for (int k = 0; k < 2; ++k) \
        acc[ai][bj][m][n] = __builtin_amdgcn_mfma_f32_16x16x32_bf16(Bt[n][k], At[m][k], acc[ai][bj][m][n], 0, 0, 0); __builtin_amdgcn_s_setprio(0); } while (0)
#define PG8_WAIT_V(n) asm volatile("s_waitcnt vmcnt(" #n ")" ::: "memory")
#define PG8_WAIT_L(n) asm volatile("s_waitcnt lgkmcnt(" #n ")" ::: "memory")
#define PG8_BAR __builtin_amdgcn_s_barrier()
#define PG8_SCHED __builtin_amdgcn_sched_barrier(0)
    Unit cur, nxt; int ui = 0;
    if (!S.next(0, cur)) return;
    f32x4 acc[2][2][4][2];
#pragma unroll
    for (int a = 0; a < 2; ++a)
#pragma unroll
        for (int b = 0; b < 2; ++b)
#pragma unroll
            for (int m = 0; m < 4; ++m)
#pragma unroll
                for (int n = 0; n < 2; ++n) acc[a][b][m][n] = (f32x4){0.f, 0.f, 0.f, 0.f};
    bf16x8 At[4][2], B0[2][2], B1[2][2];
    const char* cA = (const char*)g.A + (size_t)cur.pm * tstep; const char* cB = (const char*)g.Bt + (size_t)cur.pn * tstep;
    S.a_ready(cur);
    if constexpr (SP2) {
        PG8_STAGE(PG8_SB(0, 0), cB, voffB); PG8_STAGE(PG8_SB(0, 1), cB + hstep, voffB); PG8_STAGE(PG8_SA(0, 0), cA, voffA); PG8_STAGE(PG8_SA(0, 1), cA + hstep, voffA);
        if (wr == 1) PG8_BAR;
        PG8_WAIT_V(2); PG8_BAR;
        PG8_STAGE(PG8_SB(1, 0), cB + kstep, voffB); PG8_STAGE(PG8_SA(1, 0), cA + kstep, voffA); PG8_STAGE(PG8_SB(1, 1), cB + hstep + kstep, voffB);
        PG8_WAIT_V(6); PG8_BAR;
    } else {
        PG8_STAGE(PG8_SB(0, 0), cB, voffB); PG8_STAGE(PG8_SA(0, 0), cA, voffA); PG8_STAGE(PG8_SB(0, 1), cB + hstep, voffB); PG8_STAGE(PG8_SA(0, 1), cA + hstep, voffA);
        if (wr == 1) PG8_BAR;
        PG8_WAIT_V(4); PG8_BAR;
        PG8_STAGE(PG8_SB(1, 0), cB + kstep, voffB); PG8_STAGE(PG8_SA(1, 0), cA + kstep, voffA); PG8_STAGE(PG8_SB(1, 1), cB + hstep + kstep, voffB);
        PG8_WAIT_V(6); PG8_BAR;
    }
    for (;;) {
        const bool has_next = S.next(ui + 1, nxt);
        const char* nA = has_next ? (const char*)g.A + (size_t)nxt.pm * tstep : cA; const char* nB = has_next ? (const char*)g.Bt + (size_t)nxt.pn * tstep : cB;
        for (int t = 0; t < nt; t += 2) {
            const bool last = (t == nt - 2);
            const char* a1 = cA + (size_t)(t + 1) * kstep;
            const char* a2 = last ? nA : cA + (size_t)(t + 2) * kstep; const char* b2 = last ? nB : cB + (size_t)(t + 2) * kstep;
            const char* a3 = a2 + kstep; const char* b3 = b2 + kstep;
            if (last && has_next) S.a_ready(nxt);
            if constexpr (SP2) {
            PG8_LDB(B0, 0, 0); PG8_LDB(B1, 0, 1); PG8_SCHED; PG8_LDA(At, 0, 0); PG8_STAGE(PG8_SA(1, 1), a1 + hstep, voffA);
            PG8_WAIT_V(8); PG8_WAIT_L(0); PG8_BAR; PG8_MMA(0, 0, At, B0); PG8_MMA(0, 1, At, B1); PG8_BAR; PG8_SCHED;
            PG8_LDA(At, 0, 1); PG8_STAGE(PG8_SB(0, 0), b2, voffB); PG8_STAGE(PG8_SB(0, 1), b2 + hstep, voffB); PG8_STAGE(PG8_SA(0, 0), a2, voffA);
            PG8_WAIT_V(8); PG8_WAIT_L(0); PG8_BAR; PG8_MMA(1, 0, At, B0); PG8_MMA(1, 1, At, B1); PG8_BAR; PG8_SCHED;
            PG8_LDB(B0, 1, 0); PG8_LDB(B1, 1, 1); PG8_SCHED; PG8_LDA(At, 1, 0); PG8_STAGE(PG8_SA(0, 1), a2 + hstep, voffA);
            PG8_WAIT_V(8); PG8_WAIT_L(0); PG8_BAR; PG8_MMA(0, 0, At, B0); PG8_MMA(0, 1, At, B1); PG8_BAR; PG8_SCHED;
            PG8_LDA(At, 1, 1); PG8_STAGE(PG8_SB(1, 0), b3, voffB); PG8_STAGE(PG8_SB(1, 1), b3 + hstep, voffB); PG8_STAGE(PG8_SA(1, 0), a3, voffA);
            PG8_WAIT_V(8); PG8_WAIT_L(0); PG8_BAR; PG8_MMA(1, 0, At, B0); PG8_MMA(1, 1, At, B1); PG8_BAR; PG8_SCHED;
            } else {
            PG8_LDB(B0, 0, 0); PG8_SCHED; PG8_LDA(At, 0, 0); PG8_STAGE(PG8_SA(1, 1), a1 + hstep, voffA);
            PG8_WAIT_L(8); PG8_BAR; PG8_WAIT_L(0); PG8_MMA(0, 0, At, B0); PG8_BAR; PG8_SCHED;
            PG8_LDB(B1, 0, 1); PG8_STAGE(PG8_SB(0, 0), b2, voffB);
            PG8_BAR; PG8_WAIT_L(0); PG8_MMA(0, 1, At, B1); PG8_BAR;
            PG8_LDA(At, 0, 1); PG8_STAGE(PG8_SA(0, 0), a2, voffA);
            PG8_BAR; PG8_WAIT_L(0); PG8_MMA(1, 0, At, B0); PG8_BAR; PG8_SCHED;
            PG8_STAGE(PG8_SB(0, 1), b2 + hstep, voffB);
            PG8_WAIT_V(6); PG8_BAR; PG8_MMA(1, 1, At, B1); PG8_BAR;
            PG8_LDB(B0, 1, 0); PG8_SCHED; PG8_LDA(At, 1, 0); PG8_STAGE(PG8_SA(0, 1), a2 + hstep, voffA);
            PG8_WAIT_L(8); PG8_BAR; PG8_WAIT_L(0); PG8_MMA(0, 0, At, B0); PG8_BAR; PG8_SCHED;
            PG8_LDB(B1, 1, 1); PG8_STAGE(PG8_SB(1, 0), b3, voffB);
            PG8_BAR; PG8_WAIT_L(0); PG8_MMA(0, 1, At, B1); PG8_BAR;
            PG8_LDA(At, 1, 1); PG8_STAGE(PG8_SA(1, 0), a3, voffA);
            PG8_BAR; PG8_WAIT_L(0); PG8_MMA(1, 0, At, B0); PG8_BAR; PG8_SCHED;
            PG8_STAGE(PG8_SB(1, 1), b3 + hstep, voffB);
            PG8_WAIT_V(6); PG8_BAR; PG8_MMA(1, 1, At, B1); PG8_BAR;
            }
        }
        if constexpr (ALIGN_EPI) { if (wr == 0) PG8_BAR; }
        if constexpr (!Epi::AFTER_DRAIN) { E(acc, cur, wr, wc, fr, fq); S.done(cur); }
        if (!has_next) break;
#pragma unroll
        for (int a = 0; a < 2; ++a)
#pragma unroll
            for (int b = 0; b < 2; ++b)
#pragma unroll
                for (int m = 0; m < 4; ++m)
#pragma unroll
                    for (int n = 0; n < 2; ++n) acc[a][b][m][n] = (f32x4){0.f, 0.f, 0.f, 0.f};
        cur = nxt; cA = nA; cB = nB; ++ui;
        if constexpr (ALIGN_EPI) { if (wr == 1) PG8_BAR; }
    }
    PG8_WAIT_V(0);
    if constexpr (!ALIGN_EPI) { if (wr == 0) PG8_BAR; }
    PG8_BAR;
    if constexpr (Epi::AFTER_DRAIN) { E.fused(acc, cur, wr, wc, fr, fq, lds, wid, lane); S.done(cur); }
#undef PG8_SA
#undef PG8_SB
#undef PG8_STAGE
#undef PG8_LDA
#undef PG8_LDB
#undef PG8_MMA
#undef PG8_WAIT_V
#undef PG8_WAIT_L
#undef PG8_BAR
#undef PG8_SCHED
}
}

namespace pg8 {
typedef __bf16 bf16x2v __attribute__((ext_vector_type(2)));
typedef float f32x2w __attribute__((ext_vector_type(2)));
__device__ __forceinline__ unsigned pk_bf16(float lo, float hi) { f32x2w v = {lo, hi}; bf16x2v b = __builtin_convertvector(v, bf16x2v); return __builtin_bit_cast(unsigned, b); }
template <int ACT> struct EpiBf16A {
    static constexpr bool PERM = true, AFTER_DRAIN = false;
    bf16_t* O; int ldc;
    __device__ __forceinline__ void operator()(const f32x4 (&acc)[2][2][4][2], const Unit& u, int wr, int wc, int fr, int fq) const {
        const int row0 = u.pm * BM + wr * 64 + fr; const int col0 = u.pn * BM + wc * 32 + 8 * fq;
#pragma unroll
        for (int ai = 0; ai < 2; ++ai)
#pragma unroll
            for (int m = 0; m < 4; ++m) { bf16_t* rowp = O + (size_t)(row0 + ai * HALF + m * 16) * ldc + col0;
#pragma unroll
                for (int bj = 0; bj < 2; ++bj) { f32x4 v0 = acc[ai][bj][m][0], v1 = acc[ai][bj][m][1];
                    if (ACT == 1) {
#pragma unroll
                        for (int j = 0; j < 4; ++j) { const float a = fmaxf(v0[j], 0.f), b = fmaxf(v1[j], 0.f); v0[j] = a * a; v1[j] = b * b; } }
                    u32x4 w; w.x = pk_bf16(v0[0], v0[1]); w.y = pk_bf16(v0[2], v0[3]); w.z = pk_bf16(v1[0], v1[1]); w.w = pk_bf16(v1[2], v1[3]);
                    *(u32x4*)(rowp + bj * HALF) = w; } }
    }
};
struct EpiF32A {
    static constexpr bool PERM = false, AFTER_DRAIN = false;
    float* C; int ldc;
    __device__ __forceinline__ void operator()(const f32x4 (&acc)[2][2][4][2], const Unit& u, int wr, int wc, int fr, int fq) const {
        const int row0 = u.pm * BM + wr * 64 + fr, col0 = u.pn * BM + wc * 32 + 4 * fq;
#pragma unroll
        for (int ai = 0; ai < 2; ++ai)
#pragma unroll
            for (int m = 0; m < 4; ++m) { float* rowp = C + (size_t)(row0 + ai * HALF + m * 16) * ldc + col0;
#pragma unroll
                for (int bj = 0; bj < 2; ++bj)
#pragma unroll
                    for (int n = 0; n < 2; ++n) *(f32x4*)(rowp + bj * HALF + n * 16) = acc[ai][bj][m][n]; }
    }
};
}

#define GAS __attribute__((address_space(1)))
#define LAS __attribute__((address_space(3)))
typedef unsigned short bf16;
typedef unsigned v4u __attribute__((ext_vector_type(4)));
typedef unsigned v2u __attribute__((ext_vector_type(2)));
typedef float f32x4 __attribute__((ext_vector_type(4)));
typedef float f32x16 __attribute__((ext_vector_type(16)));
typedef short bf16x8 __attribute__((ext_vector_type(8)));
typedef short s16x4 __attribute__((ext_vector_type(4)));
typedef GAS unsigned gu32;
typedef GAS unsigned long long gu64;
#define RLX_AGENT __ATOMIC_RELAXED, __HIP_MEMORY_SCOPE_AGENT
#define LDS_WAIT() asm volatile("s_waitcnt lgkmcnt(0)" ::: "memory")
#define VM_WAIT() asm volatile("s_waitcnt vmcnt(0)" ::: "memory")
__device__ __forceinline__ unsigned pk2(float lo, float hi) { return pg8::pk_bf16(lo, hi); }
__device__ __forceinline__ bf16 f2bf(float f) { return (bf16)(pk2(f, 0.f) & 0xffffu); }
__device__ __forceinline__ float bf2f(bf16 h) { return __uint_as_float((unsigned)h << 16); }
__device__ __forceinline__ float bflo(unsigned w) { return __uint_as_float(w << 16); }
__device__ __forceinline__ float bfhi(unsigned w) { return __uint_as_float(w & 0xffff0000u); }

#define XB_TMO      128
#define XB_XCNT(j)  (256  + 64 * (j))
#define XB_XSUB(j)  (1280 + 64 * (j))
#define XB_XGEN(j)  (2304 + 64 * (j))
#define XB_TOP      3328
#define XB_TOPGEN   3392
#define XCD_BAR_WORDS 3456
#define XB_SPIN_CAP (1u << 18)

__device__ __forceinline__ unsigned xb_ld(unsigned* p)              { return __hip_atomic_load(p, __ATOMIC_RELAXED, __HIP_MEMORY_SCOPE_AGENT); }
__device__ __forceinline__ unsigned xb_add(unsigned* p, unsigned v) { return __hip_atomic_fetch_add(p, v, __ATOMIC_RELAXED, __HIP_MEMORY_SCOPE_AGENT); }
__device__ __forceinline__ unsigned xb_xcc_id() { return (unsigned)__builtin_amdgcn_s_getreg((3 << 11) | 20) & 0xFu; }
#define XB_SPIN(cond, bar) do { unsigned _sp = 0; while (cond) { __builtin_amdgcn_s_sleep(1); \
    if ((++_sp & 255u) == 0u) { if (xb_ld(&(bar)[XB_TMO])) break; if (_sp > XB_SPIN_CAP) { atomicAdd(&(bar)[XB_TMO], 1u); break; } } } } while (0)

struct XcdBarrier {
    unsigned* bar; unsigned x;
    volatile LAS unsigned* st;
};

__device__ __forceinline__ XcdBarrier xcd_barrier_post(unsigned* bar, volatile LAS unsigned* st) {
    XcdBarrier b; b.bar = bar; b.x = xb_xcc_id(); b.st = st;
    if (threadIdx.x == 0) (void)xb_add(&bar[XB_XCNT(b.x)], 1u);
    return b;
}
__device__ __forceinline__ void xcd_barrier_complete(unsigned* bar, unsigned x, unsigned& nloc, unsigned& nx) {
    const unsigned G = gridDim.x * gridDim.y * gridDim.z;
    unsigned sum, cnt, mine, sp = 0u;
    for (;;) {
        sum = 0u; cnt = 0u; mine = 0u;
#pragma unroll
        for (unsigned j = 0; j < 16; ++j) { const unsigned c = xb_ld(&bar[XB_XCNT(j)]); sum += c; cnt += (c > 0u) ? 1u : 0u; mine = (j == x) ? c : mine; }
        if (sum == G) break;
        __builtin_amdgcn_s_sleep(1);
        if ((++sp & 255u) == 0u) { if (xb_ld(&bar[XB_TMO])) break; if (sp > XB_SPIN_CAP) { atomicAdd(&bar[XB_TMO], 1u); break; } }
    }
    nloc = mine > 0u ? mine : 1u; nx = cnt > 0u ? cnt : 1u;
}

__device__ __forceinline__ void xcd_barrier(const XcdBarrier& b) {
    asm volatile("s_waitcnt vmcnt(0)" ::: "memory");
    __syncthreads();
    if (threadIdx.x == 0) {
        unsigned* bar = b.bar;
        __builtin_amdgcn_s_waitcnt(0);
        unsigned nloc = b.st[0], nx = b.st[1];
        if (nloc == 0u) { xcd_barrier_complete(bar, b.x, nloc, nx); b.st[0] = nloc; b.st[1] = nx; }
        const unsigned old = xb_add(&bar[XB_XSUB(b.x)], 1u);
        const unsigned gen = old / nloc;
        if (old + 1u == (gen + 1u) * nloc) {
            __builtin_amdgcn_fence(__ATOMIC_RELEASE, "agent");
            asm volatile("s_waitcnt vmcnt(0)" ::: "memory");
            const unsigned og = xb_add(&bar[XB_TOP], 1u);
            const unsigned tg = og / nx;
            if (og + 1u == (tg + 1u) * nx) xb_add(&bar[XB_TOPGEN], 1u);
            else XB_SPIN(xb_ld(&bar[XB_TOPGEN]) == tg, bar);
            __builtin_amdgcn_fence(__ATOMIC_ACQUIRE, "agent");
            xb_add(&bar[XB_XGEN(b.x)], 1u);
            asm volatile("s_waitcnt vmcnt(0)" ::: "memory");
        } else {
            XB_SPIN(xb_ld(&bar[XB_XGEN(b.x)]) == gen, bar);
            __builtin_amdgcn_fence(__ATOMIC_ACQUIRE, "agent");
            asm volatile("s_waitcnt vmcnt(0)" ::: "memory");
        }
    }
    __syncthreads();
}

constexpr int NWAVES = 8, NTHR = 512;
constexpr int BATCH = 8, T = 2048, D = 1024, M = BATCH * T, NMEM = 256, MMEM = BATCH * NMEM, FF = 4096, DEPTH = 4;
constexpr int AB_IN = 2576, GDN_IN = 4112, NIN_E = 2816, NIN_O = 4096;
constexpr float EPS = 1e-6f;
enum InIdx { I_X = 0, I_MEM, I_MIX_PRE_G, I_MIX_POST_G, I_AB_W_IN, I_GK_W2, I_GK_B, I_GLA_NORM_G, I_LRU_CONV_W, I_LRU_CONV_B, I_LRU_W_A, I_LRU_B_A, I_LRU_W_X, I_LRU_B_X,
             I_LRU_LAMBDA, I_AB_W_OUT, I_GDN_W_IN, I_GDN_CONV_W, I_GDN_A_LOG, I_GDN_DT_BIAS, I_GDN_NORM_G, I_GDN_W_OUT, I_XA_PRE_G, I_XA_MEM_G, I_XA_POST_G, I_XA_W_Q,
             I_XA_W_KV, I_XA_W_O, I_MLP_PRE_G, I_MLP_POST_G, I_MLP_W1, I_MLP_W2, N_IN };

constexpr size_t KiB = 1u << 10, MiB = 1u << 20;
constexpr size_t WS_CTL = 0, CTL_ZERO_BYTES = 65536;
constexpr size_t WS_BA = 1 * MiB;
constexpr size_t WS_SCAL = 2 * MiB;
constexpr size_t WS_HALO = 3 * MiB;
constexpr size_t WS_LRUW = 7 * MiB + 768 * KiB;
constexpr size_t WS_W = 8 * MiB + 512 * KiB;
constexpr size_t WL_E = 27 * MiB + 512 * KiB, WL_O = 30 * MiB + 128 * KiB;
constexpr size_t WS_KALL = WS_W + 2 * WL_E + 2 * WL_O;
constexpr size_t WS_VT = WS_KALL + 16 * MiB;
constexpr size_t WS_ACT = WS_VT + 16 * MiB;
constexpr size_t WS_R = WS_ACT + 32 * MiB;
constexpr size_t WS_AQK = WS_R + 128 * MiB;
constexpr size_t WS_END = WS_AQK + 16 * MiB;
constexpr size_t WS_WK = WS_R, WS_WV = WS_R + 8 * MiB, WS_MEMN = WS_R + 16 * MiB, WS_QO = WS_R + 64 * MiB;
constexpr int CW_BAR = 4096;
constexpr int RING_BYTES = 131072, LDSCTL_OFF = RING_BYTES, MISC_OFF = LDSCTL_OFF + 320, LDS_BYTES = 147456;
enum WOff { WO_IN = 0, WO_OUT, WO_Q, WO_O, WO_W1, WO_W2, WO_BA };

struct Args { const float* in[N_IN]; float* out; unsigned char* ws; int ph_lo, ph_hi; };

__device__ __forceinline__ float wave_sum(float v) {
#pragma unroll
    for (int o = 1; o < 64; o <<= 1) v += __shfl_xor(v, o);
    return v;
}
__device__ __forceinline__ float sigmoidf_(float x) { return 1.0f / (1.0f + __expf(-x)); }
__device__ __forceinline__ float siluf_(float x) { return x / (1.0f + __expf(-x)); }
__device__ __forceinline__ float softplusf_(float x) { return fmaxf(x, 0.f) + log1pf(__expf(-fabsf(x))); }
__device__ __forceinline__ float gelu_tanh(float x) { const float u = 0.7978845608028654f * (x + 0.044715f * x * x * x); return 0.5f * x * (1.0f + tanhf(u)); }

struct Job { const float* W; int ldw, c0, ncols, k_lo, Kr; bf16* WT; int dstK, r0; const float* gain; int gmask; float sc; };
__device__ __forceinline__ bf16* wl(unsigned char* ws, int i, int which) {
    const size_t lbase = WS_W + (size_t)(i >> 1) * (WL_E + WL_O) + ((i & 1) ? WL_E : 0);
    const size_t win = (i & 1) ? 8 * MiB : 5 * MiB + 512 * KiB;
    size_t off = 0;
    if (which == WO_OUT) off = win; else if (which == WO_Q) off = win + 2 * MiB; else if (which == WO_O) off = win + 4 * MiB;
    else if (which == WO_W1) off = win + 6 * MiB; else if (which == WO_W2) off = win + 14 * MiB; else if (which == WO_BA) off = win + 22 * MiB;
    return (bf16*)(ws + lbase + off);
}
__device__ __forceinline__ void get_job(const Args& a, int jid, Job& J) {
    const int i = jid / 10, s = jid % 10, j = i >> 1; const bool even = !(i & 1);
    unsigned char* ws = a.ws;
    J.c0 = 0; J.k_lo = 0; J.Kr = 1024; J.dstK = 1024; J.r0 = 0; J.gain = nullptr; J.gmask = 1023; J.sc = 1.f; J.ncols = 1024; J.ldw = 1024; J.W = nullptr; J.WT = nullptr;
    switch (s) {
    case 0: J.W = even ? a.in[I_AB_W_IN] + (size_t)j * 1024 * AB_IN : a.in[I_GDN_W_IN] + (size_t)j * 1024 * GDN_IN; J.ldw = even ? AB_IN : GDN_IN; J.ncols = even ? 1536 : 4096;
            J.WT = wl(ws, i, WO_IN); J.gain = a.in[I_MIX_PRE_G] + i * 1024; break;
    case 1: J.W = a.in[I_AB_W_IN] + (size_t)j * 1024 * AB_IN; J.ldw = AB_IN; J.c0 = 1552; J.ncols = even ? 1024 : 0; J.WT = wl(ws, i, WO_IN); J.r0 = 1536; J.gain = a.in[I_MIX_PRE_G] + i * 1024; break;
    case 2: J.W = even ? a.in[I_AB_W_OUT] + (size_t)j * 1024 * 1024 : a.in[I_GDN_W_OUT] + (size_t)j * 1024 * 1024; J.Kr = 512; J.WT = wl(ws, i, WO_OUT);
            J.gain = even ? a.in[I_GLA_NORM_G] + j * 128 : a.in[I_GDN_NORM_G] + j * 128; J.gmask = 127; break;
    case 3: J.W = even ? a.in[I_AB_W_OUT] + (size_t)j * 1024 * 1024 : a.in[I_GDN_W_OUT] + (size_t)j * 1024 * 1024; J.k_lo = 512; J.Kr = 512; J.WT = wl(ws, i, WO_OUT);
            J.gain = even ? nullptr : a.in[I_GDN_NORM_G] + j * 128; J.gmask = 127; break;
    case 4: J.W = a.in[I_XA_W_Q] + (size_t)i * 1024 * 1024; J.WT = wl(ws, i, WO_Q); J.gain = a.in[I_XA_PRE_G] + i * 1024; J.sc = 0.0625f; break;
    case 5: J.W = a.in[I_XA_W_KV] + (size_t)i * 1024 * 2048; J.ldw = 2048; J.WT = (bf16*)(ws + WS_WK); J.r0 = i * 1024; J.gain = a.in[I_XA_MEM_G] + i * 1024; break;
    case 6: J.W = a.in[I_XA_W_KV] + (size_t)i * 1024 * 2048; J.ldw = 2048; J.c0 = 1024; J.WT = (bf16*)(ws + WS_WV); J.r0 = i * 1024; J.gain = a.in[I_XA_MEM_G] + i * 1024; break;
    case 7: J.W = a.in[I_XA_W_O] + (size_t)i * 1024 * 1024; J.WT = wl(ws, i, WO_O); break;
    case 8: J.W = a.in[I_MLP_W1] + (size_t)i * 1024 * 4096; J.ldw = 4096; J.ncols = 4096; J.WT = wl(ws, i, WO_W1); J.gain = a.in[I_MLP_PRE_G] + i * 1024; break;
    default: J.W = a.in[I_MLP_W2] + (size_t)i * 4096 * 1024; J.Kr = 4096; J.dstK = 4096; J.WT = wl(ws, i, WO_W2); break;
    }
}
__device__ __forceinline__ void transpose_item(const Job& J, LAS float* scr, int item, int lane) {
    const int nblk = J.ncols / 32, kb = item / nblk, nb = item % nblk, k0 = J.k_lo + 64 * kb, n0 = 32 * nb;
#pragma unroll 8
    for (int i = 0; i < 32; ++i) { const int kk = 2 * i + (lane >> 5); const int k = k0 + kk;
        float v = J.W[(size_t)k * J.ldw + J.c0 + n0 + (lane & 31)];
        const float g = J.gain ? J.gain[k & J.gmask] : 1.0f;
        scr[kk * 33 + (lane & 31)] = v * g * J.sc; }
    LDS_WAIT(); asm volatile("" ::: "memory");
    const int c = lane & 7;
#pragma unroll
    for (int jj = 0; jj < 4; ++jj) { const int n = (lane >> 3) + 8 * jj; const LAS float* s = scr + (8 * c) * 33 + n;
        v4u o; o.x = pk2(s[0 * 33], s[1 * 33]); o.y = pk2(s[2 * 33], s[3 * 33]); o.z = pk2(s[4 * 33], s[5 * 33]); o.w = pk2(s[6 * 33], s[7 * 33]);
        *(GAS v4u*)(J.WT + (size_t)(J.r0 + n0 + n) * J.dstK + k0 + 8 * c) = o; }
    LDS_WAIT(); asm volatile("" ::: "memory");
}
__device__ __forceinline__ void rms_row_to_bf16(const float* xrow, bf16* orow, int lane) {
    const GAS f32x4* xr = (const GAS f32x4*)xrow + lane;
    f32x4 v[4]; float s = 0.f;
#pragma unroll
    for (int j = 0; j < 4; ++j) { v[j] = xr[64 * j]; s += (v[j].x * v[j].x + v[j].y * v[j].y) + (v[j].z * v[j].z + v[j].w * v[j].w); }
    const float r = 1.0f / sqrtf(wave_sum(s) * (1.f / 1024.f) + EPS);
    GAS v2u* o8 = (GAS v2u*)orow + lane;
#pragma unroll
    for (int j = 0; j < 4; ++j) { v2u w; w.x = pk2(v[j].x * r, v[j].y * r); w.y = pk2(v[j].z * r, v[j].w * r); o8[64 * j] = w; }
}
__device__ __forceinline__ void phase_prologue(const Args& a, LAS unsigned char* lds, int bid, int G, int wave, int lane, int tid) {
    LAS float* scr = (LAS float*)(lds + wave * 16384);
    const int gw = bid * NWAVES + wave, NGW = G * NWAVES;
    {
        int jid = 0; Job J; get_job(a, 0, J); int jstart = 0, jn = (J.Kr / 64) * (J.ncols / 32);
        constexpr int NJOBS = DEPTH * 10;
        for (int it = gw;; it += NGW) {
            while (jid < NJOBS && it >= jstart + jn) { jstart += jn; ++jid; if (jid < NJOBS) { get_job(a, jid, J); jn = (J.Kr / 64) * (J.ncols / 32); } }
            if (jid >= NJOBS) break;
            transpose_item(J, scr, it - jstart, lane);
        }
    }
    for (int m = gw; m < M + MMEM; m += NGW) {
        if (m < M) rms_row_to_bf16(a.in[I_X] + (size_t)m * D, (bf16*)(a.ws + WS_ACT) + (size_t)m * D, lane);
        else rms_row_to_bf16(a.in[I_MEM] + (size_t)(m - M) * D, (bf16*)(a.ws + WS_MEMN) + (size_t)(m - M) * D, lane);
    }
    for (int it = gw; it < 2 * 256 * 16; it += NGW) {
        const int j = it / 4096, n = (it / 16) & 255, k = (it & 15) * 64 + lane, i = 2 * j;
        const float* wrow = a.in[I_AB_W_IN] + (size_t)j * 1024 * AB_IN + (size_t)k * AB_IN + 1536;
        const float* w2 = a.in[I_GK_W2] + j * 16 * 256 + n;
        float s = 0.f;
#pragma unroll
        for (int r = 0; r < 16; ++r) s += wrow[r] * w2[r * 256];
        s *= a.in[I_MIX_PRE_G][i * 1024 + k];
        wl(a.ws, i, WO_IN)[(size_t)(2560 + n) * 1024 + k] = f2bf(s);
    }
    for (int it = gw * 64 + lane; it < 2 * 16 * 1024; it += NGW * 64) {
        const int j = it / 16384, o = (it / 1024) & 15, k = it & 1023, i = 2 * j + 1;
        ((float*)wl(a.ws, i, WO_BA))[o * 1024 + k] = a.in[I_GDN_W_IN][(size_t)j * 1024 * GDN_IN + (size_t)k * GDN_IN + 4096 + o] * a.in[I_MIX_PRE_G][i * 1024 + k];
    }
    (void)tid;
}

template <bool MBF16>
__device__ __forceinline__ void phase_res(const void* mptr, const float* base, const float* gpost, float* out, bf16* xn, int gw, int NGW, int lane) {
    for (int row = gw; row < M; row += NGW) {
        f32x4 mv[4], hv[4], gv[4];
#pragma unroll
        for (int j = 0; j < 4; ++j) {
            const int idx = 4 * lane + 256 * j;
            if (MBF16) { const v2u w = *(const GAS v2u*)((const bf16*)mptr + (size_t)row * D + idx); mv[j] = (f32x4){bflo(w.x), bfhi(w.x), bflo(w.y), bfhi(w.y)}; }
            else mv[j] = *(const GAS f32x4*)((const float*)mptr + (size_t)row * D + idx);
            hv[j] = *(const GAS f32x4*)(base + (size_t)row * D + idx);
            gv[j] = *(const GAS f32x4*)(gpost + idx);
        }
        float s = 0.f;
#pragma unroll
        for (int j = 0; j < 4; ++j) s += (mv[j].x * mv[j].x + mv[j].y * mv[j].y) + (mv[j].z * mv[j].z + mv[j].w * mv[j].w);
        const float r1 = 1.0f / sqrtf(wave_sum(s) * (1.f / 1024.f) + EPS);
        float s2 = 0.f;
#pragma unroll
        for (int j = 0; j < 4; ++j) { hv[j] = hv[j] + mv[j] * gv[j] * r1; s2 += (hv[j].x * hv[j].x + hv[j].y * hv[j].y) + (hv[j].z * hv[j].z + hv[j].w * hv[j].w); }
        const float r2 = 1.0f / sqrtf(wave_sum(s2) * (1.f / 1024.f) + EPS);
#pragma unroll
        for (int j = 0; j < 4; ++j) {
            const int idx = 4 * lane + 256 * j;
            *(GAS f32x4*)(out + (size_t)row * D + idx) = hv[j];
            v2u w; w.x = pk2(hv[j].x * r2, hv[j].y * r2); w.y = pk2(hv[j].z * r2, hv[j].w * r2);
            *(GAS v2u*)(xn + (size_t)row * D + idx) = w;
        }
    }
}

__device__ __forceinline__ void phase_ba(const bf16* xn, const float* Wba, float* BA, LAS unsigned char* lds, int bid, int G, int wave, int lane, int tid) {
    LAS float* sw = (LAS float*)lds;
    for (int i = tid; i < 16 * 1024 / 4; i += NTHR) ((LAS f32x4*)sw)[i] = ((const GAS f32x4*)Wba)[i];
    __syncthreads();
    const int gw = bid * NWAVES + wave, NGW = G * NWAVES;
    for (int row = gw; row < M; row += NGW) {
        const v4u w0 = *(const GAS v4u*)(xn + (size_t)row * D + 8 * lane), w1 = *(const GAS v4u*)(xn + (size_t)row * D + 512 + 8 * lane);
        float xv[16] = {bflo(w0.x), bfhi(w0.x), bflo(w0.y), bfhi(w0.y), bflo(w0.z), bfhi(w0.z), bflo(w0.w), bfhi(w0.w),
                        bflo(w1.x), bfhi(w1.x), bflo(w1.y), bfhi(w1.y), bflo(w1.z), bfhi(w1.z), bflo(w1.w), bfhi(w1.w)};
        float res = 0.f;
#pragma unroll 1
        for (int o = 0; o < 16; ++o) {
            const LAS f32x4* p0 = (const LAS f32x4*)(sw + o * 1024 + 8 * lane); const LAS f32x4* p1 = (const LAS f32x4*)(sw + o * 1024 + 512 + 8 * lane);
            const f32x4 a0 = p0[0], a1 = p0[1], b0 = p1[0], b1 = p1[1];
            float s = xv[0] * a0.x + xv[1] * a0.y + xv[2] * a0.z + xv[3] * a0.w + xv[4] * a1.x + xv[5] * a1.y + xv[6] * a1.z + xv[7] * a1.w
                    + xv[8] * b0.x + xv[9] * b0.y + xv[10] * b0.z + xv[11] * b0.w + xv[12] * b1.x + xv[13] * b1.y + xv[14] * b1.z + xv[15] * b1.w;
            s = wave_sum(s);
            res = (lane == o) ? s : res;
        }
        if (lane < 16) BA[(size_t)row * 16 + lane] = res;
    }
    __syncthreads();
}

__device__ __forceinline__ void gla_seq_unit(const Args& a, int jl, int b, int h, const bf16* proj, bf16* mixed, LAS unsigned char* lds, int tid) {
    LAS float* sq = (LAS float*)lds; LAS float* sk = sq + 64; LAS float* se = sk + 64; LAS float* red = se + 64; LAS float* wss = red + 4 * 128;
    const int c = tid & 127, kq = tid >> 7, d0 = kq * 16, lane = tid & 63, wave = tid >> 6;
    float S[16];
#pragma unroll
    for (int i = 0; i < 16; ++i) S[i] = 0.f;
    const float gkb = (tid < 64) ? a.in[I_GK_B][jl * 256 + h * 64 + tid] : 0.f;
    const bf16* prow = proj + (size_t)b * T * NIN_E;
    bf16 nq = 0, nk = 0, ng = 0, nv, ngo = 0;
    if (tid < 64) { nq = prow[h * 64 + tid]; nk = prow[256 + h * 64 + tid]; ng = prow[2560 + h * 64 + tid]; }
    nv = prow[512 + h * 128 + c]; if (kq == 0) ngo = prow[1024 + h * 128 + c];
    for (int t = 0; t < T; ++t) {
        if (tid < 64) { const float x = bf2f(ng) + gkb; const float gk = -softplusf_(-x) * (1.f / 16.f); sq[tid] = bf2f(nq) * 0.125f; sk[tid] = bf2f(nk); se[tid] = __expf(gk); }
        const float v = bf2f(nv), go = bf2f(ngo);
        if (t + 1 < T) { const bf16* pn = prow + (size_t)(t + 1) * NIN_E;
            if (tid < 64) { nq = pn[h * 64 + tid]; nk = pn[256 + h * 64 + tid]; ng = pn[2560 + h * 64 + tid]; }
            nv = pn[512 + h * 128 + c]; if (kq == 0) ngo = pn[1024 + h * 128 + c]; }
        __syncthreads();
        float part = 0.f;
#pragma unroll
        for (int i = 0; i < 16; ++i) { S[i] = se[d0 + i] * S[i] + sk[d0 + i] * v; part += sq[d0 + i] * S[i]; }
        red[kq * 128 + c] = part;
        __syncthreads();
        float o = 0.f;
        if (kq == 0) { o = (red[c] + red[128 + c]) + (red[256 + c] + red[384 + c]); const float ss = wave_sum(o * o); if (lane == 0) wss[wave] = ss; }
        __syncthreads();
        if (kq == 0) { const float tot = wss[0] + wss[1]; const float r = 1.0f / sqrtf(tot * (1.f / 128.f) + EPS);
            mixed[(size_t)(b * T + t) * D + h * 128 + c] = f2bf(o * r * siluf_(go)); }
    }
    __syncthreads();
}
__device__ __forceinline__ void lru_seq_unit(const Args& a, int jl, int b, int n, const bf16* proj, bf16* mixed, LAS unsigned char* lds, int tid) {
    LAS float* sxr = (LAS float*)lds; LAS float* sig = sxr + 128;
    const bool act = tid < 256; const int j = tid & 127, gsel = (tid >> 7) & 1, ch = n * 128 + j;
    float w[128];
    {
        const float* wp = (gsel ? a.in[I_LRU_W_X] : a.in[I_LRU_W_A]) + ((size_t)(jl * 4 + n) * 128) * 128 + j;
#pragma unroll
        for (int i = 0; i < 128; ++i) w[i] = act ? wp[i * 128] : 0.f;
    }
    const float bias = (gsel ? a.in[I_LRU_B_X] : a.in[I_LRU_B_A])[jl * 512 + ch];
    const float cw0 = a.in[I_LRU_CONV_W][(jl * 4 + 0) * 512 + ch], cw1 = a.in[I_LRU_CONV_W][(jl * 4 + 1) * 512 + ch], cw2 = a.in[I_LRU_CONV_W][(jl * 4 + 2) * 512 + ch], cw3 = a.in[I_LRU_CONV_W][(jl * 4 + 3) * 512 + ch];
    const float cb = a.in[I_LRU_CONV_B][jl * 512 + ch];
    const float sp8 = 8.0f * softplusf_(-a.in[I_LRU_LAMBDA][jl * 512 + ch]);
    float x1 = 0.f, x2 = 0.f, x3 = 0.f, hst = 0.f;
    const bf16* prow = proj + (size_t)b * T * NIN_E;
    bf16 nx = 0, ngt = 0;
    if (tid < 128) { nx = prow[1536 + ch]; ngt = prow[2048 + ch]; }
    for (int t = 0; t < T; ++t) {
        float xr = 0.f, gate = 0.f;
        if (tid < 128) { const float x0 = bf2f(nx); gate = bf2f(ngt); xr = cw0 * x3 + cw1 * x2 + cw2 * x1 + cw3 * x0 + cb; x3 = x2; x2 = x1; x1 = x0; sxr[tid] = xr;
            if (t + 1 < T) { const bf16* pn = prow + (size_t)(t + 1) * NIN_E; nx = pn[1536 + ch]; ngt = pn[2048 + ch]; } }
        __syncthreads();
        float dot = bias;
        if (act) {
#pragma unroll
            for (int i4 = 0; i4 < 32; ++i4) { const f32x4 xv = ((const LAS f32x4*)sxr)[i4]; dot += xv.x * w[4 * i4] + xv.y * w[4 * i4 + 1] + xv.z * w[4 * i4 + 2] + xv.w * w[4 * i4 + 3]; }
        }
        const float sg = sigmoidf_(dot);
        if (act && gsel == 1) sig[j] = sg;
        __syncthreads();
        if (tid < 128) { const float ig = sig[j]; const float log_a = -sp8 * sg; const float av = __expf(log_a); const float u = sqrtf(-expm1f(2.0f * log_a)) * (ig * xr);
            hst = av * hst + u; mixed[(size_t)(b * T + t) * D + 512 + ch] = f2bf(hst * gelu_tanh(gate)); }
    }
    __syncthreads();
}
__device__ __forceinline__ void gdn_seq_unit(const Args& a, int jl, int b, int h, const bf16* proj, const float* BA, bf16* mixed, LAS unsigned char* lds, int tid) {
    LAS float* sq = (LAS float*)lds; LAS float* sk = sq + 128; LAS float* sv = sk + 128; LAS float* red = sv + 128; LAS float* red2 = red + 512; LAS float* wss = red2 + 512; LAS float* wss2 = wss + 8;
    const int c = tid & 127, kq = tid >> 7, d0 = kq * 32, lane = tid & 63, wave = tid >> 6;
    float S[32];
#pragma unroll
    for (int i = 0; i < 32; ++i) S[i] = 0.f;
    const int col = (kq < 3 ? kq : 3) * 1024 + h * 128 + c;
    float cw0 = 0.f, cw1 = 0.f, cw2 = 0.f, cw3 = 0.f;
    if (kq < 3) { const float* cwp = a.in[I_GDN_CONV_W] + (size_t)jl * 4 * 3072 + col; cw0 = cwp[0]; cw1 = cwp[3072]; cw2 = cwp[2 * 3072]; cw3 = cwp[3 * 3072]; }
    const float Aneg = -__expf(a.in[I_GDN_A_LOG][jl * 8 + h]), dtb = a.in[I_GDN_DT_BIAS][jl * 8 + h];
    float x1 = 0.f, x2 = 0.f, x3 = 0.f;
    const bf16* prow = proj + (size_t)b * T * NIN_O; const float* barow = BA + (size_t)b * T * 16;
    bf16 nx = prow[col]; float nb = barow[h], na = barow[8 + h];
    for (int t = 0; t < T; ++t) {
        const float x0 = bf2f(nx); const float beta = sigmoidf_(nb); const float eg = __expf(Aneg * softplusf_(na + dtb));
        if (t + 1 < T) { nx = prow[(size_t)(t + 1) * NIN_O + col]; nb = barow[(t + 1) * 16 + h]; na = barow[(t + 1) * 16 + 8 + h]; }
        float y = 0.f;
        if (kq < 3) { y = cw0 * x3 + cw1 * x2 + cw2 * x1 + cw3 * x0; x3 = x2; x2 = x1; x1 = x0; y = siluf_(y); }
        if (kq == 0) sq[c] = y; else if (kq == 1) sk[c] = y; else if (kq == 2) sv[c] = y;
        { const float ss = wave_sum(y * y); if (lane == 0) wss[wave] = ss; }
        __syncthreads();
        const float nqf = (1.0f / sqrtf(wss[0] + wss[1] + EPS)) * 0.08838834764831845f, nkf = 1.0f / sqrtf(wss[2] + wss[3] + EPS);
        float part = 0.f;
#pragma unroll
        for (int i = 0; i < 32; ++i) { S[i] *= eg; part += sk[d0 + i] * S[i]; }
        red[kq * 128 + c] = part * nkf;
        __syncthreads();
        const float kS = (red[c] + red[128 + c]) + (red[256 + c] + red[384 + c]);
        const float vnew = beta * (sv[c] - kS) * nkf;
        float opart = 0.f;
#pragma unroll
        for (int i = 0; i < 32; ++i) { S[i] += sk[d0 + i] * vnew; opart += sq[d0 + i] * S[i]; }
        red2[kq * 128 + c] = opart * nqf;
        __syncthreads();
        float o = 0.f;
        if (kq == 3) { o = (red2[c] + red2[128 + c]) + (red2[256 + c] + red2[384 + c]); const float ss = wave_sum(o * o); if (lane == 0) wss2[wave - 6] = ss; }
        __syncthreads();
        if (kq == 3) { const float tot = wss2[0] + wss2[1]; const float r = 1.0f / sqrtf(tot * (1.f / 128.f) + EPS);
            mixed[(size_t)(b * T + t) * D + h * 128 + c] = f2bf(o * r * siluf_(x0)); }
    }
    __syncthreads();
}

#define MFMA32(a_, b_, c_) __builtin_amdgcn_mfma_f32_32x32x16_bf16((a_), (b_), (c_), 0, 0, 0)
__device__ __forceinline__ bf16x8 pack8(const f32x16& x, int s) {
    v4u p; p.x = pk2(x[8 * s], x[8 * s + 1]); p.y = pk2(x[8 * s + 2], x[8 * s + 3]); p.z = pk2(x[8 * s + 4], x[8 * s + 5]); p.w = pk2(x[8 * s + 6], x[8 * s + 7]);
    return __builtin_bit_cast(bf16x8, p);
}
__device__ __forceinline__ void attn_unit(int l, int pm, int h, bf16* QO, const bf16* Kall, const bf16* Vt, int wave, int lane) {
    const int b = pm >> 3, r = lane & 31, hh = lane >> 5, row = pm * 256 + wave * 32 + r;
    bf16* qrow = QO + (size_t)row * D + h * 256;
    bf16x8 qf[16];
#pragma unroll
    for (int s = 0; s < 16; ++s) qf[s] = *(const GAS bf16x8*)(qrow + 16 * s + 8 * hh);
    f32x16 st[8];
    const bf16* kbase = Kall + (size_t)(b * 256 + r) * 4096 + l * 1024 + h * 256 + 8 * hh;
#pragma unroll
    for (int kb = 0; kb < 8; ++kb) {
        f32x16 acc;
#pragma unroll
        for (int i = 0; i < 16; ++i) acc[i] = 0.f;
#pragma unroll
        for (int s = 0; s < 16; ++s) { const bf16x8 kf = *(const GAS bf16x8*)(kbase + (size_t)(32 * kb) * 4096 + 16 * s); acc = MFMA32(kf, qf[s], acc); }
        st[kb] = acc;
    }
    float mx = -3.0e38f;
#pragma unroll
    for (int kb = 0; kb < 8; ++kb)
#pragma unroll
        for (int i = 0; i < 16; ++i) mx = fmaxf(mx, st[kb][i]);
    mx = fmaxf(mx, __shfl_xor(mx, 32));
    float sum = 0.f;
#pragma unroll
    for (int kb = 0; kb < 8; ++kb)
#pragma unroll
        for (int i = 0; i < 16; ++i) { const float p = __expf(st[kb][i] - mx); st[kb][i] = p; sum += p; }
    sum += __shfl_xor(sum, 32);
    const float inv = 1.0f / sum;
    bf16x8 pf[8][2];
#pragma unroll
    for (int kb = 0; kb < 8; ++kb) { pf[kb][0] = pack8(st[kb], 0); pf[kb][1] = pack8(st[kb], 1); }
    const bf16* vbase = Vt + (size_t)(l * 1024 + h * 256 + r) * MMEM + b * 256 + 4 * hh;
#pragma unroll
    for (int db = 0; db < 8; ++db) {
        f32x16 y;
#pragma unroll
        for (int i = 0; i < 16; ++i) y[i] = 0.f;
#pragma unroll
        for (int kb = 0; kb < 8; ++kb)
#pragma unroll
            for (int s = 0; s < 2; ++s) {
                const bf16* vp = vbase + (size_t)(32 * db) * MMEM + 32 * kb + 16 * s;
                const s16x4 lo = *(const GAS s16x4*)vp, hi = *(const GAS s16x4*)(vp + 8);
                const bf16x8 va = __builtin_shufflevector(lo, hi, 0, 1, 2, 3, 4, 5, 6, 7);
                y = MFMA32(va, pf[kb][s], y);
            }
#pragma unroll
        for (int g = 0; g < 4; ++g) { v2u w; w.x = pk2(y[4 * g] * inv, y[4 * g + 1] * inv); w.y = pk2(y[4 * g + 2] * inv, y[4 * g + 3] * inv);
            *(GAS v2u*)(qrow + 32 * db + 8 * g + 4 * hh) = w; }
    }
}


namespace pg8 {
struct EpiGdnIn {
    static constexpr bool PERM = true, AFTER_DRAIN = false;
    bf16_t* P; bf16_t* halo;
    __device__ __forceinline__ void operator()(const f32x4 (&acc)[2][2][4][2], const Unit& u, int wr, int wc, int fr, int fq) const {
        const int row0 = u.pm * BM + wr * 64 + fr; const int t = u.pn >> 2; const int col0 = (u.pn & 3) * BM + wc * 32 + 8 * fq;
        bf16_t* base = P + (size_t)t * ((size_t)16384 * 1024);
#pragma unroll
        for (int ai = 0; ai < 2; ++ai)
#pragma unroll
            for (int m = 0; m < 4; ++m) { const int row = row0 + ai * HALF + m * 16; bf16_t* rowp = base + (size_t)row * 1024 + col0;
#pragma unroll
                for (int bj = 0; bj < 2; ++bj) { const f32x4 v0 = acc[ai][bj][m][0], v1 = acc[ai][bj][m][1];
                    u32x4 w; w.x = pk_bf16(v0[0], v0[1]); w.y = pk_bf16(v0[2], v0[3]); w.z = pk_bf16(v1[0], v1[1]); w.w = pk_bf16(v1[2], v1[3]);
                    *(u32x4*)(rowp + bj * HALF) = w;
                    if (m == 3 && t < 3 && fr >= 13) *(u32x4*)(halo + (((size_t)t * 257 + (row >> 6) + 1) * 3 + (fr - 13)) * 1024 + col0 + bj * HALF) = w; } }
    }
};
}

__device__ __forceinline__ int crow(int reg, int hh) { return (reg & 3) + 8 * (reg >> 2) + 4 * hh; }
__device__ __forceinline__ s16x4 tr4(const LAS unsigned char* img, int RS, int rowbase, int col0, int lane) {
    const int blk = (lane >> 4) & 1, q = (lane & 15) >> 2, p = lane & 3;
    return __builtin_amdgcn_ds_read_tr16_b64_v4i16((LAS s16x4*)(img + (rowbase + q) * RS + (col0 + 16 * blk + 4 * p) * 2));
}
__device__ __forceinline__ bf16x8 cat8(s16x4 lo, s16x4 hi) { return __builtin_shufflevector(lo, hi, 0, 1, 2, 3, 4, 5, 6, 7); }
__device__ __forceinline__ bf16x8 ldperm(const LAS unsigned char* p) { return cat8(*(const LAS s16x4*)p, *(const LAS s16x4*)(p + 16)); }

constexpr int RS128 = 272, RS64 = 144;
constexpr int GA_QI = 0, GA_KI = 17408, GA_RK = 34816, GA_RV = 67584, GA_MM = 100352, GA_SC = 116736;
constexpr size_t PSZ = (size_t)M * 1024;

__device__ __forceinline__ void gdn_a_unit(const Args& a, int jl, int unit, unsigned char* ws, LAS unsigned char* lds, int tid) {
    const int lane = tid & 63, wave = __builtin_amdgcn_readfirstlane(tid >> 6);
    const int b = unit >> 8, h = (unit >> 5) & 7, n = unit & 31;
    const int rowbase = b * T + n * 64, gcidx = b * 32 + n;
    bf16* Pq = (bf16*)(ws + WS_R); const bf16* halo = (const bf16*)(ws + WS_HALO);
    LAS float* SCb = (LAS float*)(lds + GA_SC); LAS float* SCg = SCb + 64;
    if (wave == 0) {
        const float* ba = (const float*)(ws + WS_BA) + (size_t)(rowbase + lane) * 16;
        const float beta = sigmoidf_(ba[h]);
        const float Aneg = -__expf(a.in[I_GDN_A_LOG][jl * 8 + h]), dtb = a.in[I_GDN_DT_BIAS][jl * 8 + h];
        float g = Aneg * softplusf_(ba[8 + h] + dtb);
#pragma unroll
        for (int o = 1; o < 64; o <<= 1) { const float v = __shfl_up(g, o); if (lane >= o) g += v; }
        const float gl = __shfl(g, 63);
        SCb[lane] = beta; SCg[lane] = g;
        float* sc = (float*)(ws + WS_SCAL) + (size_t)unit * 128; sc[lane] = __expf(g); sc[64 + lane] = __expf(gl - g);
    }
    __syncthreads();
#pragma unroll
    for (int m = 0; m < 6; ++m) {
        const int x = m >> 1, tok = (tid >> 4) + 32 * (m & 1), grp = tid & 15, col = h * 128 + grp * 8;
        const bf16* Px = Pq + (size_t)x * PSZ;
        float y[8];
#pragma unroll
        for (int c = 0; c < 8; ++c) y[c] = 0.f;
#pragma unroll
        for (int kk = 0; kk < 4; ++kk) {
            const int tt = tok - 3 + kk;
            v4u raw = {0u, 0u, 0u, 0u};
            if (tt >= 0) raw = *(const GAS v4u*)(Px + (size_t)(rowbase + tt) * 1024 + col);
            else if (n > 0) raw = *(const GAS v4u*)(halo + (((size_t)x * 257 + gcidx) * 3 + (tt + 3)) * 1024 + col);
            const float* cwp = a.in[I_GDN_CONV_W] + (size_t)(jl * 4 + kk) * 3072 + x * 1024 + col;
            const f32x4 c0 = *(const GAS f32x4*)cwp, c1 = *(const GAS f32x4*)(cwp + 4);
            y[0] += c0.x * bflo(raw.x); y[1] += c0.y * bfhi(raw.x); y[2] += c0.z * bflo(raw.y); y[3] += c0.w * bfhi(raw.y);
            y[4] += c1.x * bflo(raw.z); y[5] += c1.y * bfhi(raw.z); y[6] += c1.z * bflo(raw.w); y[7] += c1.w * bfhi(raw.w);
        }
        float ss = 0.f;
#pragma unroll
        for (int c = 0; c < 8; ++c) { y[c] = siluf_(y[c]); ss += y[c] * y[c]; }
        if (x < 2) {
            ss += __shfl_xor(ss, 1); ss += __shfl_xor(ss, 2); ss += __shfl_xor(ss, 4); ss += __shfl_xor(ss, 8);
            const float rr = (1.0f / sqrtf(ss + EPS)) * (x == 0 ? 0.08838834764831845f : 1.0f);
#pragma unroll
            for (int c = 0; c < 8; ++c) y[c] *= rr;
            v4u w; w.x = pk2(y[0], y[1]); w.y = pk2(y[2], y[3]); w.z = pk2(y[4], y[5]); w.w = pk2(y[6], y[7]);
            *(LAS v4u*)(lds + (x == 0 ? GA_QI : GA_KI) + tok * RS128 + grp * 16) = w;
        }
        if (x >= 1) {
            const float f = (x == 1) ? SCb[tok] * __expf(SCg[tok]) : SCb[tok];
            LAS f32x4* dst = (LAS f32x4*)(lds + (x == 1 ? GA_RK : GA_RV) + (tok * 128 + grp * 8) * 4);
            dst[0] = (f32x4){y[0] * f, y[1] * f, y[2] * f, y[3] * f}; dst[1] = (f32x4){y[4] * f, y[5] * f, y[6] * f, y[7] * f};
        }
    }
    __syncthreads();
    {
        const int which = wave >> 2, it = (wave >> 1) & 1, jt = wave & 1, r = lane & 31, hh = lane >> 5;
        if (!(it == 0 && jt == 1)) {
            f32x16 acc;
#pragma unroll
            for (int i = 0; i < 16; ++i) acc[i] = 0.f;
            const LAS unsigned char* Ap = lds + (which ? GA_QI : GA_KI) + (32 * it + r) * RS128 + 16 * hh;
            const LAS unsigned char* Bp = lds + GA_KI + (32 * jt + r) * RS128 + 16 * hh;
#pragma unroll
            for (int s = 0; s < 8; ++s) acc = MFMA32(*(const LAS bf16x8*)(Ap + 32 * s), *(const LAS bf16x8*)(Bp + 32 * s), acc);
            const int tj = 32 * jt + r; const float gj = SCg[tj];
            LAS float* MMp = (LAS float*)(lds + GA_MM); bf16* aq = (bf16*)(ws + WS_AQK) + (size_t)unit * 4096;
#pragma unroll
            for (int i = 0; i < 16; ++i) {
                const int ti = 32 * it + crow(i, hh); const float e = __expf(SCg[ti] - gj);
                if (which == 0) MMp[ti * 64 + tj] = (tj < ti) ? SCb[ti] * acc[i] * e : 0.f;
                else aq[ti * 64 + tj] = f2bf((tj <= ti) ? acc[i] * e : 0.f);
            }
        }
    }
    __syncthreads();
    if (wave < 4) {
        const int c = (wave & 1) * 64 + lane;
        const LAS float* rhs = (const LAS float*)(lds + (wave < 2 ? GA_RK : GA_RV)) + c;
        int zoff = 0; asm volatile("" : "+v"(zoff));
        const LAS float* MMp = (const LAS float*)(lds + GA_MM) + zoff;
        float t[64];
#pragma unroll
        for (int i = 0; i < 64; ++i) t[i] = 0.f;
#pragma unroll
        for (int i = 0; i < 64; ++i) {
            float s = rhs[i * 128];
#pragma unroll
            for (int j4 = 0; j4 < (i + 3) / 4; ++j4) { const f32x4 mq = *(const LAS f32x4*)(MMp + i * 64 + 4 * j4);
                s -= mq.x * t[4 * j4]; if (4 * j4 + 1 < i) s -= mq.y * t[4 * j4 + 1]; if (4 * j4 + 2 < i) s -= mq.z * t[4 * j4 + 2]; if (4 * j4 + 3 < i) s -= mq.w * t[4 * j4 + 3]; }
            t[i] = s;
        }
        if (wave < 2) {
            bf16* wn = (bf16*)(ws + WS_ACT) + (size_t)unit * 8192 + c;
#pragma unroll
            for (int i = 0; i < 64; ++i) wn[i * 128] = f2bf(-t[i]);
        } else {
            const int w = c >> 5, r = c & 31;
#pragma unroll
            for (int it = 0; it < 2; ++it)
#pragma unroll
                for (int hh = 0; hh < 2; ++hh) {
                    const int o = ((w * 2 + it) * 64 + hh * 32 + r) * 32;
                    unsigned char* dst = (unsigned char*)(Pq + 2 * PSZ) + ((size_t)(rowbase + (o >> 8)) * 1024 + h * 128) * 2 + (o & 255);
                    v4u w0, w1;
                    w0.x = pk2(t[32 * it + crow(0, hh)], t[32 * it + crow(1, hh)]); w0.y = pk2(t[32 * it + crow(2, hh)], t[32 * it + crow(3, hh)]);
                    w0.z = pk2(t[32 * it + crow(4, hh)], t[32 * it + crow(5, hh)]); w0.w = pk2(t[32 * it + crow(6, hh)], t[32 * it + crow(7, hh)]);
                    w1.x = pk2(t[32 * it + crow(8, hh)], t[32 * it + crow(9, hh)]); w1.y = pk2(t[32 * it + crow(10, hh)], t[32 * it + crow(11, hh)]);
                    w1.z = pk2(t[32 * it + crow(12, hh)], t[32 * it + crow(13, hh)]); w1.w = pk2(t[32 * it + crow(14, hh)], t[32 * it + crow(15, hh)]);
                    *(GAS v4u*)dst = w0; *(GAS v4u*)(dst + 16) = w1;
                }
        }
    } else {
        const int lt = tid - 256;
#pragma unroll
        for (int k = 0; k < 8; ++k) {
            const int cidx = lt + 256 * k, x = cidx >> 10, row = (cidx >> 4) & 63, ch = cidx & 15;
            const v4u v = *(const LAS v4u*)(lds + (x ? GA_KI : GA_QI) + row * RS128 + ch * 16);
            *(GAS v4u*)(Pq + (size_t)x * PSZ + (size_t)(rowbase + row) * 1024 + h * 128 + ch * 8) = v;
        }
    }
    __syncthreads();
}

constexpr int GB_QI = 0, GB_KI = 17408, GB_WI = 34816, GB_AI = 52224, GB_OB0 = 61440, GB_OB1 = 78848, GB_SC = 96256;
__device__ __forceinline__ void gdn_b_unit(int bh, unsigned char* ws, LAS unsigned char* lds, int tid) {
    const int lane = tid & 63, wave = __builtin_amdgcn_readfirstlane(tid >> 6), r = lane & 31, hh = lane >> 5;
    const int b = bh >> 3, h = bh & 7;
    bf16* Pq = (bf16*)(ws + WS_R); bf16* Pk = Pq + PSZ; bf16* Pv = Pq + 2 * PSZ; bf16* Pz = Pq + 3 * PSZ;
    const bf16* Wn = (const bf16*)(ws + WS_ACT); const bf16* Aq = (const bf16*)(ws + WS_AQK); const float* Sc = (const float*)(ws + WS_SCAL);
    const bool comp = wave < 4;
    const int lt = tid & 255;
    f32x16 S[4];
#pragma unroll
    for (int dt = 0; dt < 4; ++dt)
#pragma unroll
        for (int i = 0; i < 16; ++i) S[dt][i] = 0.f;
    v4u pq[4], pk[4], pw[4], pa[2], zc[4], zn[4]; f32x4 psc = {0.f, 0.f, 0.f, 0.f};
#define GB_LOAD(nn) do { const int un_ = bh * 32 + (nn); const size_t rb_ = (size_t)(b * T + (nn) * 64); \
        _Pragma("unroll") for (int k = 0; k < 4; ++k) { const int ci = lt + 256 * k, row = ci >> 4, ch = ci & 15; \
            pq[k] = *(const GAS v4u*)(Pq + (rb_ + row) * 1024 + h * 128 + ch * 8); pk[k] = *(const GAS v4u*)(Pk + (rb_ + row) * 1024 + h * 128 + ch * 8); \
            pw[k] = *(const GAS v4u*)(Wn + (size_t)un_ * 8192 + row * 128 + ch * 8); } \
        _Pragma("unroll") for (int k = 0; k < 2; ++k) { const int ci = lt + 256 * k, row = ci >> 3, ch = ci & 7; pa[k] = *(const GAS v4u*)(Aq + (size_t)un_ * 4096 + row * 64 + ch * 8); } \
        if (lt < 32) psc = *(const GAS f32x4*)(Sc + (size_t)un_ * 128 + lt * 4); } while (0)
#define GB_STORE() do { \
        _Pragma("unroll") for (int k = 0; k < 4; ++k) { const int ci = lt + 256 * k, row = ci >> 4, ch = ci & 15; \
            *(LAS v4u*)(lds + GB_QI + row * RS128 + ch * 16) = pq[k]; *(LAS v4u*)(lds + GB_KI + row * RS128 + ch * 16) = pk[k]; *(LAS v4u*)(lds + GB_WI + row * RS128 + ch * 16) = pw[k]; } \
        _Pragma("unroll") for (int k = 0; k < 2; ++k) { const int ci = lt + 256 * k, row = ci >> 3, ch = ci & 7; *(LAS v4u*)(lds + GB_AI + row * RS64 + ch * 16) = pa[k]; } \
        if (lt < 32) *(LAS f32x4*)(lds + GB_SC + lt * 16) = psc; } while (0)
#define GB_LOADZ(dst, nn) do { const bf16* zp_ = Pz + (size_t)(b * T + (nn) * 64 + (lt >> 2)) * 1024 + h * 128 + (lt & 3) * 32; \
        _Pragma("unroll") for (int k = 0; k < 4; ++k) dst[k] = *(const GAS v4u*)(zp_ + 8 * k); } while (0)
#define GB_EPI(zr, nn) do { const int tok_ = lt >> 2, qt_ = lt & 3; const LAS unsigned char* ob_ = lds + (((nn) & 1) ? GB_OB1 : GB_OB0) + tok_ * RS128 + qt_ * 64; \
        v4u ov_[4]; float ss_ = 0.f; \
        _Pragma("unroll") for (int k = 0; k < 4; ++k) { ov_[k] = *(const LAS v4u*)(ob_ + 16 * k); \
            ss_ += bflo(ov_[k].x) * bflo(ov_[k].x) + bfhi(ov_[k].x) * bfhi(ov_[k].x) + bflo(ov_[k].y) * bflo(ov_[k].y) + bfhi(ov_[k].y) * bfhi(ov_[k].y) \
                 + bflo(ov_[k].z) * bflo(ov_[k].z) + bfhi(ov_[k].z) * bfhi(ov_[k].z) + bflo(ov_[k].w) * bflo(ov_[k].w) + bfhi(ov_[k].w) * bfhi(ov_[k].w); } \
        ss_ += __shfl_xor(ss_, 1); ss_ += __shfl_xor(ss_, 2); \
        const float rr_ = 1.0f / sqrtf(ss_ * (1.f / 128.f) + EPS); \
        bf16* op_ = Pz + (size_t)(b * T + (nn) * 64 + tok_) * 1024 + h * 128 + qt_ * 32; \
        _Pragma("unroll") for (int k = 0; k < 4; ++k) { v4u w_; \
            w_.x = pk2(bflo(ov_[k].x) * rr_ * siluf_(bflo(zr[k].x)), bfhi(ov_[k].x) * rr_ * siluf_(bfhi(zr[k].x))); \
            w_.y = pk2(bflo(ov_[k].y) * rr_ * siluf_(bflo(zr[k].y)), bfhi(ov_[k].y) * rr_ * siluf_(bfhi(zr[k].y))); \
            w_.z = pk2(bflo(ov_[k].z) * rr_ * siluf_(bflo(zr[k].z)), bfhi(ov_[k].z) * rr_ * siluf_(bfhi(zr[k].z))); \
            w_.w = pk2(bflo(ov_[k].w) * rr_ * siluf_(bflo(zr[k].w)), bfhi(ov_[k].w) * rr_ * siluf_(bfhi(zr[k].w))); \
            *(GAS v4u*)(op_ + 8 * k) = w_; } } while (0)
    if (comp) {
        for (int n = 0; n < 32; ++n) {
            __syncthreads();
            const int w = wave;
            bf16x8 Sb[4][2];
#pragma unroll
            for (int dt = 0; dt < 4; ++dt) { Sb[dt][0] = pack8(S[dt], 0); Sb[dt][1] = pack8(S[dt], 1); }
            f32x16 Vn[2];
#pragma unroll
            for (int it = 0; it < 2; ++it) {
                const int o = ((w * 2 + it) * 64 + lane) * 32;
                const unsigned char* up = (const unsigned char*)Pv + ((size_t)(b * T + n * 64 + (o >> 8)) * 1024 + h * 128) * 2 + (o & 255);
                const v4u u0 = *(const GAS v4u*)up, u1 = *(const GAS v4u*)(up + 16);
                Vn[it][0] = bflo(u0.x); Vn[it][1] = bfhi(u0.x); Vn[it][2] = bflo(u0.y); Vn[it][3] = bfhi(u0.y); Vn[it][4] = bflo(u0.z); Vn[it][5] = bfhi(u0.z); Vn[it][6] = bflo(u0.w); Vn[it][7] = bfhi(u0.w);
                Vn[it][8] = bflo(u1.x); Vn[it][9] = bfhi(u1.x); Vn[it][10] = bflo(u1.y); Vn[it][11] = bfhi(u1.y); Vn[it][12] = bflo(u1.z); Vn[it][13] = bfhi(u1.z); Vn[it][14] = bflo(u1.w); Vn[it][15] = bfhi(u1.w);
            }
#pragma unroll
            for (int it = 0; it < 2; ++it)
#pragma unroll
                for (int dt = 0; dt < 4; ++dt)
#pragma unroll
                    for (int s = 0; s < 2; ++s) Vn[it] = MFMA32(ldperm(lds + GB_WI + (32 * it + r) * RS128 + (32 * dt + 16 * s + 4 * hh) * 2), Sb[dt][s], Vn[it]);
            const LAS float* scp = (const LAS float*)(lds + GB_SC);
            bf16x8 Vb[2][2], Vb2[2][2];
#pragma unroll
            for (int it = 0; it < 2; ++it) {
                Vb[it][0] = pack8(Vn[it], 0); Vb[it][1] = pack8(Vn[it], 1);
                f32x16 vs;
#pragma unroll
                for (int g = 0; g < 4; ++g) { const f32x4 e4 = *(const LAS f32x4*)(scp + 64 + 32 * it + 8 * g + 4 * hh);
                    vs[4 * g] = Vn[it][4 * g] * e4.x; vs[4 * g + 1] = Vn[it][4 * g + 1] * e4.y; vs[4 * g + 2] = Vn[it][4 * g + 2] * e4.z; vs[4 * g + 3] = Vn[it][4 * g + 3] * e4.w; }
                Vb2[it][0] = pack8(vs, 0); Vb2[it][1] = pack8(vs, 1);
            }
            LAS unsigned char* ob = lds + ((n & 1) ? GB_OB1 : GB_OB0);
#pragma unroll
            for (int it = 0; it < 2; ++it) {
                f32x16 O;
#pragma unroll
                for (int i = 0; i < 16; ++i) O[i] = 0.f;
#pragma unroll
                for (int dt = 0; dt < 4; ++dt)
#pragma unroll
                    for (int s = 0; s < 2; ++s) O = MFMA32(ldperm(lds + GB_QI + (32 * it + r) * RS128 + (32 * dt + 16 * s + 4 * hh) * 2), Sb[dt][s], O);
#pragma unroll
                for (int g = 0; g < 4; ++g) { const f32x4 e4 = *(const LAS f32x4*)(scp + 32 * it + 8 * g + 4 * hh);
                    O[4 * g] *= e4.x; O[4 * g + 1] *= e4.y; O[4 * g + 2] *= e4.z; O[4 * g + 3] *= e4.w; }
#pragma unroll
                for (int jt = 0; jt <= it; ++jt)
#pragma unroll
                    for (int s = 0; s < 2; ++s) O = MFMA32(ldperm(lds + GB_AI + (32 * it + r) * RS64 + (32 * jt + 16 * s + 4 * hh) * 2), Vb[jt][s], O);
#pragma unroll
                for (int i = 0; i < 16; ++i) *(LAS bf16*)(ob + (32 * it + crow(i, hh)) * RS128 + (32 * w + r) * 2) = f2bf(O[i]);
            }
            const float decay = scp[63];
#pragma unroll
            for (int dt = 0; dt < 4; ++dt) {
#pragma unroll
                for (int i = 0; i < 16; ++i) S[dt][i] *= decay;
#pragma unroll
                for (int it = 0; it < 2; ++it)
#pragma unroll
                    for (int s = 0; s < 2; ++s) {
                        const int rowb = 32 * it + 16 * s + 4 * hh;
                        S[dt] = MFMA32(cat8(tr4(lds + GB_KI, RS128, rowb, 32 * dt, lane), tr4(lds + GB_KI, RS128, rowb + 8, 32 * dt, lane)), Vb2[it][s], S[dt]);
                    }
            }
            __syncthreads();
        }
    } else {
#pragma unroll
        for (int k = 0; k < 4; ++k) zn[k] = (v4u){0u, 0u, 0u, 0u};
        GB_LOAD(0); GB_STORE();
        for (int n = 0; n < 32; ++n) {
            __syncthreads();
#pragma unroll
            for (int k = 0; k < 4; ++k) zc[k] = zn[k];
            if (n + 1 < 32) GB_LOAD(n + 1);
            GB_LOADZ(zn, n);
            if (n >= 1) GB_EPI(zc, n - 1);
            __syncthreads();
            if (n + 1 < 32) GB_STORE();
        }
    }
    __syncthreads();
    if (!comp) GB_EPI(zn, 31);
    __syncthreads();
#undef GB_LOAD
#undef GB_STORE
#undef GB_LOADZ
#undef GB_EPI
}
#ifndef EN_MASK
#define EN_MASK 0xFFFF
#endif
#define EN(k) (((EN_MASK) >> (k)) & 1)
enum Kind { K_PRO = 0, K_KV = 1, K_IN = 2, K_MIXA = 3, K_MIXB = 4, K_OUT = 5, K_RES1 = 6, K_Q = 7, K_ATT = 8, K_O = 9, K_RES2 = 10, K_UP = 11, K_DOWN = 12, K_RES3 = 13 };
constexpr int PPL = 12, NPH = 2 + PPL * DEPTH;

__global__ void __launch_bounds__(NTHR, 2) mk_fwd(Args a) {
    extern __shared__ __attribute__((aligned(16))) unsigned char lds_raw[];
    LAS unsigned char* lds = (LAS unsigned char*)lds_raw;
    volatile LAS unsigned* MISC = (volatile LAS unsigned*)(lds + MISC_OFF);
    const int tid0 = threadIdx.x;
    const int G = gridDim.x, bid = blockIdx.x;
    unsigned char* ws = a.ws;
    for (int u = tid0; u < (LDS_BYTES - LDSCTL_OFF) / 4; u += NTHR) ((LAS unsigned*)(lds + LDSCTL_OFF))[u] = 0u;
    __syncthreads();
    const int lo = a.ph_lo, hi = a.ph_hi;
    XcdBarrier bar; bar.bar = (unsigned*)(ws + WS_CTL) + CW_BAR; bar.x = 0; bar.st = nullptr;
    if (hi - lo > 1) bar = xcd_barrier_post((unsigned*)(ws + WS_CTL) + CW_BAR, MISC + 8);
    const int NGW = G * NWAVES;

    for (int ph = lo; ph < hi; ++ph) {
        int tid = threadIdx.x; asm volatile("" : "+v"(tid));
        const int lane = tid & 63, wave = __builtin_amdgcn_readfirstlane(tid >> 6), gw = bid * NWAVES + wave;
        int kind, l;
        if (ph == 0) { kind = K_PRO; l = 0; } else if (ph == 1) { kind = K_KV; l = 0; } else { const int r = ph - 2; l = r / PPL; kind = 2 + r % PPL; }
        const bool even = !(l & 1); const int jl = l >> 1;
        bf16* ACT = (bf16*)(ws + WS_ACT);
        if (EN(K_PRO) && kind == K_PRO) {
            phase_prologue(a, lds, bid, G, wave, lane, tid);
        } else if (EN(K_IN) && kind == K_IN && !even) {
            phase_ba(ACT, (const float*)wl(ws, l, WO_BA), (float*)(ws + WS_BA), lds, bid, G, wave, lane, tid);
            pg8::Gemm g{ACT, wl(ws, l, WO_IN), M, NIN_O, 1024}; pg8::StaticOrder S; S.init(M, NIN_O, G, bid);
            pg8::EpiGdnIn E{(bf16*)(ws + WS_R), (bf16*)(ws + WS_HALO)};
            pg8::gemm_phase<pg8::EpiGdnIn, pg8::StaticOrder, true, true>(lds, g, S, E);
        } else if (EN(K_KV) && (kind == K_KV || kind == K_IN || kind == K_Q)) {
            const int nrep = (kind == K_KV) ? 2 : 1;
            for (int rep = 0; rep < nrep; ++rep) {
                const bf16* A; const bf16* Bt; int Mg, Ng; bf16* O;
                if (kind == K_KV) {
                    if (rep == 0) { A = (const bf16*)(ws + WS_MEMN); Bt = (const bf16*)(ws + WS_WK); Mg = MMEM; Ng = 4096; O = (bf16*)(ws + WS_KALL); }
                    else { A = (const bf16*)(ws + WS_WV); Bt = (const bf16*)(ws + WS_MEMN); Mg = 4096; Ng = MMEM; O = (bf16*)(ws + WS_VT); }
                } else if (kind == K_IN) { A = ACT; Bt = wl(ws, l, WO_IN); Mg = M; Ng = NIN_E; O = (bf16*)(ws + WS_R); }
                else { A = ACT; Bt = wl(ws, l, WO_Q); Mg = M; Ng = 1024; O = (bf16*)(ws + WS_QO); }
                pg8::Gemm g{A, Bt, Mg, Ng, 1024}; pg8::StaticOrder S; S.init(Mg, Ng, G, bid);
                pg8::EpiBf16A<0> E{O, Ng};
                pg8::gemm_phase<pg8::EpiBf16A<0>, pg8::StaticOrder, true, true>(lds, g, S, E);
            }
        } else if (EN(K_DOWN) && kind == K_DOWN) {
            pg8::Gemm g{(const bf16*)(ws + WS_R), wl(ws, l, WO_W2), M, 1024, FF}; pg8::StaticOrder S; S.init(M, 1024, G, bid);
            pg8::EpiBf16A<0> E{ACT, 1024};
            pg8::gemm_phase<pg8::EpiBf16A<0>, pg8::StaticOrder, true, true>(lds, g, S, E);
        } else if (EN(K_UP) && kind == K_UP) {
            pg8::Gemm g{ACT, wl(ws, l, WO_W1), M, FF, 1024}; pg8::StaticOrder S; S.init(M, FF, G, bid);
            pg8::EpiBf16A<1> E{(bf16*)(ws + WS_R), FF};
            pg8::gemm_phase<pg8::EpiBf16A<1>, pg8::StaticOrder, true, true>(lds, g, S, E);
        } else if (EN(K_OUT) && (kind == K_OUT || kind == K_O)) {
            const bf16* A = (kind == K_OUT) ? (even ? ACT : (const bf16*)(ws + WS_R) + 3 * PSZ) : (const bf16*)(ws + WS_QO); const bf16* Bt = (kind == K_OUT) ? wl(ws, l, WO_OUT) : wl(ws, l, WO_O);
            pg8::Gemm g{A, Bt, M, 1024, 1024}; pg8::StaticOrder S; S.init(M, 1024, G, bid);
            pg8::EpiF32A E{(float*)(ws + WS_R), 1024};
            pg8::gemm_phase<pg8::EpiF32A, pg8::StaticOrder, true, true>(lds, g, S, E);
        } else if (EN(K_RES1) && (kind == K_RES1 || kind == K_RES2)) {
            const float* base = (kind == K_RES1 && l == 0) ? a.in[I_X] : a.out;
            const float* gp = ((kind == K_RES1) ? a.in[I_MIX_POST_G] : a.in[I_XA_POST_G]) + l * 1024;
            phase_res<false>(ws + WS_R, base, gp, a.out, ACT, gw, NGW, lane);
        } else if (EN(K_RES3) && kind == K_RES3) {
            phase_res<true>(ACT, a.out, a.in[I_MLP_POST_G] + l * 1024, a.out, ACT, gw, NGW, lane);
        } else if (EN(K_MIXA) && kind == K_MIXA) {
            const bf16* proj = (const bf16*)(ws + WS_R);
            if (even) {
                for (int u = bid; u < 64; u += G) {
                    if (u < 32) gla_seq_unit(a, jl, u >> 2, u & 3, proj, ACT, lds, tid);
                    else lru_seq_unit(a, jl, (u - 32) >> 2, (u - 32) & 3, proj, ACT, lds, tid);
                }
            } else {
                for (int u = bid; u < 2048; u += G) gdn_a_unit(a, jl, u, ws, lds, tid);
            }
        } else if (EN(K_MIXB) && kind == K_MIXB) {
            if (!even) { for (int u = bid; u < 64; u += G) gdn_b_unit(u, ws, lds, tid); }
        } else if (EN(K_ATT) && kind == K_ATT) {
            for (int u = bid; u < 256; u += G) attn_unit(l, u >> 2, u & 3, (bf16*)(ws + WS_QO), (const bf16*)(ws + WS_KALL), (const bf16*)(ws + WS_VT), wave, lane);
        }
        if (ph + 1 < hi) xcd_barrier(bar);
    }
}

#ifndef MK_PER_PHASE
#define MK_PER_PHASE 0
#endif
extern "C" void kernel_launch(void* const* d_in, const int* in_sizes, int n_in, void* d_out, int out_size, void* d_ws, size_t ws_size, hipStream_t stream) {
    static int grid = 0;
    if (grid == 0) {
        if (n_in != N_IN || out_size != M * D || ws_size < WS_END) { fprintf(stderr, "kernel_launch: unexpected shapes (n_in %d out %d ws %zu)\n", n_in, out_size, ws_size); grid = -1; return; }
        int dev = 0, cus = 0, per_cu = 0;
        if (hipGetDevice(&dev) != hipSuccess || hipDeviceGetAttribute(&cus, hipDeviceAttributeMultiprocessorCount, dev) != hipSuccess) { grid = -1; return; }
        if (hipFuncSetAttribute((const void*)mk_fwd, hipFuncAttributeMaxDynamicSharedMemorySize, LDS_BYTES) != hipSuccess) { fprintf(stderr, "kernel_launch: hipFuncSetAttribute failed\n"); grid = -1; return; }
        if (hipOccupancyMaxActiveBlocksPerMultiprocessor(&per_cu, (const void*)mk_fwd, NTHR, LDS_BYTES) != hipSuccess || per_cu < 1) { fprintf(stderr, "kernel_launch: occupancy query says %d blocks per CU\n", per_cu); }
        (void)hipGetLastError();
        grid = cus;
    }
    if (grid < 0) return;
    (void)in_sizes;
    if (hipMemsetAsync((char*)d_ws + WS_CTL, 0, CTL_ZERO_BYTES, stream) != hipSuccess) { fprintf(stderr, "kernel_launch: memset failed\n"); return; }
    Args a{};
    for (int i = 0; i < N_IN; ++i) a.in[i] = (const float*)d_in[i];
    a.out = (float*)d_out; a.ws = (unsigned char*)d_ws;
#if MK_PER_PHASE
    for (int ph = 0; ph < NPH; ++ph) { a.ph_lo = ph; a.ph_hi = ph + 1; hipLaunchKernelGGL(mk_fwd, dim3(grid), dim3(NTHR), LDS_BYTES, stream, a); }
#else
    a.ph_lo = 0; a.ph_hi = NPH;
    hipLaunchKernelGGL(mk_fwd, dim3(grid), dim3(NTHR), LDS_BYTES, stream, a);
#endif
}
```

```cpp
#include <hip/hip_runtime.h>
#include <cstdio>
#include <cstdint>
namespace pg8 {
#define PG8_LAS __attribute__((address_space(3)))
typedef unsigned short bf16_t;
typedef short bf16x8 __attribute__((ext_vector_type(8)));
typedef float f32x4 __attribute__((ext_vector_type(4)));
typedef unsigned u32x4 __attribute__((ext_vector_type(4)));
constexpr int BM = 256, BK = 64, HALF = 128, HTB = HALF * BK * 2  , STAGE_BYTES = 8 * HTB, NXCD = 8, WGM = 8;

__host__ __device__ __forceinline__ int lds_byte(int r, int c) { const int st = (r >> 4) * 2 + (c >> 5), rr = r & 15, cc = c & 31, ob = rr * 64 + cc * 2; return st * 1024 + (ob ^ (((ob >> 9) & 1) << 5)); }
__host__ __device__ __forceinline__ void stage_rc(int b, int& R, int& C) { const int st = b / 1024, sb = b % 1024, swz = sb ^ (((sb >> 9) & 1) << 5); R = (st >> 1) * 16 + swz / 64; C = (st & 1) * 32 + (swz % 64) / 2; }
__host__ __device__ __forceinline__ int perm32(int rho) { const int n = rho >> 4, i = rho & 15; return 8 * (i >> 2) + 4 * n + (i & 3); }

struct Unit { int pm, pn; };
struct Gemm { const bf16_t* A; const bf16_t* Bt; int M, N, K; };

struct StaticOrder {
    int nM, nN, nwg, G, c;
    __host__ __device__ void init(int M, int N, int G_, int c_) { nM = M / BM; nN = N / BM; nwg = nM * nN; G = G_; c = c_; }
    __host__ __device__ bool next(int i, Unit& u) const {
        const long L = (long)i * G + c; if (L >= nwg) return false;
        int wgid = (int)L; { const int q = nwg / NXCD, r = nwg % NXCD, xcd = wgid % NXCD, off = wgid / NXCD; wgid = (xcd < r ? xcd * (q + 1) : r * (q + 1) + (xcd - r) * q) + off; }
        const int nig = WGM * nN, gid = wgid / nig, fm = gid * WGM, gsz = (nM - fm) < WGM ? (nM - fm) : WGM;
        u.pm = fm + ((wgid % nig) % gsz); u.pn = (wgid % nig) / gsz; return true;
    }
    __device__ __forceinline__ void a_ready(const Unit&) const {}
    __device__ __forceinline__ void done(const Unit&) const {}
};

__device__ __forceinline__ unsigned cvt_pk_bf16(float lo, float hi) { unsigned r; asm volatile("v_cvt_pk_bf16_f32 %0, %1, %2" : "=v"(r) : "v"(lo), "v"(hi)); return r; }
typedef float f32x2 __attribute__((ext_vector_type(2)));
__device__ __forceinline__ f32x2 gelu_pk(f32x2 v) {
    const f32x2 av = __builtin_elementwise_abs(v), d = av * 0.2316418882f + 1.0f;
    f32x2 t; t.x = __builtin_amdgcn_rcpf(d.x); t.y = __builtin_amdgcn_rcpf(d.y);
    f32x2 q = t * 0.5307027145f + (-0.7265760135f); q = q * t + 0.7107068705f; q = q * t + (-0.142248368f); q = q * t + 0.127414796f; q = q * t;
    const f32x2 s = (v * v) * (-0.72134752044f);
    f32x2 e; e.x = __builtin_amdgcn_exp2f(s.x); e.y = __builtin_amdgcn_exp2f(s.y);
    const f32x2 m = v * (q * e), r = v - m;
    f32x2 o; o.x = v.x < 0.f ? m.x : r.x; o.y = v.y < 0.f ? m.y : r.y; return o;
}

template <int ACT  > struct EpiBf16 {
    static constexpr bool PERM = true, AFTER_DRAIN = false; static_assert(ACT == 0 || ACT == 1, "EpiBf16: ACT is 0 (none) or 1 (gelu_pk)");
    bf16_t* O; int ldc; const float* bias; int split_cols; size_t split_stride; float scale0;
    __device__ __forceinline__ void operator()(const f32x4 (&acc)[2][2][4][2], const Unit& u, int wr, int wc, int fr, int fq) const {
        const int row0 = u.pm * BM + wr * 64 + fr; int colt = u.pn * BM; bf16_t* base = O;
        float sc = 1.f; if (split_cols) { const int t = colt / split_cols; base += (size_t)t * split_stride; colt -= t * split_cols; if (t == 0) sc = scale0; }
        const int col0 = colt + wc * 32 + 8 * fq, bcol0 = u.pn * BM + wc * 32 + 8 * fq;
        f32x4 bv[2][2];
#pragma unroll
        for (int bj = 0; bj < 2; ++bj)
#pragma unroll
            for (int n = 0; n < 2; ++n) bv[bj][n] = bias ? *(const f32x4*)(bias + bcol0 + bj * HALF + 4 * n) : (f32x4){0.f, 0.f, 0.f, 0.f};
#pragma unroll
        for (int ai = 0; ai < 2; ++ai)
#pragma unroll
            for (int m = 0; m < 4; ++m) { bf16_t* rowp = base + (size_t)(row0 + ai * HALF + m * 16) * ldc + col0;
#pragma unroll
                for (int bj = 0; bj < 2; ++bj) { f32x4 v0 = acc[ai][bj][m][0] + bv[bj][0], v1 = acc[ai][bj][m][1] + bv[bj][1];
                    if (ACT == 1) { f32x2 a = gelu_pk((f32x2){v0[0], v0[1]}), b = gelu_pk((f32x2){v0[2], v0[3]}), c = gelu_pk((f32x2){v1[0], v1[1]}), d = gelu_pk((f32x2){v1[2], v1[3]});
                        v0 = (f32x4){a.x, a.y, b.x, b.y}; v1 = (f32x4){c.x, c.y, d.x, d.y}; }
                    v0 = v0 * sc; v1 = v1 * sc; u32x4 w; w.x = cvt_pk_bf16(v0[0], v0[1]); w.y = cvt_pk_bf16(v0[2], v0[3]); w.z = cvt_pk_bf16(v1[0], v1[1]); w.w = cvt_pk_bf16(v1[2], v1[3]);
                    *(u32x4*)(rowp + bj * HALF) = w; } }
    }
};

struct PanelStats {
    unsigned* xbuf;
    unsigned* cnt;
    unsigned* tmo;
    int ntn; float eps;
    unsigned code;
    __device__ __forceinline__ bool run(const f32x4 (&v)[2][2][4][2], const Unit& u, int wr, int wc, int fr, int fq, PG8_LAS unsigned char* lds, int wid, int lane) const {
        typedef float f32x2v __attribute__((ext_vector_type(2)));
        PG8_LAS f32x2v* P = (PG8_LAS f32x2v*)lds;
        PG8_LAS f32x2v* S = (PG8_LAS f32x2v*)(lds + 8192);
        PG8_LAS unsigned* flag = (PG8_LAS unsigned*)(lds + 8192 + 2048);
#pragma unroll
        for (int ai = 0; ai < 2; ++ai)
#pragma unroll
            for (int m = 0; m < 4; ++m) {
                float s = 0.f;
#pragma unroll
                for (int bj = 0; bj < 2; ++bj)
#pragma unroll
                    for (int n = 0; n < 2; ++n) { const f32x4 x = v[ai][bj][m][n]; s += (x[0] + x[1]) + (x[2] + x[3]); }
                s += __shfl_xor(s, 16); s += __shfl_xor(s, 32);
                const float mw = s * (1.0f / 64.0f); float q = 0.f;
#pragma unroll
                for (int bj = 0; bj < 2; ++bj)
#pragma unroll
                    for (int n = 0; n < 2; ++n) { const f32x4 d = v[ai][bj][m][n] - mw; q += (d[0] * d[0] + d[1] * d[1]) + (d[2] * d[2] + d[3] * d[3]); }
                q += __shfl_xor(q, 16); q += __shfl_xor(q, 32);
                if (fq == 0) P[(ai * HALF + wr * 64 + m * 16 + fr) * 4 + wc] = (f32x2v){mw, q};
            }
        asm volatile("s_waitcnt lgkmcnt(0)" ::: "memory"); __builtin_amdgcn_s_barrier(); asm volatile("" ::: "memory");
#if defined(BROKEN_EXCHANGE_NO_WAIT)
#warning BROKEN CONTROL BUILD: the row-statistics exchange does not wait; results are wrong by design
        if (blockIdx.x >= 64) { const long long t0_ = clock64(); while (clock64() - t0_ < 60000) __builtin_amdgcn_s_sleep(8); }
#endif
        const int row = wid * 32 + (lane & 31);
        if (lane < 32) {
            const f32x2v a = P[row * 4 + 0], b = P[row * 4 + 1], c = P[row * 4 + 2], d = P[row * 4 + 3];
            const float mt = (a.x + b.x + c.x + d.x) * 0.25f;
            const float da = a.x - mt, db = b.x - mt, dc = c.x - mt, dd = d.x - mt;
            const float m2 = (a.y + b.y) + (c.y + d.y) + 64.0f * ((da * da + db * db) + (dc * dc + dd * dd));
            unsigned long long* slot = (unsigned long long*)xbuf + ((size_t)(u.pm * BM + row) * 4 + u.pn);
            __hip_atomic_store(slot, ((unsigned long long)__float_as_uint(m2) << 32) | __float_as_uint(mt), __ATOMIC_RELAXED, __HIP_MEMORY_SCOPE_AGENT);
        }
        asm volatile("s_waitcnt vmcnt(0)" ::: "memory");
        if (lane == 0) __hip_atomic_fetch_add(cnt + 64 * u.pm, 1u, __ATOMIC_RELAXED, __HIP_MEMORY_SCOPE_AGENT);
        if (wid == 0) {
            bool dead = false; const unsigned long long t0 = __builtin_amdgcn_s_memrealtime(); const unsigned want = 8u * (unsigned)ntn;
            for (;;) {
#if defined(BROKEN_EXCHANGE_NO_WAIT)
                break;
#endif
                if ((unsigned)__builtin_amdgcn_readfirstlane(__hip_atomic_load(cnt + 64 * u.pm, __ATOMIC_RELAXED, __HIP_MEMORY_SCOPE_AGENT)) >= want) break;
                if (__builtin_amdgcn_s_memrealtime() - t0 > 2000000ull) {
                    if (lane == 0) { unsigned expect = 0u; __hip_atomic_compare_exchange_strong(tmo + 1, &expect, code | (unsigned)(u.pm & 0xff), __ATOMIC_RELAXED, __ATOMIC_RELAXED, __HIP_MEMORY_SCOPE_AGENT);
                                     __hip_atomic_store(tmo, 1u, __ATOMIC_RELAXED, __HIP_MEMORY_SCOPE_AGENT); }
                    dead = true; break; }
                __builtin_amdgcn_s_sleep(2);
            }
            __builtin_amdgcn_fence(__ATOMIC_ACQUIRE, "agent");
            if (lane == 0) flag[0] = dead ? 1u : 0u;
        }
        asm volatile("s_waitcnt vmcnt(0) lgkmcnt(0)" ::: "memory"); __builtin_amdgcn_s_barrier(); asm volatile("" ::: "memory");
        const bool bad = flag[0] != 0u;
        if (lane < 32) {
            const unsigned long long* slot = (const unsigned long long*)xbuf + (size_t)(u.pm * BM + row) * 4; float mt[4], m2[4]; float ms = 0.f;
#pragma unroll
            for (int t = 0; t < 4; ++t) { if (t < ntn) { const unsigned long long w = __hip_atomic_load(slot + t, __ATOMIC_RELAXED, __HIP_MEMORY_SCOPE_AGENT); mt[t] = __uint_as_float((unsigned)w); m2[t] = __uint_as_float((unsigned)(w >> 32)); } else { mt[t] = 0.f; m2[t] = 0.f; } ms += mt[t]; }
            const float mean = ms / (float)ntn; float q = 0.f;
#pragma unroll
            for (int t = 0; t < 4; ++t) if (t < ntn) { const float dm = mt[t] - mean; q += m2[t] + 256.0f * dm * dm; }
            S[row] = (f32x2v){mean, 1.0f / sqrtf(q / (256.0f * (float)ntn) + eps)};
        }
        asm volatile("s_waitcnt lgkmcnt(0)" ::: "memory"); __builtin_amdgcn_s_barrier(); asm volatile("" ::: "memory");
        return bad;
    }
};
struct EpiLnRes {
    static constexpr bool PERM = false, AFTER_DRAIN = true;
    const float* base; float* out; int ldc; const float* bias; PanelStats st; unsigned poison;
    __device__ __forceinline__ void fused(f32x4 (&acc)[2][2][4][2], const Unit& u, int wr, int wc, int fr, int fq, PG8_LAS unsigned char* lds, int wid, int lane) const {
        typedef float f32x2v __attribute__((ext_vector_type(2)));
        const PG8_LAS f32x2v* S = (const PG8_LAS f32x2v*)(lds + 8192);
        const int col0 = u.pn * BM + wc * 32 + 4 * fq;
#pragma unroll
        for (int bj = 0; bj < 2; ++bj)
#pragma unroll
            for (int n = 0; n < 2; ++n) { const f32x4 bv = bias ? *(const f32x4*)(bias + col0 + bj * HALF + n * 16) : (f32x4){0.f, 0.f, 0.f, 0.f};
#pragma unroll
                for (int ai = 0; ai < 2; ++ai)
#pragma unroll
                    for (int m = 0; m < 4; ++m) acc[ai][bj][m][n] += bv; }
        f32x4 pre[4][2][2];
#pragma unroll
        for (int m = 0; m < 4; ++m) { const size_t off = (size_t)(u.pm * BM + wr * 64 + m * 16 + fr) * ldc + col0;
#pragma unroll
            for (int bj = 0; bj < 2; ++bj)
#pragma unroll
                for (int n = 0; n < 2; ++n) pre[m][bj][n] = *(const f32x4*)(base + off + bj * HALF + n * 16); }
        const bool bad = st.run(acc, u, wr, wc, fr, fq, lds, wid, lane) || poison != 0u;
        const float qnan = __builtin_nanf("");
#pragma unroll
        for (int ai = 0; ai < 2; ++ai)
#pragma unroll
            for (int m = 0; m < 4; ++m) { const int r = ai * HALF + wr * 64 + m * 16 + fr; const f32x2v sr = S[r]; const size_t off = (size_t)(u.pm * BM + r) * ldc + col0;
#pragma unroll
                for (int bj = 0; bj < 2; ++bj)
#pragma unroll
                    for (int n = 0; n < 2; ++n) { const f32x4 bs = ai == 0 ? pre[m][bj][n] : *(const f32x4*)(base + off + bj * HALF + n * 16); f32x4 o = bs + (acc[ai][bj][m][n] - sr.x) * sr.y;
                        if (bad) o = (f32x4){qnan, qnan, qnan, qnan}; *(f32x4*)(out + off + bj * HALF + n * 16) = o; }
                if (m & 1) asm volatile("" ::: "memory"); }
    }
};
struct EpiLnResLn {
    static constexpr bool PERM = false, AFTER_DRAIN = true;
    const float* base; float* out; bf16_t* xn; int ldc; const float* bias; PanelStats st1, st2; unsigned poison;
    __device__ __forceinline__ void fused(f32x4 (&acc)[2][2][4][2], const Unit& u, int wr, int wc, int fr, int fq, PG8_LAS unsigned char* lds, int wid, int lane) const {
        typedef float f32x2v __attribute__((ext_vector_type(2))); typedef unsigned u32x2v __attribute__((ext_vector_type(2)));
        const PG8_LAS f32x2v* S = (const PG8_LAS f32x2v*)(lds + 8192);
        const int col0 = u.pn * BM + wc * 32 + 4 * fq;
#pragma unroll
        for (int bj = 0; bj < 2; ++bj)
#pragma unroll
            for (int n = 0; n < 2; ++n) { const f32x4 bv = bias ? *(const f32x4*)(bias + col0 + bj * HALF + n * 16) : (f32x4){0.f, 0.f, 0.f, 0.f};
#pragma unroll
                for (int ai = 0; ai < 2; ++ai)
#pragma unroll
                    for (int m = 0; m < 4; ++m) acc[ai][bj][m][n] += bv; }
        bool bad = st1.run(acc, u, wr, wc, fr, fq, lds, wid, lane) || poison != 0u;
        const float qnan = __builtin_nanf("");
#pragma unroll
        for (int ai = 0; ai < 2; ++ai)
#pragma unroll
            for (int m = 0; m < 4; ++m) { const int r = ai * HALF + wr * 64 + m * 16 + fr; const f32x2v sr = S[r]; const size_t off = (size_t)(u.pm * BM + r) * ldc + col0;
#pragma unroll
                for (int bj = 0; bj < 2; ++bj)
#pragma unroll
                    for (int n = 0; n < 2; ++n) { const f32x4 bs = *(const f32x4*)(base + off + bj * HALF + n * 16); acc[ai][bj][m][n] = bs + (acc[ai][bj][m][n] - sr.x) * sr.y; }
                asm volatile("" : "+v"(acc[ai][0][m][0]), "+v"(acc[ai][0][m][1]), "+v"(acc[ai][1][m][0]), "+v"(acc[ai][1][m][1]));
                if (m & 1) asm volatile("" ::: "memory"); }
        const bool bad1 = bad;
        bad = st2.run(acc, u, wr, wc, fr, fq, lds, wid, lane) || bad;
#pragma unroll
        for (int ai = 0; ai < 2; ++ai)
#pragma unroll
            for (int m = 0; m < 4; ++m) { const int r = ai * HALF + wr * 64 + m * 16 + fr; const f32x2v sr = S[r]; const size_t off = (size_t)(u.pm * BM + r) * ldc + col0;
#pragma unroll
                for (int bj = 0; bj < 2; ++bj)
#pragma unroll
                    for (int n = 0; n < 2; ++n) { const f32x4 x1 = acc[ai][bj][m][n]; *(f32x4*)(out + off + bj * HALF + n * 16) = bad1 ? (f32x4){qnan, qnan, qnan, qnan} : x1;
                        const f32x4 o = (x1 - sr.x) * sr.y; u32x2v w; w.x = cvt_pk_bf16(o[0], o[1]); w.y = cvt_pk_bf16(o[2], o[3]);
                        if (bad) { w.x = 0x7fc07fc0u; w.y = 0x7fc07fc0u; } *(u32x2v*)(xn + off + bj * HALF + n * 16) = w; }
                asm volatile("" ::: "memory"); }
    }
};

template <class Epi, class Sched, bool ALIGN_EPI = false, bool SP2 = false>
__device__ __forceinline__ void gemm_phase(PG8_LAS unsigned char* lds, const Gemm g, const Sched& S, const Epi& E) {
    int tid_ = threadIdx.x; asm volatile("" : "+v"(tid_));
    const int tid = tid_, wid = __builtin_amdgcn_readfirstlane(tid >> 6), lane = tid & 63, wr = wid >> 2, wc = wid & 3, fr = lane & 15, fq = lane >> 4;
    const int K = g.K, nt = K / BK;
    unsigned voffA[2], voffB[2];
#pragma unroll
    for (int i = 0; i < 2; ++i) { int R, C; stage_rc(tid * 16 + i * 8192, R, C); const int Rb = Epi::PERM ? ((R & ~31) + perm32(R & 31)) : R;
        voffA[i] = (unsigned)(R * K + C) * 2u; voffB[i] = (unsigned)(Rb * K + C) * 2u; }
    const size_t kstep = (size_t)(BK * 2);
    const size_t hstep = (size_t)HALF * K * 2;
    const size_t tstep = 2 * hstep;
    const unsigned ldsw = (unsigned)wid * 1024u;
    const int aoff = lds_byte(wr * 64 + fr, fq * 8), boff = lds_byte(wc * 32 + fr, fq * 8);
#define PG8_SA(b, h) (((b) * 2 + (h)) * HTB)
#define PG8_SB(b, h) ((4 + (b) * 2 + (h)) * HTB)
#define PG8_STAGE(bufoff, gbase, voff) do { _Pragma("unroll") for (int _i = 0; _i < 2; ++_i) \
        __builtin_amdgcn_global_load_lds((const unsigned*)((const char*)(gbase) + (voff)[_i]), (PG8_LAS unsigned*)(lds + (bufoff) + ldsw + _i * 8192), 16, 0, 0); } while (0)
#define PG8_LDA(dst, b, h) do { _Pragma("unroll") for (int m = 0; m < 4; ++m) _Pragma("unroll") for (int k = 0; k < 2; ++k) dst[m][k] = *(const PG8_LAS bf16x8*)(lds + PG8_SA(b, h) + aoff + m * 2048 + k * 1024); } while (0)
#define PG8_LDB(dst, b, h) do { _Pragma("unroll") for (int n = 0; n < 2; ++n) _Pragma("unroll") for (int k = 0; k < 2; ++k) dst[n][k] = *(const PG8_LAS bf16x8*)(lds + PG8_SB(b, h) + boff + n * 2048 + k * 1024); } while (0)
#define PG8_MMA(ai, bj, At, Bt) do { __builtin_amdgcn_s_setprio(1); _Pragma("unroll") for (int m = 0; m < 4; ++m) _Pragma("unroll") for (int n = 0; n < 2; ++n) _Pragma("unroll") for (int k = 0; k < 2; ++k) \
        acc[ai][bj][m][n] = __builtin_amdgcn_mfma_f32_16x16x32_bf16(Bt[n][k], At[m][k], acc[ai][bj][m][n], 0, 0, 0); __builtin_amdgcn_s_setprio(0); } while (0)
#define PG8_WAIT_V(n) asm volatile("s_waitcnt vmcnt(" #n ")" ::: "memory")
#define PG8_WAIT_L(n) asm volatile("s_waitcnt lgkmcnt(" #n ")" ::: "memory")
#define PG8_BAR __builtin_amdgcn_s_barrier()
#define PG8_SCHED __builtin_amdgcn_sched_barrier(0)
    Unit cur, nxt; int ui = 0;
    if (!S.next(0, cur)) return;
    f32x4 acc[2][2][4][2];
#pragma unroll
    for (int a = 0; a < 2; ++a)
#pragma unroll
        for (int b = 0; b < 2; ++b)
#pragma unroll
            for (int m = 0; m < 4; ++m)
#pragma unroll
                for (int n = 0; n < 2; ++n) acc[a][b][m][n] = (f32x4){0.f, 0.f, 0.f, 0.f};
    bf16x8 At[4][2], B0[2][2], B1[2][2];
    const char* cA = (const char*)g.A + (size_t)cur.pm * tstep; const char* cB = (const char*)g.Bt + (size_t)cur.pn * tstep;
    S.a_ready(cur);
    if constexpr (SP2) {
        PG8_STAGE(PG8_SB(0, 0), cB, voffB); PG8_STAGE(PG8_SB(0, 1), cB + hstep, voffB); PG8_STAGE(PG8_SA(0, 0), cA, voffA); PG8_STAGE(PG8_SA(0, 1), cA + hstep, voffA);
        if (wr == 1) PG8_BAR;
        PG8_WAIT_V(2); PG8_BAR;
        PG8_STAGE(PG8_SB(1, 0), cB + kstep, voffB); PG8_STAGE(PG8_SA(1, 0), cA + kstep, voffA); PG8_STAGE(PG8_SB(1, 1), cB + hstep + kstep, voffB);
        PG8_WAIT_V(6); PG8_BAR;
    } else {
        PG8_STAGE(PG8_SB(0, 0), cB, voffB); PG8_STAGE(PG8_SA(0, 0), cA, voffA); PG8_STAGE(PG8_SB(0, 1), cB + hstep, voffB); PG8_STAGE(PG8_SA(0, 1), cA + hstep, voffA);
        if (wr == 1) PG8_BAR;
        PG8_WAIT_V(4); PG8_BAR;
        PG8_STAGE(PG8_SB(1, 0), cB + kstep, voffB); PG8_STAGE(PG8_SA(1, 0), cA + kstep, voffA); PG8_STAGE(PG8_SB(1, 1), cB + hstep + kstep, voffB);
        PG8_WAIT_V(6); PG8_BAR;
    }
    for (;;) {
        const bool has_next = S.next(ui + 1, nxt);
        const char* nA = has_next ? (const char*)g.A + (size_t)nxt.pm * tstep : cA; const char* nB = has_next ? (const char*)g.Bt + (size_t)nxt.pn * tstep : cB;
        for (int t = 0; t < nt; t += 2) {
            const bool last = (t == nt - 2);
            const char* a1 = cA + (size_t)(t + 1) * kstep;
            const char* a2 = last ? nA : cA + (size_t)(t + 2) * kstep; const char* b2 = last ? nB : cB + (size_t)(t + 2) * kstep;
            const char* a3 = a2 + kstep; const char* b3 = b2 + kstep;
            if (last && has_next) S.a_ready(nxt);
            if constexpr (SP2) {
            PG8_LDB(B0, 0, 0); PG8_LDB(B1, 0, 1); PG8_SCHED; PG8_LDA(At, 0, 0); PG8_STAGE(PG8_SA(1, 1), a1 + hstep, voffA);
            PG8_WAIT_V(8); PG8_WAIT_L(0); PG8_BAR; PG8_MMA(0, 0, At, B0); PG8_MMA(0, 1, At, B1); PG8_BAR; PG8_SCHED;
            PG8_LDA(At, 0, 1); PG8_STAGE(PG8_SB(0, 0), b2, voffB); PG8_STAGE(PG8_SB(0, 1), b2 + hstep, voffB); PG8_STAGE(PG8_SA(0, 0), a2, voffA);
            PG8_WAIT_V(8); PG8_WAIT_L(0); PG8_BAR; PG8_MMA(1, 0, At, B0); PG8_MMA(1, 1, At, B1); PG8_BAR; PG8_SCHED;
            PG8_LDB(B0, 1, 0); PG8_LDB(B1, 1, 1); PG8_SCHED; PG8_LDA(At, 1, 0); PG8_STAGE(PG8_SA(0, 1), a2 + hstep, voffA);
            PG8_WAIT_V(8); PG8_WAIT_L(0); PG8_BAR; PG8_MMA(0, 0, At, B0); PG8_MMA(0, 1, At, B1); PG8_BAR; PG8_SCHED;
            PG8_LDA(At, 1, 1); PG8_STAGE(PG8_SB(1, 0), b3, voffB); PG8_STAGE(PG8_SB(1, 1), b3 + hstep, voffB); PG8_STAGE(PG8_SA(1, 0), a3, voffA);
            PG8_WAIT_V(8); PG8_WAIT_L(0); PG8_BAR; PG8_MMA(1, 0, At, B0); PG8_MMA(1, 1, At, B1); PG8_BAR; PG8_SCHED;
            } else {
            PG8_LDB(B0, 0, 0); PG8_SCHED; PG8_LDA(At, 0, 0); PG8_STAGE(PG8_SA(1, 1), a1 + hstep, voffA);
            PG8_WAIT_L(8); PG8_BAR; PG8_WAIT_L(0); PG8_MMA(0, 0, At, B0); PG8_BAR; PG8_SCHED;
            PG8_LDB(B1, 0, 1); PG8_STAGE(PG8_SB(0, 0), b2, voffB);
            PG8_BAR; PG8_WAIT_L(0); PG8_MMA(0, 1, At, B1); PG8_BAR;
            PG8_LDA(At, 0, 1); PG8_STAGE(PG8_SA(0, 0), a2, voffA);
            PG8_BAR; PG8_WAIT_L(0); PG8_MMA(1, 0, At, B0); PG8_BAR; PG8_SCHED;
            PG8_STAGE(PG8_SB(0, 1), b2 + hstep, voffB);
            PG8_WAIT_V(6); PG8_BAR; PG8_MMA(1, 1, At, B1); PG8_BAR;
            PG8_LDB(B0, 1, 0); PG8_SCHED; PG8_LDA(At, 1, 0); PG8_STAGE(PG8_SA(0, 1), a2 + hstep, voffA);
            PG8_WAIT_L(8); PG8_BAR; PG8_WAIT_L(0); PG8_MMA(0, 0, At, B0); PG8_BAR; PG8_SCHED;
            PG8_LDB(B1, 1, 1); PG8_STAGE(PG8_SB(1, 0), b3, voffB);
            PG8_BAR; PG8_WAIT_L(0); PG8_MMA(0, 1, At, B1); PG8_BAR;
            PG8_LDA(At, 1, 1); PG8_STAGE(PG8_SA(1, 0), a3, voffA);
            PG8_BAR; PG8_WAIT_L(0); PG8_MMA(1, 0, At, B0); PG8_BAR; PG8_SCHED;
            PG8_STAGE(PG8_SB(1, 1), b3 + hstep, voffB);
            PG8_WAIT_V(6); PG8_BAR; PG8_MMA(1, 1, At, B1); PG8_BAR;
            }
        }
        if constexpr (ALIGN_EPI) { if (wr == 0) PG8_BAR; }
        if constexpr (!Epi::AFTER_DRAIN) { E(acc, cur, wr, wc, fr, fq); S.done(cur); }
        if (!has_next) break;
#pragma unroll
        for (int a = 0; a < 2; ++a)
#pragma unroll
            for (int b = 0; b < 2; ++b)
#pragma unroll
                for (int m = 0; m < 4; ++m)
#pragma unroll
                    for (int n = 0; n < 2; ++n) acc[a][b][m][n] = (f32x4){0.f, 0.f, 0.f, 0.f};
        cur = nxt; cA = nA; cB = nB; ++ui;
        if constexpr (ALIGN_EPI) { if (wr == 1) PG8_BAR; }
    }
    PG8_WAIT_V(0);
    if constexpr (!ALIGN_EPI) { if (wr == 0) PG8_BAR; }
    PG8_BAR;
    if constexpr (Epi::AFTER_DRAIN) { E.fused(acc, cur, wr, wc, fr, fq, lds, wid, lane); S.done(cur); }
#undef PG8_SA
#undef PG8_SB
#undef PG8_STAGE
#undef PG8_LDA
#undef PG8_LDB
#undef PG8_MMA
#undef PG8_WAIT_V
#undef PG8_WAIT_L
#undef PG8_BAR
#undef PG8_SCHED
}
}

namespace pg8 {
typedef __bf16 bf16x2v __attribute__((ext_vector_type(2)));
typedef float f32x2w __attribute__((ext_vector_type(2)));
__device__ __forceinline__ unsigned pk_bf16(float lo, float hi) { f32x2w v = {lo, hi}; bf16x2v b = __builtin_convertvector(v, bf16x2v); return __builtin_bit_cast(unsigned, b); }
template <int ACT> struct EpiBf16A {
    static constexpr bool PERM = true, AFTER_DRAIN = false;
    bf16_t* O; int ldc;
    __device__ __forceinline__ void operator()(const f32x4 (&acc)[2][2][4][2], const Unit& u, int wr, int wc, int fr, int fq) const {
        const int row0 = u.pm * BM + wr * 64 + fr; const int col0 = u.pn * BM + wc * 32 + 8 * fq;
#pragma unroll
        for (int ai = 0; ai < 2; ++ai)
#pragma unroll
            for (int m = 0; m < 4; ++m) { bf16_t* rowp = O + (size_t)(row0 + ai * HALF + m * 16) * ldc + col0;
#pragma unroll
                for (int bj = 0; bj < 2; ++bj) { f32x4 v0 = acc[ai][bj][m][0], v1 = acc[ai][bj][m][1];
                    if (ACT == 1) {
#pragma unroll
                        for (int j = 0; j < 4; ++j) { const float a = fmaxf(v0[j], 0.f), b = fmaxf(v1[j], 0.f); v0[j] = a * a; v1[j] = b * b; } }
                    u32x4 w; w.x = pk_bf16(v0[0], v0[1]); w.y = pk_bf16(v0[2], v0[3]); w.z = pk_bf16(v1[0], v1[1]); w.w = pk_bf16(v1[2], v1[3]);
                    *(u32x4*)(rowp + bj * HALF) = w; } }
    }
};
struct EpiF32A {
    static constexpr bool PERM = false, AFTER_DRAIN = false;
    float* C; int ldc;
    __device__ __forceinline__ void operator()(const f32x4 (&acc)[2][2][4][2], const Unit& u, int wr, int wc, int fr, int fq) const {
        const int row0 = u.pm * BM + wr * 64 + fr, col0 = u.pn * BM + wc * 32 + 4 * fq;
#pragma unroll
        for (int ai = 0; ai < 2; ++ai)
#pragma unroll
            for (int m = 0; m < 4; ++m) { float* rowp = C + (size_t)(row0 + ai * HALF + m * 16) * ldc + col0;
#pragma unroll
                for (int bj = 0; bj < 2; ++bj)
#pragma unroll
                    for (int n = 0; n < 2; ++n) *(f32x4*)(rowp + bj * HALF + n * 16) = acc[ai][bj][m][n]; }
    }
};
}

#define GAS __attribute__((address_space(1)))
#define LAS __attribute__((address_space(3)))
typedef unsigned short bf16;
typedef unsigned v4u __attribute__((ext_vector_type(4)));
typedef unsigned v2u __attribute__((ext_vector_type(2)));
typedef float f32x4 __attribute__((ext_vector_type(4)));
typedef float f32x16 __attribute__((ext_vector_type(16)));
typedef short bf16x8 __attribute__((ext_vector_type(8)));
typedef short s16x4 __attribute__((ext_vector_type(4)));
typedef GAS unsigned gu32;
typedef GAS unsigned long long gu64;
#define RLX_AGENT __ATOMIC_RELAXED, __HIP_MEMORY_SCOPE_AGENT
#define LDS_WAIT() asm volatile("s_waitcnt lgkmcnt(0)" ::: "memory")
#define VM_WAIT() asm volatile("s_waitcnt vmcnt(0)" ::: "memory")
__device__ __forceinline__ unsigned pk2(float lo, float hi) { return pg8::pk_bf16(lo, hi); }
__device__ __forceinline__ bf16 f2bf(float f) { return (bf16)(pk2(f, 0.f) & 0xffffu); }
__device__ __forceinline__ float bf2f(bf16 h) { return __uint_as_float((unsigned)h << 16); }
__device__ __forceinline__ float bflo(unsigned w) { return __uint_as_float(w << 16); }
__device__ __forceinline__ float bfhi(unsigned w) { return __uint_as_float(w & 0xffff0000u); }

#define XB_TMO      128
#define XB_XCNT(j)  (256  + 64 * (j))
#define XB_XSUB(j)  (1280 + 64 * (j))
#define XB_XGEN(j)  (2304 + 64 * (j))
#define XB_TOP      3328
#define XB_TOPGEN   3392
#define XCD_BAR_WORDS 3456
#define XB_SPIN_CAP (1u << 18)

__device__ __forceinline__ unsigned xb_ld(unsigned* p)              { return __hip_atomic_load(p, __ATOMIC_RELAXED, __HIP_MEMORY_SCOPE_AGENT); }
__device__ __forceinline__ unsigned xb_add(unsigned* p, unsigned v) { return __hip_atomic_fetch_add(p, v, __ATOMIC_RELAXED, __HIP_MEMORY_SCOPE_AGENT); }
__device__ __forceinline__ unsigned xb_xcc_id() { return (unsigned)__builtin_amdgcn_s_getreg((3 << 11) | 20) & 0xFu; }
#define XB_SPIN(cond, bar) do { unsigned _sp = 0; while (cond) { __builtin_amdgcn_s_sleep(1); \
    if ((++_sp & 255u) == 0u) { if (xb_ld(&(bar)[XB_TMO])) break; if (_sp > XB_SPIN_CAP) { atomicAdd(&(bar)[XB_TMO], 1u); break; } } } } while (0)

struct XcdBarrier {
    unsigned* bar; unsigned x;
    volatile LAS unsigned* st;
};

__device__ __forceinline__ XcdBarrier xcd_barrier_post(unsigned* bar, volatile LAS unsigned* st) {
    XcdBarrier b; b.bar = bar; b.x = xb_xcc_id(); b.st = st;
    if (threadIdx.x == 0) (void)xb_add(&bar[XB_XCNT(b.x)], 1u);
    return b;
}
__device__ __forceinline__ void xcd_barrier_complete(unsigned* bar, unsigned x, unsigned& nloc, unsigned& nx) {
    const unsigned G = gridDim.x * gridDim.y * gridDim.z;
    unsigned sum, cnt, mine, sp = 0u;
    for (;;) {
        sum = 0u; cnt = 0u; mine = 0u;
#pragma unroll
        for (unsigned j = 0; j < 16; ++j) { const unsigned c = xb_ld(&bar[XB_XCNT(j)]); sum += c; cnt += (c > 0u) ? 1u : 0u; mine = (j == x) ? c : mine; }
        if (sum == G) break;
        __builtin_amdgcn_s_sleep(1);
        if ((++sp & 255u) == 0u) { if (xb_ld(&bar[XB_TMO])) break; if (sp > XB_SPIN_CAP) { atomicAdd(&bar[XB_TMO], 1u); break; } }
    }
    nloc = mine > 0u ? mine : 1u; nx = cnt > 0u ? cnt : 1u;
}

__device__ __forceinline__ void xcd_barrier(const XcdBarrier& b) {
    asm volatile("s_waitcnt vmcnt(0)" ::: "memory");
    __syncthreads();
    if (threadIdx.x == 0) {
        unsigned* bar = b.bar;
        __builtin_amdgcn_s_waitcnt(0);
        unsigned nloc = b.st[0], nx = b.st[1];
        if (nloc == 0u) { xcd_barrier_complete(bar, b.x, nloc, nx); b.st[0] = nloc; b.st[1] = nx; }
        const unsigned old = xb_add(&bar[XB_XSUB(b.x)], 1u);
        const unsigned gen = old / nloc;
        if (old + 1u == (gen + 1u) * nloc) {
            __builtin_amdgcn_fence(__ATOMIC_RELEASE, "agent");
            asm volatile("s_waitcnt vmcnt(0)" ::: "memory");
            const unsigned og = xb_add(&bar[XB_TOP], 1u);
            const unsigned tg = og / nx;
            if (og + 1u == (tg + 1u) * nx) xb_add(&bar[XB_TOPGEN], 1u);
            else XB_SPIN(xb_ld(&bar[XB_TOPGEN]) == tg, bar);
            __builtin_amdgcn_fence(__ATOMIC_ACQUIRE, "agent");
            xb_add(&bar[XB_XGEN(b.x)], 1u);
            asm volatile("s_waitcnt vmcnt(0)" ::: "memory");
        } else {
            XB_SPIN(xb_ld(&bar[XB_XGEN(b.x)]) == gen, bar);
            __builtin_amdgcn_fence(__ATOMIC_ACQUIRE, "agent");
            asm volatile("s_waitcnt vmcnt(0)" ::: "memory");
        }
    }
    __syncthreads();
}

constexpr int NWAVES = 8, NTHR = 512;
constexpr int BATCH = 8, T = 2048, D = 1024, M = BATCH * T, NMEM = 256, MMEM = BATCH * NMEM, FF = 4096, DEPTH = 4;
constexpr int AB_IN = 2576, GDN_IN = 4112, NIN_E = 2816, NIN_O = 4096;
constexpr float EPS = 1e-6f;
enum InIdx { I_X = 0, I_MEM, I_MIX_PRE_G, I_MIX_POST_G, I_AB_W_IN, I_GK_W2, I_GK_B, I_GLA_NORM_G, I_LRU_CONV_W, I_LRU_CONV_B, I_LRU_W_A, I_LRU_B_A, I_LRU_W_X, I_LRU_B_X,
             I_LRU_LAMBDA, I_AB_W_OUT, I_GDN_W_IN, I_GDN_CONV_W, I_GDN_A_LOG, I_GDN_DT_BIAS, I_GDN_NORM_G, I_GDN_W_OUT, I_XA_PRE_G, I_XA_MEM_G, I_XA_POST_G, I_XA_W_Q,
             I_XA_W_KV, I_XA_W_O, I_MLP_PRE_G, I_MLP_POST_G, I_MLP_W1, I_MLP_W2, N_IN };

constexpr size_t KiB = 1u << 10, MiB = 1u << 20;
constexpr size_t WS_CTL = 0, CTL_ZERO_BYTES = 65536;
constexpr size_t WS_BA = 1 * MiB;
constexpr size_t WS_SCAL = 2 * MiB;
constexpr size_t WS_HALO = 3 * MiB;
constexpr size_t WS_LRUW = 7 * MiB + 768 * KiB;
constexpr size_t WS_W = 8 * MiB + 512 * KiB;
constexpr size_t WL_E = 27 * MiB + 512 * KiB, WL_O = 30 * MiB + 128 * KiB;
constexpr size_t WS_KALL = WS_W + 2 * WL_E + 2 * WL_O;
constexpr size_t WS_VT = WS_KALL + 16 * MiB;
constexpr size_t WS_ACT = WS_VT + 16 * MiB;
constexpr size_t WS_R = WS_ACT + 32 * MiB;
constexpr size_t WS_AQK = WS_R + 128 * MiB;
constexpr size_t WS_END = WS_AQK + 16 * MiB;
constexpr size_t WS_WK = WS_R, WS_WV = WS_R + 8 * MiB, WS_MEMN = WS_R + 16 * MiB, WS_QO = WS_R + 64 * MiB;
constexpr int CW_BAR = 4096;
constexpr int RING_BYTES = 131072, LDSCTL_OFF = RING_BYTES, MISC_OFF = LDSCTL_OFF + 320, LDS_BYTES = 147456;
enum WOff { WO_IN = 0, WO_OUT, WO_Q, WO_O, WO_W1, WO_W2, WO_BA };

struct Args { const float* in[N_IN]; float* out; unsigned char* ws; int ph_lo, ph_hi; };

__device__ __forceinline__ float wave_sum(float v) {
#pragma unroll
    for (int o = 1; o < 64; o <<= 1) v += __shfl_xor(v, o);
    return v;
}
__device__ __forceinline__ float sigmoidf_(float x) { return 1.0f / (1.0f + __expf(-x)); }
__device__ __forceinline__ float siluf_(float x) { return x / (1.0f + __expf(-x)); }
__device__ __forceinline__ float softplusf_(float x) { return fmaxf(x, 0.f) + log1pf(__expf(-fabsf(x))); }
__device__ __forceinline__ float gelu_tanh(float x) { const float u = 0.7978845608028654f * (x + 0.044715f * x * x * x); return 0.5f * x * (1.0f + tanhf(u)); }

struct Job { const float* W; int ldw, c0, ncols, k_lo, Kr; bf16* WT; int dstK, r0; const float* gain; int gmask; float sc; };
__device__ __forceinline__ bf16* wl(unsigned char* ws, int i, int which) {
    const size_t lbase = WS_W + (size_t)(i >> 1) * (WL_E + WL_O) + ((i & 1) ? WL_E : 0);
    const size_t win = (i & 1) ? 8 * MiB : 5 * MiB + 512 * KiB;
    size_t off = 0;
    if (which == WO_OUT) off = win; else if (which == WO_Q) off = win + 2 * MiB; else if (which == WO_O) off = win + 4 * MiB;
    else if (which == WO_W1) off = win + 6 * MiB; else if (which == WO_W2) off = win + 14 * MiB; else if (which == WO_BA) off = win + 22 * MiB;
    return (bf16*)(ws + lbase + off);
}
__device__ __forceinline__ void get_job(const Args& a, int jid, Job& J) {
    const int i = jid / 10, s = jid % 10, j = i >> 1; const bool even = !(i & 1);
    unsigned char* ws = a.ws;
    J.c0 = 0; J.k_lo = 0; J.Kr = 1024; J.dstK = 1024; J.r0 = 0; J.gain = nullptr; J.gmask = 1023; J.sc = 1.f; J.ncols = 1024; J.ldw = 1024; J.W = nullptr; J.WT = nullptr;
    if (jid >= DEPTH * 10) {
        const int s2 = jid - DEPTH * 10, jl = s2 >> 3, gate = (s2 >> 2) & 1, n = s2 & 3;
        J.W = (gate ? a.in[I_LRU_W_X] : a.in[I_LRU_W_A]) + (size_t)(jl * 4 + n) * 16384; J.ldw = 128; J.ncols = 128; J.Kr = 128; J.dstK = 128;
        J.WT = (bf16*)(ws + WS_LRUW) + (size_t)((jl * 2 + gate) * 4 + n) * 16384; return;
    }
    switch (s) {
    case 0: J.W = even ? a.in[I_AB_W_IN] + (size_t)j * 1024 * AB_IN : a.in[I_GDN_W_IN] + (size_t)j * 1024 * GDN_IN; J.ldw = even ? AB_IN : GDN_IN; J.ncols = even ? 1536 : 4096;
            J.WT = wl(ws, i, WO_IN); J.gain = a.in[I_MIX_PRE_G] + i * 1024; break;
    case 1: J.W = a.in[I_AB_W_IN] + (size_t)j * 1024 * AB_IN; J.ldw = AB_IN; J.c0 = 1552; J.ncols = even ? 1024 : 0; J.WT = wl(ws, i, WO_IN); J.r0 = 1536; J.gain = a.in[I_MIX_PRE_G] + i * 1024; break;
    case 2: J.W = even ? a.in[I_AB_W_OUT] + (size_t)j * 1024 * 1024 : a.in[I_GDN_W_OUT] + (size_t)j * 1024 * 1024; J.Kr = 512; J.WT = wl(ws, i, WO_OUT);
            J.gain = even ? a.in[I_GLA_NORM_G] + j * 128 : a.in[I_GDN_NORM_G] + j * 128; J.gmask = 127; break;
    case 3: J.W = even ? a.in[I_AB_W_OUT] + (size_t)j * 1024 * 1024 : a.in[I_GDN_W_OUT] + (size_t)j * 1024 * 1024; J.k_lo = 512; J.Kr = 512; J.WT = wl(ws, i, WO_OUT);
            J.gain = even ? nullptr : a.in[I_GDN_NORM_G] + j * 128; J.gmask = 127; break;
    case 4: J.W = a.in[I_XA_W_Q] + (size_t)i * 1024 * 1024; J.WT = wl(ws, i, WO_Q); J.gain = a.in[I_XA_PRE_G] + i * 1024; J.sc = 0.0625f; break;
    case 5: J.W = a.in[I_XA_W_KV] + (size_t)i * 1024 * 2048; J.ldw = 2048; J.WT = (bf16*)(ws + WS_WK); J.r0 = i * 1024; J.gain = a.in[I_XA_MEM_G] + i * 1024; break;
    case 6: J.W = a.in[I_XA_W_KV] + (size_t)i * 1024 * 2048; J.ldw = 2048; J.c0 = 1024; J.WT = (bf16*)(ws + WS_WV); J.r0 = i * 1024; J.gain = a.in[I_XA_MEM_G] + i * 1024; break;
    case 7: J.W = a.in[I_XA_W_O] + (size_t)i * 1024 * 1024; J.WT = wl(ws, i, WO_O); break;
    case 8: J.W = a.in[I_MLP_W1] + (size_t)i * 1024 * 4096; J.ldw = 4096; J.ncols = 4096; J.WT = wl(ws, i, WO_W1); J.gain = a.in[I_MLP_PRE_G] + i * 1024; break;
    default: J.W = a.in[I_MLP_W2] + (size_t)i * 4096 * 1024; J.Kr = 4096; J.dstK = 4096; J.WT = wl(ws, i, WO_W2); break;
    }
}
__device__ __forceinline__ void transpose_item(const Job& J, LAS float* scr, int item, int lane) {
    const int nblk = J.ncols / 32, kb = item / nblk, nb = item % nblk, k0 = J.k_lo + 64 * kb, n0 = 32 * nb;
#pragma unroll 8
    for (int i = 0; i < 32; ++i) { const int kk = 2 * i + (lane >> 5); const int k = k0 + kk;
        float v = J.W[(size_t)k * J.ldw + J.c0 + n0 + (lane & 31)];
        const float g = J.gain ? J.gain[k & J.gmask] : 1.0f;
        scr[kk * 33 + (lane & 31)] = v * g * J.sc; }
    LDS_WAIT(); asm volatile("" ::: "memory");
    const int c = lane & 7;
#pragma unroll
    for (int jj = 0; jj < 4; ++jj) { const int n = (lane >> 3) + 8 * jj; const LAS float* s = scr + (8 * c) * 33 + n;
        v4u o; o.x = pk2(s[0 * 33], s[1 * 33]); o.y = pk2(s[2 * 33], s[3 * 33]); o.z = pk2(s[4 * 33], s[5 * 33]); o.w = pk2(s[6 * 33], s[7 * 33]);
        *(GAS v4u*)(J.WT + (size_t)(J.r0 + n0 + n) * J.dstK + k0 + 8 * c) = o; }
    LDS_WAIT(); asm volatile("" ::: "memory");
}
__device__ __forceinline__ void rms_row_to_bf16(const float* xrow, bf16* orow, int lane) {
    const GAS f32x4* xr = (const GAS f32x4*)xrow + lane;
    f32x4 v[4]; float s = 0.f;
#pragma unroll
    for (int j = 0; j < 4; ++j) { v[j] = xr[64 * j]; s += (v[j].x * v[j].x + v[j].y * v[j].y) + (v[j].z * v[j].z + v[j].w * v[j].w); }
    const float r = 1.0f / sqrtf(wave_sum(s) * (1.f / 1024.f) + EPS);
    GAS v2u* o8 = (GAS v2u*)orow + lane;
#pragma unroll
    for (int j = 0; j < 4; ++j) { v2u w; w.x = pk2(v[j].x * r, v[j].y * r); w.y = pk2(v[j].z * r, v[j].w * r); o8[64 * j] = w; }
}
__device__ __forceinline__ void phase_prologue(const Args& a, LAS unsigned char* lds, int bid, int G, int wave, int lane, int tid) {
    LAS float* scr = (LAS float*)(lds + wave * 16384);
    const int gw = bid * NWAVES + wave, NGW = G * NWAVES;
    {
        int jid = 0; Job J; get_job(a, 0, J); int jstart = 0, jn = (J.Kr / 64) * (J.ncols / 32);
        constexpr int NJOBS = DEPTH * 10 + 16;
        for (int it = gw;; it += NGW) {
            while (jid < NJOBS && it >= jstart + jn) { jstart += jn; ++jid; if (jid < NJOBS) { get_job(a, jid, J); jn = (J.Kr / 64) * (J.ncols / 32); } }
            if (jid >= NJOBS) break;
            transpose_item(J, scr, it - jstart, lane);
        }
    }
    for (int m = gw; m < M + MMEM; m += NGW) {
        if (m < M) rms_row_to_bf16(a.in[I_X] + (size_t)m * D, (bf16*)(a.ws + WS_ACT) + (size_t)m * D, lane);
        else rms_row_to_bf16(a.in[I_MEM] + (size_t)(m - M) * D, (bf16*)(a.ws + WS_MEMN) + (size_t)(m - M) * D, lane);
    }
    for (int it = gw; it < 2 * 256 * 16; it += NGW) {
        const int j = it / 4096, n = (it / 16) & 255, k = (it & 15) * 64 + lane, i = 2 * j;
        const float* wrow = a.in[I_AB_W_IN] + (size_t)j * 1024 * AB_IN + (size_t)k * AB_IN + 1536;
        const float* w2 = a.in[I_GK_W2] + j * 16 * 256 + n;
        float s = 0.f;
#pragma unroll
        for (int r = 0; r < 16; ++r) s += wrow[r] * w2[r * 256];
        s *= a.in[I_MIX_PRE_G][i * 1024 + k];
        wl(a.ws, i, WO_IN)[(size_t)(2560 + n) * 1024 + k] = f2bf(s);
    }
    for (int it = gw * 64 + lane; it < 2 * 16 * 1024; it += NGW * 64) {
        const int j = it / 16384, o = (it / 1024) & 15, k = it & 1023, i = 2 * j + 1;
        ((float*)wl(a.ws, i, WO_BA))[o * 1024 + k] = a.in[I_GDN_W_IN][(size_t)j * 1024 * GDN_IN + (size_t)k * GDN_IN + 4096 + o] * a.in[I_MIX_PRE_G][i * 1024 + k];
    }
    (void)tid;
}

template <bool MBF16>
__device__ __forceinline__ void phase_res(const void* mptr, const float* base, const float* gpost, float* out, bf16* xn, int gw, int NGW, int lane) {
    for (int row = gw; row < M; row += NGW) {
        f32x4 mv[4], hv[4], gv[4];
#pragma unroll
        for (int j = 0; j < 4; ++j) {
            const int idx = 4 * lane + 256 * j;
            if (MBF16) { const v2u w = *(const GAS v2u*)((const bf16*)mptr + (size_t)row * D + idx); mv[j] = (f32x4){bflo(w.x), bfhi(w.x), bflo(w.y), bfhi(w.y)}; }
            else mv[j] = *(const GAS f32x4*)((const float*)mptr + (size_t)row * D + idx);
            hv[j] = *(const GAS f32x4*)(base + (size_t)row * D + idx);
            gv[j] = *(const GAS f32x4*)(gpost + idx);
        }
        float s = 0.f;
#pragma unroll
        for (int j = 0; j < 4; ++j) s += (mv[j].x * mv[j].x + mv[j].y * mv[j].y) + (mv[j].z * mv[j].z + mv[j].w * mv[j].w);
        const float r1 = 1.0f / sqrtf(wave_sum(s) * (1.f / 1024.f) + EPS);
        float s2 = 0.f;
#pragma unroll
        for (int j = 0; j < 4; ++j) { hv[j] = hv[j] + mv[j] * gv[j] * r1; s2 += (hv[j].x * hv[j].x + hv[j].y * hv[j].y) + (hv[j].z * hv[j].z + hv[j].w * hv[j].w); }
        const float r2 = 1.0f / sqrtf(wave_sum(s2) * (1.f / 1024.f) + EPS);
#pragma unroll
        for (int j = 0; j < 4; ++j) {
            const int idx = 4 * lane + 256 * j;
            *(GAS f32x4*)(out + (size_t)row * D + idx) = hv[j];
            v2u w; w.x = pk2(hv[j].x * r2, hv[j].y * r2); w.y = pk2(hv[j].z * r2, hv[j].w * r2);
            *(GAS v2u*)(xn + (size_t)row * D + idx) = w;
        }
    }
}

__device__ __forceinline__ void phase_ba(const bf16* xn, const float* Wba, float* BA, LAS unsigned char* lds, int bid, int G, int wave, int lane, int tid) {
    LAS float* sw = (LAS float*)lds;
    for (int i = tid; i < 16 * 1024 / 4; i += NTHR) ((LAS f32x4*)sw)[i] = ((const GAS f32x4*)Wba)[i];
    __syncthreads();
    const int gw = bid * NWAVES + wave, NGW = G * NWAVES;
    for (int row = gw; row < M; row += NGW) {
        const v4u w0 = *(const GAS v4u*)(xn + (size_t)row * D + 8 * lane), w1 = *(const GAS v4u*)(xn + (size_t)row * D + 512 + 8 * lane);
        float xv[16] = {bflo(w0.x), bfhi(w0.x), bflo(w0.y), bfhi(w0.y), bflo(w0.z), bfhi(w0.z), bflo(w0.w), bfhi(w0.w),
                        bflo(w1.x), bfhi(w1.x), bflo(w1.y), bfhi(w1.y), bflo(w1.z), bfhi(w1.z), bflo(w1.w), bfhi(w1.w)};
        float res = 0.f;
#pragma unroll 1
        for (int o = 0; o < 16; ++o) {
            const LAS f32x4* p0 = (const LAS f32x4*)(sw + o * 1024 + 8 * lane); const LAS f32x4* p1 = (const LAS f32x4*)(sw + o * 1024 + 512 + 8 * lane);
            const f32x4 a0 = p0[0], a1 = p0[1], b0 = p1[0], b1 = p1[1];
            float s = xv[0] * a0.x + xv[1] * a0.y + xv[2] * a0.z + xv[3] * a0.w + xv[4] * a1.x + xv[5] * a1.y + xv[6] * a1.z + xv[7] * a1.w
                    + xv[8] * b0.x + xv[9] * b0.y + xv[10] * b0.z + xv[11] * b0.w + xv[12] * b1.x + xv[13] * b1.y + xv[14] * b1.z + xv[15] * b1.w;
            s = wave_sum(s);
            res = (lane == o) ? s : res;
        }
        if (lane < 16) BA[(size_t)row * 16 + lane] = res;
    }
    __syncthreads();
}

__device__ __forceinline__ void gla_seq_unit(const Args& a, int jl, int b, int h, const bf16* proj, bf16* mixed, LAS unsigned char* lds, int tid) {
    LAS float* sq = (LAS float*)lds; LAS float* sk = sq + 64; LAS float* se = sk + 64; LAS float* red = se + 64; LAS float* wss = red + 4 * 128;
    const int c = tid & 127, kq = tid >> 7, d0 = kq * 16, lane = tid & 63, wave = tid >> 6;
    float S[16];
#pragma unroll
    for (int i = 0; i < 16; ++i) S[i] = 0.f;
    const float gkb = (tid < 64) ? a.in[I_GK_B][jl * 256 + h * 64 + tid] : 0.f;
    const bf16* prow = proj + (size_t)b * T * NIN_E;
    bf16 nq = 0, nk = 0, ng = 0, nv, ngo = 0;
    if (tid < 64) { nq = prow[h * 64 + tid]; nk = prow[256 + h * 64 + tid]; ng = prow[2560 + h * 64 + tid]; }
    nv = prow[512 + h * 128 + c]; if (kq == 0) ngo = prow[1024 + h * 128 + c];
    for (int t = 0; t < T; ++t) {
        if (tid < 64) { const float x = bf2f(ng) + gkb; const float gk = -softplusf_(-x) * (1.f / 16.f); sq[tid] = bf2f(nq) * 0.125f; sk[tid] = bf2f(nk); se[tid] = __expf(gk); }
        const float v = bf2f(nv), go = bf2f(ngo);
        if (t + 1 < T) { const bf16* pn = prow + (size_t)(t + 1) * NIN_E;
            if (tid < 64) { nq = pn[h * 64 + tid]; nk = pn[256 + h * 64 + tid]; ng = pn[2560 + h * 64 + tid]; }
            nv = pn[512 + h * 128 + c]; if (kq == 0) ngo = pn[1024 + h * 128 + c]; }
        __syncthreads();
        float part = 0.f;
#pragma unroll
        for (int i = 0; i < 16; ++i) { S[i] = se[d0 + i] * S[i] + sk[d0 + i] * v; part += sq[d0 + i] * S[i]; }
        red[kq * 128 + c] = part;
        __syncthreads();
        float o = 0.f;
        if (kq == 0) { o = (red[c] + red[128 + c]) + (red[256 + c] + red[384 + c]); const float ss = wave_sum(o * o); if (lane == 0) wss[wave] = ss; }
        __syncthreads();
        if (kq == 0) { const float tot = wss[0] + wss[1]; const float r = 1.0f / sqrtf(tot * (1.f / 128.f) + EPS);
            mixed[(size_t)(b * T + t) * D + h * 128 + c] = f2bf(o * r * siluf_(go)); }
    }
    __syncthreads();
}
__device__ __forceinline__ void lru_seq_unit(const Args& a, int jl, int b, int n, const bf16* proj, bf16* mixed, LAS unsigned char* lds, int tid) {
    LAS float* sxr = (LAS float*)lds; LAS float* sig = sxr + 128;
    const bool act = tid < 256; const int j = tid & 127, gsel = (tid >> 7) & 1, ch = n * 128 + j;
    float w[128];
    {
        const float* wp = (gsel ? a.in[I_LRU_W_X] : a.in[I_LRU_W_A]) + ((size_t)(jl * 4 + n) * 128) * 128 + j;
#pragma unroll
        for (int i = 0; i < 128; ++i) w[i] = act ? wp[i * 128] : 0.f;
    }
    const float bias = (gsel ? a.in[I_LRU_B_X] : a.in[I_LRU_B_A])[jl * 512 + ch];
    const float cw0 = a.in[I_LRU_CONV_W][(jl * 4 + 0) * 512 + ch], cw1 = a.in[I_LRU_CONV_W][(jl * 4 + 1) * 512 + ch], cw2 = a.in[I_LRU_CONV_W][(jl * 4 + 2) * 512 + ch], cw3 = a.in[I_LRU_CONV_W][(jl * 4 + 3) * 512 + ch];
    const float cb = a.in[I_LRU_CONV_B][jl * 512 + ch];
    const float sp8 = 8.0f * softplusf_(-a.in[I_LRU_LAMBDA][jl * 512 + ch]);
    float x1 = 0.f, x2 = 0.f, x3 = 0.f, hst = 0.f;
    const bf16* prow = proj + (size_t)b * T * NIN_E;
    bf16 nx = 0, ngt = 0;
    if (tid < 128) { nx = prow[1536 + ch]; ngt = prow[2048 + ch]; }
    for (int t = 0; t < T; ++t) {
        float xr = 0.f, gate = 0.f;
        if (tid < 128) { const float x0 = bf2f(nx); gate = bf2f(ngt); xr = cw0 * x3 + cw1 * x2 + cw2 * x1 + cw3 * x0 + cb; x3 = x2; x2 = x1; x1 = x0; sxr[tid] = xr;
            if (t + 1 < T) { const bf16* pn = prow + (size_t)(t + 1) * NIN_E; nx = pn[1536 + ch]; ngt = pn[2048 + ch]; } }
        __syncthreads();
        float dot = bias;
        if (act) {
#pragma unroll
            for (int i4 = 0; i4 < 32; ++i4) { const f32x4 xv = ((const LAS f32x4*)sxr)[i4]; dot += xv.x * w[4 * i4] + xv.y * w[4 * i4 + 1] + xv.z * w[4 * i4 + 2] + xv.w * w[4 * i4 + 3]; }
        }
        const float sg = sigmoidf_(dot);
        if (act && gsel == 1) sig[j] = sg;
        __syncthreads();
        if (tid < 128) { const float ig = sig[j]; const float log_a = -sp8 * sg; const float av = __expf(log_a); const float u = sqrtf(-expm1f(2.0f * log_a)) * (ig * xr);
            hst = av * hst + u; mixed[(size_t)(b * T + t) * D + 512 + ch] = f2bf(hst * gelu_tanh(gate)); }
    }
    __syncthreads();
}
__device__ __forceinline__ void gdn_seq_unit(const Args& a, int jl, int b, int h, const bf16* proj, const float* BA, bf16* mixed, LAS unsigned char* lds, int tid) {
    LAS float* sq = (LAS float*)lds; LAS float* sk = sq + 128; LAS float* sv = sk + 128; LAS float* red = sv + 128; LAS float* red2 = red + 512; LAS float* wss = red2 + 512; LAS float* wss2 = wss + 8;
    const int c = tid & 127, kq = tid >> 7, d0 = kq * 32, lane = tid & 63, wave = tid >> 6;
    float S[32];
#pragma unroll
    for (int i = 0; i < 32; ++i) S[i] = 0.f;
    const int col = (kq < 3 ? kq : 3) * 1024 + h * 128 + c;
    float cw0 = 0.f, cw1 = 0.f, cw2 = 0.f, cw3 = 0.f;
    if (kq < 3) { const float* cwp = a.in[I_GDN_CONV_W] + (size_t)jl * 4 * 3072 + col; cw0 = cwp[0]; cw1 = cwp[3072]; cw2 = cwp[2 * 3072]; cw3 = cwp[3 * 3072]; }
    const float Aneg = -__expf(a.in[I_GDN_A_LOG][jl * 8 + h]), dtb = a.in[I_GDN_DT_BIAS][jl * 8 + h];
    float x1 = 0.f, x2 = 0.f, x3 = 0.f;
    const bf16* prow = proj + (size_t)b * T * NIN_O; const float* barow = BA + (size_t)b * T * 16;
    bf16 nx = prow[col]; float nb = barow[h], na = barow[8 + h];
    for (int t = 0; t < T; ++t) {
        const float x0 = bf2f(nx); const float beta = sigmoidf_(nb); const float eg = __expf(Aneg * softplusf_(na + dtb));
        if (t + 1 < T) { nx = prow[(size_t)(t + 1) * NIN_O + col]; nb = barow[(t + 1) * 16 + h]; na = barow[(t + 1) * 16 + 8 + h]; }
        float y = 0.f;
        if (kq < 3) { y = cw0 * x3 + cw1 * x2 + cw2 * x1 + cw3 * x0; x3 = x2; x2 = x1; x1 = x0; y = siluf_(y); }
        if (kq == 0) sq[c] = y; else if (kq == 1) sk[c] = y; else if (kq == 2) sv[c] = y;
        { const float ss = wave_sum(y * y); if (lane == 0) wss[wave] = ss; }
        __syncthreads();
        const float nqf = (1.0f / sqrtf(wss[0] + wss[1] + EPS)) * 0.08838834764831845f, nkf = 1.0f / sqrtf(wss[2] + wss[3] + EPS);
        float part = 0.f;
#pragma unroll
        for (int i = 0; i < 32; ++i) { S[i] *= eg; part += sk[d0 + i] * S[i]; }
        red[kq * 128 + c] = part * nkf;
        __syncthreads();
        const float kS = (red[c] + red[128 + c]) + (red[256 + c] + red[384 + c]);
        const float vnew = beta * (sv[c] - kS) * nkf;
        float opart = 0.f;
#pragma unroll
        for (int i = 0; i < 32; ++i) { S[i] += sk[d0 + i] * vnew; opart += sq[d0 + i] * S[i]; }
        red2[kq * 128 + c] = opart * nqf;
        __syncthreads();
        float o = 0.f;
        if (kq == 3) { o = (red2[c] + red2[128 + c]) + (red2[256 + c] + red2[384 + c]); const float ss = wave_sum(o * o); if (lane == 0) wss2[wave - 6] = ss; }
        __syncthreads();
        if (kq == 3) { const float tot = wss2[0] + wss2[1]; const float r = 1.0f / sqrtf(tot * (1.f / 128.f) + EPS);
            mixed[(size_t)(b * T + t) * D + h * 128 + c] = f2bf(o * r * siluf_(x0)); }
    }
    __syncthreads();
}

#define MFMA32(a_, b_, c_) __builtin_amdgcn_mfma_f32_32x32x16_bf16((a_), (b_), (c_), 0, 0, 0)
__device__ __forceinline__ bf16x8 pack8(const f32x16& x, int s) {
    v4u p; p.x = pk2(x[8 * s], x[8 * s + 1]); p.y = pk2(x[8 * s + 2], x[8 * s + 3]); p.z = pk2(x[8 * s + 4], x[8 * s + 5]); p.w = pk2(x[8 * s + 6], x[8 * s + 7]);
    return __builtin_bit_cast(bf16x8, p);
}
__device__ __forceinline__ void attn_unit(int l, int pm, int h, bf16* QO, const bf16* Kall, const bf16* Vt, int wave, int lane) {
    const int b = pm >> 3, r = lane & 31, hh = lane >> 5, row = pm * 256 + wave * 32 + r;
    bf16* qrow = QO + (size_t)row * D + h * 256;
    bf16x8 qf[16];
#pragma unroll
    for (int s = 0; s < 16; ++s) qf[s] = *(const GAS bf16x8*)(qrow + 16 * s + 8 * hh);
    f32x16 st[8];
    const bf16* kbase = Kall + (size_t)(b * 256 + r) * 4096 + l * 1024 + h * 256 + 8 * hh;
#pragma unroll
    for (int kb = 0; kb < 8; ++kb) {
        f32x16 acc;
#pragma unroll
        for (int i = 0; i < 16; ++i) acc[i] = 0.f;
#pragma unroll
        for (int s = 0; s < 16; ++s) { const bf16x8 kf = *(const GAS bf16x8*)(kbase + (size_t)(32 * kb) * 4096 + 16 * s); acc = MFMA32(kf, qf[s], acc); }
        st[kb] = acc;
    }
    float mx = -3.0e38f;
#pragma unroll
    for (int kb = 0; kb < 8; ++kb)
#pragma unroll
        for (int i = 0; i < 16; ++i) mx = fmaxf(mx, st[kb][i]);
    mx = fmaxf(mx, __shfl_xor(mx, 32));
    float sum = 0.f;
#pragma unroll
    for (int kb = 0; kb < 8; ++kb)
#pragma unroll
        for (int i = 0; i < 16; ++i) { const float p = __expf(st[kb][i] - mx); st[kb][i] = p; sum += p; }
    sum += __shfl_xor(sum, 32);
    const float inv = 1.0f / sum;
    bf16x8 pf[8][2];
#pragma unroll
    for (int kb = 0; kb < 8; ++kb) { pf[kb][0] = pack8(st[kb], 0); pf[kb][1] = pack8(st[kb], 1); }
    const bf16* vbase = Vt + (size_t)(l * 1024 + h * 256 + r) * MMEM + b * 256 + 4 * hh;
#pragma unroll
    for (int db = 0; db < 8; ++db) {
        f32x16 y;
#pragma unroll
        for (int i = 0; i < 16; ++i) y[i] = 0.f;
#pragma unroll
        for (int kb = 0; kb < 8; ++kb)
#pragma unroll
            for (int s = 0; s < 2; ++s) {
                const bf16* vp = vbase + (size_t)(32 * db) * MMEM + 32 * kb + 16 * s;
                const s16x4 lo = *(const GAS s16x4*)vp, hi = *(const GAS s16x4*)(vp + 8);
                const bf16x8 va = __builtin_shufflevector(lo, hi, 0, 1, 2, 3, 4, 5, 6, 7);
                y = MFMA32(va, pf[kb][s], y);
            }
#pragma unroll
        for (int g = 0; g < 4; ++g) { v2u w; w.x = pk2(y[4 * g] * inv, y[4 * g + 1] * inv); w.y = pk2(y[4 * g + 2] * inv, y[4 * g + 3] * inv);
            *(GAS v2u*)(qrow + 32 * db + 8 * g + 4 * hh) = w; }
    }
}


namespace pg8 {
struct EpiGdnIn {
    static constexpr bool PERM = true, AFTER_DRAIN = false;
    bf16_t* P; bf16_t* halo;
    __device__ __forceinline__ void operator()(const f32x4 (&acc)[2][2][4][2], const Unit& u, int wr, int wc, int fr, int fq) const {
        const int row0 = u.pm * BM + wr * 64 + fr; const int t = u.pn >> 2; const int col0 = (u.pn & 3) * BM + wc * 32 + 8 * fq;
        bf16_t* base = P + (size_t)t * ((size_t)16384 * 1024);
#pragma unroll
        for (int ai = 0; ai < 2; ++ai)
#pragma unroll
            for (int m = 0; m < 4; ++m) { const int row = row0 + ai * HALF + m * 16; bf16_t* rowp = base + (size_t)row * 1024 + col0;
#pragma unroll
                for (int bj = 0; bj < 2; ++bj) { const f32x4 v0 = acc[ai][bj][m][0], v1 = acc[ai][bj][m][1];
                    u32x4 w; w.x = pk_bf16(v0[0], v0[1]); w.y = pk_bf16(v0[2], v0[3]); w.z = pk_bf16(v1[0], v1[1]); w.w = pk_bf16(v1[2], v1[3]);
                    *(u32x4*)(rowp + bj * HALF) = w;
                    if (m == 3 && t < 3 && fr >= 13) *(u32x4*)(halo + (((size_t)t * 257 + (row >> 6) + 1) * 3 + (fr - 13)) * 1024 + col0 + bj * HALF) = w; } }
    }
};
}

__device__ __forceinline__ int crow(int reg, int hh) { return (reg & 3) + 8 * (reg >> 2) + 4 * hh; }
__device__ __forceinline__ s16x4 tr4(const LAS unsigned char* img, int RS, int rowbase, int col0, int lane) {
    const int blk = (lane >> 4) & 1, q = (lane & 15) >> 2, p = lane & 3;
    return __builtin_amdgcn_ds_read_tr16_b64_v4i16((LAS s16x4*)(img + (rowbase + q) * RS + (col0 + 16 * blk + 4 * p) * 2));
}
__device__ __forceinline__ bf16x8 cat8(s16x4 lo, s16x4 hi) { return __builtin_shufflevector(lo, hi, 0, 1, 2, 3, 4, 5, 6, 7); }
__device__ __forceinline__ bf16x8 ldperm(const LAS unsigned char* p) { return cat8(*(const LAS s16x4*)p, *(const LAS s16x4*)(p + 16)); }

constexpr int RS128 = 272, RS64 = 144;
constexpr int GA_QI = 0, GA_KI = 17408, GA_RK = 34816, GA_RV = 67584, GA_MM = 100352, GA_SC = 116736;
constexpr size_t PSZ = (size_t)M * 1024;

__device__ __forceinline__ void gdn_a_unit(const Args& a, int jl, int unit, unsigned char* ws, LAS unsigned char* lds, int tid) {
    const int lane = tid & 63, wave = __builtin_amdgcn_readfirstlane(tid >> 6);
    const int b = unit >> 8, h = (unit >> 5) & 7, n = unit & 31;
    const int rowbase = b * T + n * 64, gcidx = b * 32 + n;
    bf16* Pq = (bf16*)(ws + WS_R); const bf16* halo = (const bf16*)(ws + WS_HALO);
    LAS float* SCb = (LAS float*)(lds + GA_SC); LAS float* SCg = SCb + 64;
    if (wave == 0) {
        const float* ba = (const float*)(ws + WS_BA) + (size_t)(rowbase + lane) * 16;
        const float beta = sigmoidf_(ba[h]);
        const float Aneg = -__expf(a.in[I_GDN_A_LOG][jl * 8 + h]), dtb = a.in[I_GDN_DT_BIAS][jl * 8 + h];
        float g = Aneg * softplusf_(ba[8 + h] + dtb);
#pragma unroll
        for (int o = 1; o < 64; o <<= 1) { const float v = __shfl_up(g, o); if (lane >= o) g += v; }
        const float gl = __shfl(g, 63);
        SCb[lane] = beta; SCg[lane] = g;
        float* sc = (float*)(ws + WS_SCAL) + (size_t)unit * 128; sc[lane] = __expf(g); sc[64 + lane] = __expf(gl - g);
    }
    __syncthreads();
#pragma unroll
    for (int m = 0; m < 6; ++m) {
        const int x = m >> 1, tok = (tid >> 4) + 32 * (m & 1), grp = tid & 15, col = h * 128 + grp * 8;
        const bf16* Px = Pq + (size_t)x * PSZ;
        float y[8];
#pragma unroll
        for (int c = 0; c < 8; ++c) y[c] = 0.f;
#pragma unroll
        for (int kk = 0; kk < 4; ++kk) {
            const int tt = tok - 3 + kk;
            v4u raw = {0u, 0u, 0u, 0u};
            if (tt >= 0) raw = *(const GAS v4u*)(Px + (size_t)(rowbase + tt) * 1024 + col);
            else if (n > 0) raw = *(const GAS v4u*)(halo + (((size_t)x * 257 + gcidx) * 3 + (tt + 3)) * 1024 + col);
            const float* cwp = a.in[I_GDN_CONV_W] + (size_t)(jl * 4 + kk) * 3072 + x * 1024 + col;
            const f32x4 c0 = *(const GAS f32x4*)cwp, c1 = *(const GAS f32x4*)(cwp + 4);
            y[0] += c0.x * bflo(raw.x); y[1] += c0.y * bfhi(raw.x); y[2] += c0.z * bflo(raw.y); y[3] += c0.w * bfhi(raw.y);
            y[4] += c1.x * bflo(raw.z); y[5] += c1.y * bfhi(raw.z); y[6] += c1.z * bflo(raw.w); y[7] += c1.w * bfhi(raw.w);
        }
        float ss = 0.f;
#pragma unroll
        for (int c = 0; c < 8; ++c) { y[c] = siluf_(y[c]); ss += y[c] * y[c]; }
        if (x < 2) {
            ss += __shfl_xor(ss, 1); ss += __shfl_xor(ss, 2); ss += __shfl_xor(ss, 4); ss += __shfl_xor(ss, 8);
            const float rr = (1.0f / sqrtf(ss + EPS)) * (x == 0 ? 0.08838834764831845f : 1.0f);
#pragma unroll
            for (int c = 0; c < 8; ++c) y[c] *= rr;
            v4u w; w.x = pk2(y[0], y[1]); w.y = pk2(y[2], y[3]); w.z = pk2(y[4], y[5]); w.w = pk2(y[6], y[7]);
            *(LAS v4u*)(lds + (x == 0 ? GA_QI : GA_KI) + tok * RS128 + grp * 16) = w;
        }
        if (x >= 1) {
            const float f = (x == 1) ? SCb[tok] * __expf(SCg[tok]) : SCb[tok];
            LAS f32x4* dst = (LAS f32x4*)(lds + (x == 1 ? GA_RK : GA_RV) + (tok * 128 + grp * 8) * 4);
            dst[0] = (f32x4){y[0] * f, y[1] * f, y[2] * f, y[3] * f}; dst[1] = (f32x4){y[4] * f, y[5] * f, y[6] * f, y[7] * f};
        }
    }
    __syncthreads();
    {
        const int which = wave >> 2, it = (wave >> 1) & 1, jt = wave & 1, r = lane & 31, hh = lane >> 5;
        if (!(it == 0 && jt == 1)) {
            f32x16 acc;
#pragma unroll
            for (int i = 0; i < 16; ++i) acc[i] = 0.f;
            const LAS unsigned char* Ap = lds + (which ? GA_QI : GA_KI) + (32 * it + r) * RS128 + 16 * hh;
            const LAS unsigned char* Bp = lds + GA_KI + (32 * jt + r) * RS128 + 16 * hh;
#pragma unroll
            for (int s = 0; s < 8; ++s) acc = MFMA32(*(const LAS bf16x8*)(Ap + 32 * s), *(const LAS bf16x8*)(Bp + 32 * s), acc);
            const int tj = 32 * jt + r; const float gj = SCg[tj];
            LAS float* MMp = (LAS float*)(lds + GA_MM); bf16* aq = (bf16*)(ws + WS_AQK) + (size_t)unit * 4096;
#pragma unroll
            for (int i = 0; i < 16; ++i) {
                const int ti = 32 * it + crow(i, hh); const float e = __expf(SCg[ti] - gj);
                if (which == 0) MMp[ti * 64 + tj] = (tj < ti) ? SCb[ti] * acc[i] * e : 0.f;
                else aq[ti * 64 + tj] = f2bf((tj <= ti) ? acc[i] * e : 0.f);
            }
        }
    }
    __syncthreads();
    if (wave < 4) {
        const int c = (wave & 1) * 64 + lane;
        const LAS float* rhs = (const LAS float*)(lds + (wave < 2 ? GA_RK : GA_RV)) + c;
        int zoff = 0; asm volatile("" : "+v"(zoff));
        const LAS float* MMp = (const LAS float*)(lds + GA_MM) + zoff;
        float t[64];
#pragma unroll
        for (int i = 0; i < 64; ++i) t[i] = 0.f;
#pragma unroll
        for (int i = 0; i < 64; ++i) {
            float s = rhs[i * 128];
#pragma unroll
            for (int j4 = 0; j4 < (i + 3) / 4; ++j4) { const f32x4 mq = *(const LAS f32x4*)(MMp + i * 64 + 4 * j4);
                s -= mq.x * t[4 * j4]; if (4 * j4 + 1 < i) s -= mq.y * t[4 * j4 + 1]; if (4 * j4 + 2 < i) s -= mq.z * t[4 * j4 + 2]; if (4 * j4 + 3 < i) s -= mq.w * t[4 * j4 + 3]; }
            t[i] = s;
        }
        if (wave < 2) {
            bf16* wn = (bf16*)(ws + WS_ACT) + (size_t)unit * 8192 + c;
#pragma unroll
            for (int i = 0; i < 64; ++i) wn[i * 128] = f2bf(-t[i]);
        } else {
            const int w = c >> 5, r = c & 31;
#pragma unroll
            for (int it = 0; it < 2; ++it)
#pragma unroll
                for (int hh = 0; hh < 2; ++hh) {
                    const int o = ((w * 2 + it) * 64 + hh * 32 + r) * 32;
                    unsigned char* dst = (unsigned char*)(Pq + 2 * PSZ) + ((size_t)(rowbase + (o >> 8)) * 1024 + h * 128) * 2 + (o & 255);
                    v4u w0, w1;
                    w0.x = pk2(t[32 * it + crow(0, hh)], t[32 * it + crow(1, hh)]); w0.y = pk2(t[32 * it + crow(2, hh)], t[32 * it + crow(3, hh)]);
                    w0.z = pk2(t[32 * it + crow(4, hh)], t[32 * it + crow(5, hh)]); w0.w = pk2(t[32 * it + crow(6, hh)], t[32 * it + crow(7, hh)]);
                    w1.x = pk2(t[32 * it + crow(8, hh)], t[32 * it + crow(9, hh)]); w1.y = pk2(t[32 * it + crow(10, hh)], t[32 * it + crow(11, hh)]);
                    w1.z = pk2(t[32 * it + crow(12, hh)], t[32 * it + crow(13, hh)]); w1.w = pk2(t[32 * it + crow(14, hh)], t[32 * it + crow(15, hh)]);
                    *(GAS v4u*)dst = w0; *(GAS v4u*)(dst + 16) = w1;
                }
        }
    } else {
        const int lt = tid - 256;
#pragma unroll
        for (int k = 0; k < 8; ++k) {
            const int cidx = lt + 256 * k, x = cidx >> 10, row = (cidx >> 4) & 63, ch = cidx & 15;
            const v4u v = *(const LAS v4u*)(lds + (x ? GA_KI : GA_QI) + row * RS128 + ch * 16);
            *(GAS v4u*)(Pq + (size_t)x * PSZ + (size_t)(rowbase + row) * 1024 + h * 128 + ch * 8) = v;
        }
    }
    __syncthreads();
}

constexpr int GB_QI = 0, GB_KI = 17408, GB_WI = 34816, GB_AI = 52224, GB_OB0 = 61440, GB_OB1 = 78848, GB_SC = 96256;
__device__ __forceinline__ void gdn_b_unit(int bh, unsigned char* ws, LAS unsigned char* lds, int tid) {
    const int lane = tid & 63, wave = __builtin_amdgcn_readfirstlane(tid >> 6), r = lane & 31, hh = lane >> 5;
    const int b = bh >> 3, h = bh & 7;
    bf16* Pq = (bf16*)(ws + WS_R); bf16* Pk = Pq + PSZ; bf16* Pv = Pq + 2 * PSZ; bf16* Pz = Pq + 3 * PSZ;
    const bf16* Wn = (const bf16*)(ws + WS_ACT); const bf16* Aq = (const bf16*)(ws + WS_AQK); const float* Sc = (const float*)(ws + WS_SCAL);
    const bool comp = wave < 4;
    const int lt = tid & 255;
    f32x16 S[4];
#pragma unroll
    for (int dt = 0; dt < 4; ++dt)
#pragma unroll
        for (int i = 0; i < 16; ++i) S[dt][i] = 0.f;
    v4u pq[4], pk[4], pw[4], pa[2], zc[4], zn[4]; f32x4 psc = {0.f, 0.f, 0.f, 0.f};
#define GB_LOAD(nn) do { const int un_ = bh * 32 + (nn); const size_t rb_ = (size_t)(b * T + (nn) * 64); \
        _Pragma("unroll") for (int k = 0; k < 4; ++k) { const int ci = lt + 256 * k, row = ci >> 4, ch = ci & 15; \
            pq[k] = *(const GAS v4u*)(Pq + (rb_ + row) * 1024 + h * 128 + ch * 8); pk[k] = *(const GAS v4u*)(Pk + (rb_ + row) * 1024 + h * 128 + ch * 8); \
            pw[k] = *(const GAS v4u*)(Wn + (size_t)un_ * 8192 + row * 128 + ch * 8); } \
        _Pragma("unroll") for (int k = 0; k < 2; ++k) { const int ci = lt + 256 * k, row = ci >> 3, ch = ci & 7; pa[k] = *(const GAS v4u*)(Aq + (size_t)un_ * 4096 + row * 64 + ch * 8); } \
        if (lt < 32) psc = *(const GAS f32x4*)(Sc + (size_t)un_ * 128 + lt * 4); } while (0)
#define GB_STORE() do { \
        _Pragma("unroll") for (int k = 0; k < 4; ++k) { const int ci = lt + 256 * k, row = ci >> 4, ch = ci & 15; \
            *(LAS v4u*)(lds + GB_QI + row * RS128 + ch * 16) = pq[k]; *(LAS v4u*)(lds + GB_KI + row * RS128 + ch * 16) = pk[k]; *(LAS v4u*)(lds + GB_WI + row * RS128 + ch * 16) = pw[k]; } \
        _Pragma("unroll") for (int k = 0; k < 2; ++k) { const int ci = lt + 256 * k, row = ci >> 3, ch = ci & 7; *(LAS v4u*)(lds + GB_AI + row * RS64 + ch * 16) = pa[k]; } \
        if (lt < 32) *(LAS f32x4*)(lds + GB_SC + lt * 16) = psc; } while (0)
#define GB_LOADZ(dst, nn) do { const bf16* zp_ = Pz + (size_t)(b * T + (nn) * 64 + (lt >> 2)) * 1024 + h * 128 + (lt & 3) * 32; \
        _Pragma("unroll") for (int k = 0; k < 4; ++k) dst[k] = *(const GAS v4u*)(zp_ + 8 * k); } while (0)
#define GB_EPI(zr, nn) do { const int tok_ = lt >> 2, qt_ = lt & 3; const LAS unsigned char* ob_ = lds + (((nn) & 1) ? GB_OB1 : GB_OB0) + tok_ * RS128 + qt_ * 64; \
        v4u ov_[4]; float ss_ = 0.f; \
        _Pragma("unroll") for (int k = 0; k < 4; ++k) { ov_[k] = *(const LAS v4u*)(ob_ + 16 * k); \
            ss_ += bflo(ov_[k].x) * bflo(ov_[k].x) + bfhi(ov_[k].x) * bfhi(ov_[k].x) + bflo(ov_[k].y) * bflo(ov_[k].y) + bfhi(ov_[k].y) * bfhi(ov_[k].y) \
                 + bflo(ov_[k].z) * bflo(ov_[k].z) + bfhi(ov_[k].z) * bfhi(ov_[k].z) + bflo(ov_[k].w) * bflo(ov_[k].w) + bfhi(ov_[k].w) * bfhi(ov_[k].w); } \
        ss_ += __shfl_xor(ss_, 1); ss_ += __shfl_xor(ss_, 2); \
        const float rr_ = 1.0f / sqrtf(ss_ * (1.f / 128.f) + EPS); \
        bf16* op_ = Pz + (size_t)(b * T + (nn) * 64 + tok_) * 1024 + h * 128 + qt_ * 32; \
        _Pragma("unroll") for (int k = 0; k < 4; ++k) { v4u w_; \
            w_.x = pk2(bflo(ov_[k].x) * rr_ * siluf_(bflo(zr[k].x)), bfhi(ov_[k].x) * rr_ * siluf_(bfhi(zr[k].x))); \
            w_.y = pk2(bflo(ov_[k].y) * rr_ * siluf_(bflo(zr[k].y)), bfhi(ov_[k].y) * rr_ * siluf_(bfhi(zr[k].y))); \
            w_.z = pk2(bflo(ov_[k].z) * rr_ * siluf_(bflo(zr[k].z)), bfhi(ov_[k].z) * rr_ * siluf_(bfhi(zr[k].z))); \
            w_.w = pk2(bflo(ov_[k].w) * rr_ * siluf_(bflo(zr[k].w)), bfhi(ov_[k].w) * rr_ * siluf_(bfhi(zr[k].w))); \
            *(GAS v4u*)(op_ + 8 * k) = w_; } } while (0)
    if (comp) {
        for (int n = 0; n < 32; ++n) {
            __syncthreads();
            const int w = wave;
            bf16x8 Sb[4][2];
#pragma unroll
            for (int dt = 0; dt < 4; ++dt) { Sb[dt][0] = pack8(S[dt], 0); Sb[dt][1] = pack8(S[dt], 1); }
            f32x16 Vn[2];
#pragma unroll
            for (int it = 0; it < 2; ++it) {
                const int o = ((w * 2 + it) * 64 + lane) * 32;
                const unsigned char* up = (const unsigned char*)Pv + ((size_t)(b * T + n * 64 + (o >> 8)) * 1024 + h * 128) * 2 + (o & 255);
                const v4u u0 = *(const GAS v4u*)up, u1 = *(const GAS v4u*)(up + 16);
                Vn[it][0] = bflo(u0.x); Vn[it][1] = bfhi(u0.x); Vn[it][2] = bflo(u0.y); Vn[it][3] = bfhi(u0.y); Vn[it][4] = bflo(u0.z); Vn[it][5] = bfhi(u0.z); Vn[it][6] = bflo(u0.w); Vn[it][7] = bfhi(u0.w);
                Vn[it][8] = bflo(u1.x); Vn[it][9] = bfhi(u1.x); Vn[it][10] = bflo(u1.y); Vn[it][11] = bfhi(u1.y); Vn[it][12] = bflo(u1.z); Vn[it][13] = bfhi(u1.z); Vn[it][14] = bflo(u1.w); Vn[it][15] = bfhi(u1.w);
            }
#pragma unroll
            for (int it = 0; it < 2; ++it)
#pragma unroll
                for (int dt = 0; dt < 4; ++dt)
#pragma unroll
                    for (int s = 0; s < 2; ++s) Vn[it] = MFMA32(ldperm(lds + GB_WI + (32 * it + r) * RS128 + (32 * dt + 16 * s + 4 * hh) * 2), Sb[dt][s], Vn[it]);
            const LAS float* scp = (const LAS float*)(lds + GB_SC);
            bf16x8 Vb[2][2], Vb2[2][2];
#pragma unroll
            for (int it = 0; it < 2; ++it) {
                Vb[it][0] = pack8(Vn[it], 0); Vb[it][1] = pack8(Vn[it], 1);
                f32x16 vs;
#pragma unroll
                for (int g = 0; g < 4; ++g) { const f32x4 e4 = *(const LAS f32x4*)(scp + 64 + 32 * it + 8 * g + 4 * hh);
                    vs[4 * g] = Vn[it][4 * g] * e4.x; vs[4 * g + 1] = Vn[it][4 * g + 1] * e4.y; vs[4 * g + 2] = Vn[it][4 * g + 2] * e4.z; vs[4 * g + 3] = Vn[it][4 * g + 3] * e4.w; }
                Vb2[it][0] = pack8(vs, 0); Vb2[it][1] = pack8(vs, 1);
            }
            LAS unsigned char* ob = lds + ((n & 1) ? GB_OB1 : GB_OB0);
#pragma unroll
            for (int it = 0; it < 2; ++it) {
                f32x16 O;
#pragma unroll
                for (int i = 0; i < 16; ++i) O[i] = 0.f;
#pragma unroll
                for (int dt = 0; dt < 4; ++dt)
#pragma unroll
                    for (int s = 0; s < 2; ++s) O = MFMA32(ldperm(lds + GB_QI + (32 * it + r) * RS128 + (32 * dt + 16 * s + 4 * hh) * 2), Sb[dt][s], O);
#pragma unroll
                for (int g = 0; g < 4; ++g) { const f32x4 e4 = *(const LAS f32x4*)(scp + 32 * it + 8 * g + 4 * hh);
                    O[4 * g] *= e4.x; O[4 * g + 1] *= e4.y; O[4 * g + 2] *= e4.z; O[4 * g + 3] *= e4.w; }
#pragma unroll
                for (int jt = 0; jt <= it; ++jt)
#pragma unroll
                    for (int s = 0; s < 2; ++s) O = MFMA32(ldperm(lds + GB_AI + (32 * it + r) * RS64 + (32 * jt + 16 * s + 4 * hh) * 2), Vb[jt][s], O);
#pragma unroll
                for (int i = 0; i < 16; ++i) *(LAS bf16*)(ob + (32 * it + crow(i, hh)) * RS128 + (32 * w + r) * 2) = f2bf(O[i]);
            }
            const float decay = scp[63];
#pragma unroll
            for (int dt = 0; dt < 4; ++dt) {
#pragma unroll
                for (int i = 0; i < 16; ++i) S[dt][i] *= decay;
#pragma unroll
                for (int it = 0; it < 2; ++it)
#pragma unroll
                    for (int s = 0; s < 2; ++s) {
                        const int rowb = 32 * it + 16 * s + 4 * hh;
                        S[dt] = MFMA32(cat8(tr4(lds + GB_KI, RS128, rowb, 32 * dt, lane), tr4(lds + GB_KI, RS128, rowb + 8, 32 * dt, lane)), Vb2[it][s], S[dt]);
                    }
            }
            __syncthreads();
        }
    } else {
#pragma unroll
        for (int k = 0; k < 4; ++k) zn[k] = (v4u){0u, 0u, 0u, 0u};
        GB_LOAD(0); GB_STORE();
        for (int n = 0; n < 32; ++n) {
            __syncthreads();
#pragma unroll
            for (int k = 0; k < 4; ++k) zc[k] = zn[k];
            if (n + 1 < 32) GB_LOAD(n + 1);
            GB_LOADZ(zn, n);
            if (n >= 1) GB_EPI(zc, n - 1);
            __syncthreads();
            if (n + 1 < 32) GB_STORE();
        }
    }
    __syncthreads();
    if (!comp) GB_EPI(zn, 31);
    __syncthreads();
#undef GB_LOAD
#undef GB_STORE
#undef GB_LOADZ
#undef GB_EPI
}

constexpr size_t WS_GQT = WS_R + 88 * MiB;
constexpr size_t WS_GKB = WS_R + 96 * MiB;
constexpr size_t WS_GOI = WS_R + 104 * MiB;
constexpr size_t WS_XR = WS_R + 120 * MiB;
constexpr int EA_QT = 0, EA_KH = 9216, EA_VI = 18432, EA_PFX = 35840;
__device__ __forceinline__ void gla_a_unit(const Args& a, int jl, int unit, unsigned char* ws, LAS unsigned char* lds, int tid) {
    const int lane = tid & 63, wave = __builtin_amdgcn_readfirstlane(tid >> 6), r = lane & 31, hh = lane >> 5;
    const int b = unit >> 7, h = (unit >> 5) & 3, n = unit & 31;
    const size_t rowbase = (size_t)b * T + n * 64;
    const bf16* proj = (const bf16*)(ws + WS_R);
    LAS float* PFX = (LAS float*)(lds + EA_PFX);
    {
        const int d = lane; const float gkb = a.in[I_GK_B][jl * 256 + h * 64 + d];
        float c[8]; float run = 0.f; float qv[8], kv[8];
#pragma unroll
        for (int e = 0; e < 8; ++e) {
            const bf16* pr = proj + (rowbase + 8 * wave + e) * NIN_E;
            const float x = bf2f(pr[2560 + h * 64 + d]) + gkb;
            run += -softplusf_(-x) * (1.f / 16.f); c[e] = run;
            qv[e] = bf2f(pr[h * 64 + d]); kv[e] = bf2f(pr[256 + h * 64 + d]);
        }
        PFX[wave * 64 + d] = run;
        __syncthreads();
        float pre = 0.f, tot = 0.f;
#pragma unroll
        for (int w2 = 0; w2 < 8; ++w2) { const float v = PFX[w2 * 64 + d]; tot += v; if (w2 < wave) pre += v; }
        bf16* qg = (bf16*)(ws + WS_GQT) + (size_t)unit * 4096; bf16* kg = (bf16*)(ws + WS_GKB) + (size_t)unit * 4096;
#pragma unroll
        for (int e = 0; e < 8; ++e) {
            const int tok = 8 * wave + e; const float bb = pre + c[e];
            const bf16 qt = f2bf(qv[e] * 0.125f * __expf(bb)), kh = f2bf(kv[e] * __expf(-bb)), kb = f2bf(kv[e] * __expf(tot - bb));
            *(LAS bf16*)(lds + EA_QT + tok * RS64 + d * 2) = qt; *(LAS bf16*)(lds + EA_KH + tok * RS64 + d * 2) = kh;
            qg[tok * 64 + d] = qt; kg[tok * 64 + d] = kb;
        }
        if (wave == 0) ((float*)(ws + WS_SCAL))[(size_t)unit * 64 + d] = __expf(tot);
    }
#pragma unroll
    for (int k = 0; k < 2; ++k) { const int ci = tid + 512 * k, row = ci >> 4, ch = ci & 15;
        *(LAS v4u*)(lds + EA_VI + row * RS128 + ch * 16) = *(const GAS v4u*)(proj + (rowbase + row) * NIN_E + 512 + h * 128 + ch * 8); }
    __syncthreads();
    {
        const int it = wave >> 2, dvt = wave & 3;
        f32x16 O;
#pragma unroll
        for (int i = 0; i < 16; ++i) O[i] = 0.f;
#pragma unroll
        for (int jt = 0; jt < 2; ++jt) {
            if (jt <= it) {
                f32x16 X;
#pragma unroll
                for (int i = 0; i < 16; ++i) X[i] = 0.f;
#pragma unroll
                for (int s = 0; s < 4; ++s) X = MFMA32(*(const LAS bf16x8*)(lds + EA_KH + (32 * jt + r) * RS64 + (16 * s + 8 * hh) * 2), *(const LAS bf16x8*)(lds + EA_QT + (32 * it + r) * RS64 + (16 * s + 8 * hh) * 2), X);
#pragma unroll
                for (int i = 0; i < 16; ++i) X[i] = (32 * jt + crow(i, hh) <= 32 * it + r) ? X[i] : 0.f;
#pragma unroll
                for (int s = 0; s < 2; ++s) {
                    const int rowb = 32 * jt + 16 * s + 4 * hh;
                    O = MFMA32(pack8(X, s), cat8(tr4(lds + EA_VI, RS128, rowb, 32 * dvt, lane), tr4(lds + EA_VI, RS128, rowb + 8, 32 * dvt, lane)), O);
                }
            }
        }
        v4u w0, w1;
        w0.x = pk2(O[0], O[1]); w0.y = pk2(O[2], O[3]); w0.z = pk2(O[4], O[5]); w0.w = pk2(O[6], O[7]);
        w1.x = pk2(O[8], O[9]); w1.y = pk2(O[10], O[11]); w1.z = pk2(O[12], O[13]); w1.w = pk2(O[14], O[15]);
        unsigned char* dst = ws + WS_GOI + ((size_t)unit * 8 + it * 4 + dvt) * 2048 + lane * 32;
        *(GAS v4u*)dst = w0; *(GAS v4u*)(dst + 16) = w1;
    }
    __syncthreads();
}
__device__ __forceinline__ void lru_conv_unit(const Args& a, int jl, int unit, unsigned char* ws, int tid) {
    const int b = unit >> 7, tile = (unit >> 2) & 31, n = unit & 3;
    const bf16* proj = (const bf16*)(ws + WS_R); bf16* xr = (bf16*)(ws + WS_XR);
#pragma unroll
    for (int m = 0; m < 2; ++m) {
        const int tok = (tid >> 4) + 32 * m, grp = tid & 15, ch = n * 128 + grp * 8;
        float y[8];
        { const f32x4 c0 = *(const GAS f32x4*)(a.in[I_LRU_CONV_B] + jl * 512 + ch), c1 = *(const GAS f32x4*)(a.in[I_LRU_CONV_B] + jl * 512 + ch + 4);
          y[0] = c0.x; y[1] = c0.y; y[2] = c0.z; y[3] = c0.w; y[4] = c1.x; y[5] = c1.y; y[6] = c1.z; y[7] = c1.w; }
#pragma unroll
        for (int kk = 0; kk < 4; ++kk) {
            const int ts = tile * 64 + tok - 3 + kk;
            v4u raw = {0u, 0u, 0u, 0u};
            if (ts >= 0) raw = *(const GAS v4u*)(proj + ((size_t)b * T + ts) * NIN_E + 1536 + ch);
            const float* cwp = a.in[I_LRU_CONV_W] + (size_t)(jl * 4 + kk) * 512 + ch;
            const f32x4 c0 = *(const GAS f32x4*)cwp, c1 = *(const GAS f32x4*)(cwp + 4);
            y[0] += c0.x * bflo(raw.x); y[1] += c0.y * bfhi(raw.x); y[2] += c0.z * bflo(raw.y); y[3] += c0.w * bfhi(raw.y);
            y[4] += c1.x * bflo(raw.z); y[5] += c1.y * bfhi(raw.z); y[6] += c1.z * bflo(raw.w); y[7] += c1.w * bfhi(raw.w);
        }
        v4u w; w.x = pk2(y[0], y[1]); w.y = pk2(y[2], y[3]); w.z = pk2(y[4], y[5]); w.w = pk2(y[6], y[7]);
        *(GAS v4u*)(xr + ((size_t)b * T + tile * 64 + tok) * 512 + ch) = w;
    }
}

constexpr int EB_QI = 0, EB_KI = 9216, EB_VI = 18432, EB_EB = 35840, EB_OB0 = 36864, EB_OB1 = 54272;
__device__ __forceinline__ void gla_b_unit(int bh, unsigned char* ws, LAS unsigned char* lds, int tid) {
    const int lane = tid & 63, wave = __builtin_amdgcn_readfirstlane(tid >> 6), r = lane & 31, hh = lane >> 5;
    const int b = bh >> 2, h = bh & 3;
    const bf16* proj = (const bf16*)(ws + WS_R); bf16* mixed = (bf16*)(ws + WS_ACT);
    const bf16* Qg = (const bf16*)(ws + WS_GQT); const bf16* Kg = (const bf16*)(ws + WS_GKB); const float* Eb = (const float*)(ws + WS_SCAL);
    const bool comp = wave < 4;
    const int lt = tid & 255;
#define EB_LOAD(nn) do { const int un_ = bh * 32 + (nn); const size_t rb_ = (size_t)b * T + (nn) * 64; \
        _Pragma("unroll") for (int k = 0; k < 2; ++k) { const int ci = lt + 256 * k; pq[k] = *(const GAS v4u*)(Qg + (size_t)un_ * 4096 + ci * 8); pk[k] = *(const GAS v4u*)(Kg + (size_t)un_ * 4096 + ci * 8); } \
        _Pragma("unroll") for (int k = 0; k < 4; ++k) { const int ci = lt + 256 * k, row = ci >> 4, ch = ci & 15; pv[k] = *(const GAS v4u*)(proj + (rb_ + row) * NIN_E + 512 + h * 128 + ch * 8); } \
        if (lt < 16) psc = *(const GAS f32x4*)(Eb + (size_t)un_ * 64 + lt * 4); } while (0)
#define EB_STORE() do { \
        _Pragma("unroll") for (int k = 0; k < 2; ++k) { const int ci = lt + 256 * k, row = ci >> 3, ch = ci & 7; *(LAS v4u*)(lds + EB_QI + row * RS64 + ch * 16) = pq[k]; *(LAS v4u*)(lds + EB_KI + row * RS64 + ch * 16) = pk[k]; } \
        _Pragma("unroll") for (int k = 0; k < 4; ++k) { const int ci = lt + 256 * k, row = ci >> 4, ch = ci & 15; *(LAS v4u*)(lds + EB_VI + row * RS128 + ch * 16) = pv[k]; } \
        if (lt < 16) *(LAS f32x4*)(lds + EB_EB + lt * 16) = psc; } while (0)
#define EB_LOADZ(dst, nn) do { const bf16* zp_ = proj + ((size_t)b * T + (nn) * 64 + (lt >> 2)) * NIN_E + 1024 + h * 128 + (lt & 3) * 32; \
        _Pragma("unroll") for (int k = 0; k < 4; ++k) dst[k] = *(const GAS v4u*)(zp_ + 8 * k); } while (0)
#define EB_EPI(zr, nn) do { const int tok_ = lt >> 2, qt_ = lt & 3; const LAS unsigned char* ob_ = lds + (((nn) & 1) ? EB_OB1 : EB_OB0) + tok_ * RS128 + qt_ * 64; \
        v4u ov_[4]; float ss_ = 0.f; \
        _Pragma("unroll") for (int k = 0; k < 4; ++k) { ov_[k] = *(const LAS v4u*)(ob_ + 16 * k); \
            ss_ += bflo(ov_[k].x) * bflo(ov_[k].x) + bfhi(ov_[k].x) * bfhi(ov_[k].x) + bflo(ov_[k].y) * bflo(ov_[k].y) + bfhi(ov_[k].y) * bfhi(ov_[k].y) \
                 + bflo(ov_[k].z) * bflo(ov_[k].z) + bfhi(ov_[k].z) * bfhi(ov_[k].z) + bflo(ov_[k].w) * bflo(ov_[k].w) + bfhi(ov_[k].w) * bfhi(ov_[k].w); } \
        ss_ += __shfl_xor(ss_, 1); ss_ += __shfl_xor(ss_, 2); \
        const float rr_ = 1.0f / sqrtf(ss_ * (1.f / 128.f) + EPS); \
        bf16* op_ = mixed + ((size_t)b * T + (nn) * 64 + tok_) * 1024 + h * 128 + qt_ * 32; \
        _Pragma("unroll") for (int k = 0; k < 4; ++k) { v4u w_; \
            w_.x = pk2(bflo(ov_[k].x) * rr_ * siluf_(bflo(zr[k].x)), bfhi(ov_[k].x) * rr_ * siluf_(bfhi(zr[k].x))); \
            w_.y = pk2(bflo(ov_[k].y) * rr_ * siluf_(bflo(zr[k].y)), bfhi(ov_[k].y) * rr_ * siluf_(bfhi(zr[k].y))); \
            w_.z = pk2(bflo(ov_[k].z) * rr_ * siluf_(bflo(zr[k].z)), bfhi(ov_[k].z) * rr_ * siluf_(bfhi(zr[k].z))); \
            w_.w = pk2(bflo(ov_[k].w) * rr_ * siluf_(bflo(zr[k].w)), bfhi(ov_[k].w) * rr_ * siluf_(bfhi(zr[k].w))); \
            *(GAS v4u*)(op_ + 8 * k) = w_; } } while (0)
    if (comp) {
        const int w = wave;
        f32x16 S[2];
#pragma unroll
        for (int dt = 0; dt < 2; ++dt)
#pragma unroll
            for (int i = 0; i < 16; ++i) S[dt][i] = 0.f;
        for (int n = 0; n < 32; ++n) {
            __syncthreads();
            bf16x8 Sb[2][2];
#pragma unroll
            for (int dt = 0; dt < 2; ++dt) { Sb[dt][0] = pack8(S[dt], 0); Sb[dt][1] = pack8(S[dt], 1); }
            LAS unsigned char* ob = lds + ((n & 1) ? EB_OB1 : EB_OB0);
#pragma unroll
            for (int it = 0; it < 2; ++it) {
                const unsigned char* up = ws + WS_GOI + ((size_t)(bh * 32 + n) * 8 + it * 4 + w) * 2048 + lane * 32;
                const v4u u0 = *(const GAS v4u*)up, u1 = *(const GAS v4u*)(up + 16);
                f32x16 O;
                O[0] = bflo(u0.x); O[1] = bfhi(u0.x); O[2] = bflo(u0.y); O[3] = bfhi(u0.y); O[4] = bflo(u0.z); O[5] = bfhi(u0.z); O[6] = bflo(u0.w); O[7] = bfhi(u0.w);
                O[8] = bflo(u1.x); O[9] = bfhi(u1.x); O[10] = bflo(u1.y); O[11] = bfhi(u1.y); O[12] = bflo(u1.z); O[13] = bfhi(u1.z); O[14] = bflo(u1.w); O[15] = bfhi(u1.w);
#pragma unroll
                for (int dt = 0; dt < 2; ++dt)
#pragma unroll
                    for (int s = 0; s < 2; ++s) O = MFMA32(ldperm(lds + EB_QI + (32 * it + r) * RS64 + (32 * dt + 16 * s + 4 * hh) * 2), Sb[dt][s], O);
#pragma unroll
                for (int i = 0; i < 16; ++i) *(LAS bf16*)(ob + (32 * it + crow(i, hh)) * RS128 + (32 * w + r) * 2) = f2bf(O[i]);
            }
            const LAS float* ebp = (const LAS float*)(lds + EB_EB);
#pragma unroll
            for (int dt = 0; dt < 2; ++dt) {
#pragma unroll
                for (int g = 0; g < 4; ++g) { const f32x4 e4 = *(const LAS f32x4*)(ebp + 32 * dt + 8 * g + 4 * hh);
                    S[dt][4 * g] *= e4.x; S[dt][4 * g + 1] *= e4.y; S[dt][4 * g + 2] *= e4.z; S[dt][4 * g + 3] *= e4.w; }
#pragma unroll
                for (int ks = 0; ks < 4; ++ks) {
                    const int rowb = 16 * ks + 8 * hh;
                    S[dt] = MFMA32(cat8(tr4(lds + EB_KI, RS64, rowb, 32 * dt, lane), tr4(lds + EB_KI, RS64, rowb + 4, 32 * dt, lane)),
                                   cat8(tr4(lds + EB_VI, RS128, rowb, 32 * w, lane), tr4(lds + EB_VI, RS128, rowb + 4, 32 * w, lane)), S[dt]);
                }
            }
            __syncthreads();
        }
    } else {
        v4u pq[2], pk[2], pv[4], zc[4], zn[4]; f32x4 psc = {0.f, 0.f, 0.f, 0.f};
#pragma unroll
        for (int k = 0; k < 4; ++k) zn[k] = (v4u){0u, 0u, 0u, 0u};
        EB_LOAD(0); EB_STORE();
        for (int n = 0; n < 32; ++n) {
            __syncthreads();
#pragma unroll
            for (int k = 0; k < 4; ++k) zc[k] = zn[k];
            if (n + 1 < 32) EB_LOAD(n + 1);
            EB_LOADZ(zn, n);
            if (n >= 1) EB_EPI(zc, n - 1);
            __syncthreads();
            if (n + 1 < 32) EB_STORE();
        }
        __syncthreads();
        EB_EPI(zn, 31);
    }
    if (comp) __syncthreads();
    __syncthreads();
#undef EB_LOAD
#undef EB_STORE
#undef EB_LOADZ
#undef EB_EPI
}

constexpr int LR_XI = 0, LR_XF = 17408, LR_GR = 25600, LR_SEG = 41984, LR_CAR = 46080;
__device__ __forceinline__ void lru_unit(const Args& a, int jl, int unit, unsigned char* ws, LAS unsigned char* lds, int tid) {
    const int lane = tid & 63, wave = __builtin_amdgcn_readfirstlane(tid >> 6), r = lane & 31, hh = lane >> 5;
    const int b = unit >> 4, n = (unit >> 2) & 3, cq = unit & 3;
    const int chin0 = n * 128, cho0 = n * 128 + cq * 32;
    const bf16* proj = (const bf16*)(ws + WS_R); const bf16* xrg = (const bf16*)(ws + WS_XR); bf16* mixed = (bf16*)(ws + WS_ACT);
    const int gate = (wave >> 1) & 1, tt = wave & 1;
    bf16x8 Bf[8];
    {
        const bf16* wt = (const bf16*)(ws + WS_LRUW) + ((size_t)((jl * 2 + gate) * 4 + n) * 128 + cq * 32 + r) * 128 + 8 * hh;
#pragma unroll
        for (int s = 0; s < 8; ++s) Bf[s] = *(const GAS bf16x8*)(wt + 16 * s);
    }
    const float bias = (gate ? a.in[I_LRU_B_X] : a.in[I_LRU_B_A])[jl * 512 + cho0 + r];
    const int c = tid & 31, seg = tid >> 5;
    const float sp8 = 8.0f * softplusf_(-a.in[I_LRU_LAMBDA][jl * 512 + cho0 + c]);
    const int ctok = tid >> 3, cg4 = (tid & 7) * 4;
    f32x4 cw[4];
#pragma unroll
    for (int kk = 0; kk < 4; ++kk) cw[kk] = *(const GAS f32x4*)(a.in[I_LRU_CONV_W] + (size_t)(jl * 4 + kk) * 512 + cho0 + cg4);
    const f32x4 cb = *(const GAS f32x4*)(a.in[I_LRU_CONV_B] + jl * 512 + cho0 + cg4);
    LAS float* XF = (LAS float*)(lds + LR_XF); LAS float* GR = (LAS float*)(lds + LR_GR); LAS float* SEG = (LAS float*)(lds + LR_SEG); LAS float* CAR = (LAS float*)(lds + LR_CAR);
    if (tid < 32) CAR[tid] = 0.f;
    for (int tile = 0; tile < 32; ++tile) {
        const size_t rowbase = (size_t)b * T + tile * 64;
#pragma unroll
        for (int k = 0; k < 2; ++k) { const int ci = tid + 512 * k, row = ci >> 4, ch = ci & 15;
            *(LAS v4u*)(lds + LR_XI + row * RS128 + ch * 16) = *(const GAS v4u*)(xrg + (rowbase + row) * 512 + chin0 + ch * 8); }
        {
            f32x4 y = cb;
#pragma unroll
            for (int kk = 0; kk < 4; ++kk) {
                const int ts = tile * 64 + ctok - 3 + kk;
                v2u raw = {0u, 0u};
                if (ts >= 0) raw = *(const GAS v2u*)(proj + ((size_t)b * T + ts) * NIN_E + 1536 + cho0 + cg4);
                y.x += cw[kk].x * bflo(raw.x); y.y += cw[kk].y * bfhi(raw.x); y.z += cw[kk].z * bflo(raw.y); y.w += cw[kk].w * bfhi(raw.y);
            }
            *(LAS f32x4*)(XF + ctok * 32 + cg4) = y;
        }
        __syncthreads();
        if (wave < 4) {
            f32x16 acc;
#pragma unroll
            for (int i = 0; i < 16; ++i) acc[i] = 0.f;
#pragma unroll
            for (int s = 0; s < 8; ++s) acc = MFMA32(*(const LAS bf16x8*)(lds + LR_XI + (32 * tt + r) * RS128 + (16 * s + 8 * hh) * 2), Bf[s], acc);
#pragma unroll
            for (int i = 0; i < 16; ++i) GR[(gate * 64 + 32 * tt + crow(i, hh)) * 32 + r] = sigmoidf_(acc[i] + bias);
        }
        __syncthreads();
        float av[4], uv[4]; float P = 1.f, H = 0.f;
#pragma unroll
        for (int e = 0; e < 4; ++e) {
            const int t = 4 * seg + e;
            const float rg = GR[t * 32 + c], ig = GR[(64 + t) * 32 + c], xv = XF[t * 32 + c];
            const float la = -sp8 * rg; av[e] = __expf(la);
            const float x2 = 2.0f * la;
            const float om = -x2 * (1.0f + x2 * (0.5f + x2 * (0.16666667f + x2 * (0.041666668f + x2 * (0.008333334f + x2 * 0.0013888889f)))));
            uv[e] = sqrtf(om) * (ig * xv);
            H = av[e] * H + uv[e]; P *= av[e];
        }
        SEG[(seg * 32 + c) * 2] = P; SEG[(seg * 32 + c) * 2 + 1] = H;
        __syncthreads();
        float hin = CAR[c];
        for (int s2 = 0; s2 < seg; ++s2) hin = SEG[(s2 * 32 + c) * 2] * hin + SEG[(s2 * 32 + c) * 2 + 1];
#pragma unroll
        for (int e = 0; e < 4; ++e) {
            const int t = 4 * seg + e;
            hin = av[e] * hin + uv[e];
            const float gt = bf2f(proj[(rowbase + t) * NIN_E + 2048 + cho0 + c]);
            const float u2 = 0.7978845608028654f * (gt + 0.044715f * gt * gt * gt);
            const float th = 1.0f - 2.0f / (1.0f + __expf(2.0f * u2));
            mixed[(rowbase + t) * 1024 + 512 + cho0 + c] = f2bf(hin * 0.5f * gt * (1.0f + th));
        }
        __syncthreads();
        if (seg == 15) CAR[c] = hin;
    }
    __syncthreads();
}
#ifndef EN_MASK
#define EN_MASK 0xFFFF
#endif
#define EN(k) (((EN_MASK) >> (k)) & 1)
enum Kind { K_PRO = 0, K_KV = 1, K_IN = 2, K_MIXA = 3, K_MIXB = 4, K_OUT = 5, K_RES1 = 6, K_Q = 7, K_ATT = 8, K_O = 9, K_RES2 = 10, K_UP = 11, K_DOWN = 12, K_RES3 = 13 };
constexpr int PPL = 12, NPH = 2 + PPL * DEPTH;

__global__ void __launch_bounds__(NTHR, 2) mk_fwd(Args a) {
    extern __shared__ __attribute__((aligned(16))) unsigned char lds_raw[];
    LAS unsigned char* lds = (LAS unsigned char*)lds_raw;
    volatile LAS unsigned* MISC = (volatile LAS unsigned*)(lds + MISC_OFF);
    const int tid0 = threadIdx.x;
    const int G = gridDim.x, bid = blockIdx.x;
    unsigned char* ws = a.ws;
    for (int u = tid0; u < (LDS_BYTES - LDSCTL_OFF) / 4; u += NTHR) ((LAS unsigned*)(lds + LDSCTL_OFF))[u] = 0u;
    __syncthreads();
    const int lo = a.ph_lo, hi = a.ph_hi;
    XcdBarrier bar; bar.bar = (unsigned*)(ws + WS_CTL) + CW_BAR; bar.x = 0; bar.st = nullptr;
    if (hi - lo > 1) bar = xcd_barrier_post((unsigned*)(ws + WS_CTL) + CW_BAR, MISC + 8);
    const int NGW = G * NWAVES;

    for (int ph = lo; ph < hi; ++ph) {
        int tid = threadIdx.x; asm volatile("" : "+v"(tid));
        const int lane = tid & 63, wave = __builtin_amdgcn_readfirstlane(tid >> 6), gw = bid * NWAVES + wave;
        int kind, l;
        if (ph == 0) { kind = K_PRO; l = 0; } else if (ph == 1) { kind = K_KV; l = 0; } else { const int r = ph - 2; l = r / PPL; kind = 2 + r % PPL; }
        const bool even = !(l & 1); const int jl = l >> 1;
        bf16* ACT = (bf16*)(ws + WS_ACT);
        if (EN(K_PRO) && kind == K_PRO) {
            phase_prologue(a, lds, bid, G, wave, lane, tid);
        } else if (EN(K_IN) && kind == K_IN && !even) {
            phase_ba(ACT, (const float*)wl(ws, l, WO_BA), (float*)(ws + WS_BA), lds, bid, G, wave, lane, tid);
            pg8::Gemm g{ACT, wl(ws, l, WO_IN), M, NIN_O, 1024}; pg8::StaticOrder S; S.init(M, NIN_O, G, bid);
            pg8::EpiGdnIn E{(bf16*)(ws + WS_R), (bf16*)(ws + WS_HALO)};
            pg8::gemm_phase<pg8::EpiGdnIn, pg8::StaticOrder, true, true>(lds, g, S, E);
        } else if (EN(K_KV) && (kind == K_KV || kind == K_IN || kind == K_Q)) {
            const int nrep = (kind == K_KV) ? 2 : 1;
            for (int rep = 0; rep < nrep; ++rep) {
                const bf16* A; const bf16* Bt; int Mg, Ng; bf16* O;
                if (kind == K_KV) {
                    if (rep == 0) { A = (const bf16*)(ws + WS_MEMN); Bt = (const bf16*)(ws + WS_WK); Mg = MMEM; Ng = 4096; O = (bf16*)(ws + WS_KALL); }
                    else { A = (const bf16*)(ws + WS_WV); Bt = (const bf16*)(ws + WS_MEMN); Mg = 4096; Ng = MMEM; O = (bf16*)(ws + WS_VT); }
                } else if (kind == K_IN) { A = ACT; Bt = wl(ws, l, WO_IN); Mg = M; Ng = NIN_E; O = (bf16*)(ws + WS_R); }
                else { A = ACT; Bt = wl(ws, l, WO_Q); Mg = M; Ng = 1024; O = (bf16*)(ws + WS_QO); }
                pg8::Gemm g{A, Bt, Mg, Ng, 1024}; pg8::StaticOrder S; S.init(Mg, Ng, G, bid);
                pg8::EpiBf16A<0> E{O, Ng};
                pg8::gemm_phase<pg8::EpiBf16A<0>, pg8::StaticOrder, true, true>(lds, g, S, E);
            }
        } else if (EN(K_DOWN) && kind == K_DOWN) {
            pg8::Gemm g{(const bf16*)(ws + WS_R), wl(ws, l, WO_W2), M, 1024, FF}; pg8::StaticOrder S; S.init(M, 1024, G, bid);
            pg8::EpiBf16A<0> E{ACT, 1024};
            pg8::gemm_phase<pg8::EpiBf16A<0>, pg8::StaticOrder, true, true>(lds, g, S, E);
        } else if (EN(K_UP) && kind == K_UP) {
            pg8::Gemm g{ACT, wl(ws, l, WO_W1), M, FF, 1024}; pg8::StaticOrder S; S.init(M, FF, G, bid);
            pg8::EpiBf16A<1> E{(bf16*)(ws + WS_R), FF};
            pg8::gemm_phase<pg8::EpiBf16A<1>, pg8::StaticOrder, true, true>(lds, g, S, E);
        } else if (EN(K_OUT) && (kind == K_OUT || kind == K_O)) {
            const bf16* A = (kind == K_OUT) ? (even ? ACT : (const bf16*)(ws + WS_R) + 3 * PSZ) : (const bf16*)(ws + WS_QO); const bf16* Bt = (kind == K_OUT) ? wl(ws, l, WO_OUT) : wl(ws, l, WO_O);
            pg8::Gemm g{A, Bt, M, 1024, 1024}; pg8::StaticOrder S; S.init(M, 1024, G, bid);
            pg8::EpiF32A E{(float*)(ws + WS_R), 1024};
            pg8::gemm_phase<pg8::EpiF32A, pg8::StaticOrder, true, true>(lds, g, S, E);
        } else if (EN(K_RES1) && (kind == K_RES1 || kind == K_RES2)) {
            const float* base = (kind == K_RES1 && l == 0) ? a.in[I_X] : a.out;
            const float* gp = ((kind == K_RES1) ? a.in[I_MIX_POST_G] : a.in[I_XA_POST_G]) + l * 1024;
            phase_res<false>(ws + WS_R, base, gp, a.out, ACT, gw, NGW, lane);
        } else if (EN(K_RES3) && kind == K_RES3) {
            phase_res<true>(ACT, a.out, a.in[I_MLP_POST_G] + l * 1024, a.out, ACT, gw, NGW, lane);
        } else if (EN(K_MIXA) && kind == K_MIXA) {
            if (even) {
                for (int u = bid; u < 2048; u += G) { if (u < 1024) gla_a_unit(a, jl, u, ws, lds, tid); else lru_conv_unit(a, jl, u - 1024, ws, tid); }
            } else {
                for (int u = bid; u < 2048; u += G) gdn_a_unit(a, jl, u, ws, lds, tid);
            }
        } else if (EN(K_MIXB) && kind == K_MIXB) {
            if (even) { for (int u = bid; u < 160; u += G) { if (u < 128) lru_unit(a, jl, u, ws, lds, tid); else gla_b_unit(u - 128, ws, lds, tid); } }
            else { for (int u = bid; u < 64; u += G) gdn_b_unit(u, ws, lds, tid); }
        } else if (EN(K_ATT) && kind == K_ATT) {
            for (int u = bid; u < 256; u += G) attn_unit(l, u >> 2, u & 3, (bf16*)(ws + WS_QO), (const bf16*)(ws + WS_KALL), (const bf16*)(ws + WS_VT), wave, lane);
        }
        if (ph + 1 < hi) xcd_barrier(bar);
    }
}

#ifndef MK_PER_PHASE
#define MK_PER_PHASE 0
#endif
extern "C" void kernel_launch(void* const* d_in, const int* in_sizes, int n_in, void* d_out, int out_size, void* d_ws, size_t ws_size, hipStream_t stream) {
    static int grid = 0;
    if (grid == 0) {
        if (n_in != N_IN || out_size != M * D || ws_size < WS_END) { fprintf(stderr, "kernel_launch: unexpected shapes (n_in %d out %d ws %zu)\n", n_in, out_size, ws_size); grid = -1; return; }
        int dev = 0, cus = 0, per_cu = 0;
        if (hipGetDevice(&dev) != hipSuccess || hipDeviceGetAttribute(&cus, hipDeviceAttributeMultiprocessorCount, dev) != hipSuccess) { grid = -1; return; }
        if (hipFuncSetAttribute((const void*)mk_fwd, hipFuncAttributeMaxDynamicSharedMemorySize, LDS_BYTES) != hipSuccess) { fprintf(stderr, "kernel_launch: hipFuncSetAttribute failed\n"); grid = -1; return; }
        if (hipOccupancyMaxActiveBlocksPerMultiprocessor(&per_cu, (const void*)mk_fwd, NTHR, LDS_BYTES) != hipSuccess || per_cu < 1) { fprintf(stderr, "kernel_launch: occupancy query says %d blocks per CU\n", per_cu); }
        (void)hipGetLastError();
        grid = cus;
    }
    if (grid < 0) return;
    (void)in_sizes;
    if (hipMemsetAsync((char*)d_ws + WS_CTL, 0, CTL_ZERO_BYTES, stream) != hipSuccess) { fprintf(stderr, "kernel_launch: memset failed\n"); return; }
    Args a{};
    for (int i = 0; i < N_IN; ++i) a.in[i] = (const float*)d_in[i];
    a.out = (float*)d_out; a.ws = (unsigned char*)d_ws;
#if MK_PER_PHASE
    for (int ph = 0; ph < NPH; ++ph) { a.ph_lo = ph; a.ph_hi = ph + 1; hipLaunchKernelGGL(mk_fwd, dim3(grid), dim3(NTHR), LDS_BYTES, stream, a); }
#else
    a.ph_lo = 0; a.ph_hi = NPH;
    hipLaunchKernelGGL(mk_fwd, dim3(grid), dim3(NTHR), LDS_BYTES, stream, a);
#endif
}
```

```cpp
#include <hip/hip_runtime.h>
#include <cstdio>
#include <cstdint>
namespace pg8 {
#define PG8_LAS __attribute__((address_space(3)))
typedef unsigned short bf16_t;
typedef short bf16x8 __attribute__((ext_vector_type(8)));
typedef float f32x4 __attribute__((ext_vector_type(4)));
typedef unsigned u32x4 __attribute__((ext_vector_type(4)));
constexpr int BM = 256, BK = 64, HALF = 128, HTB = HALF * BK * 2  , STAGE_BYTES = 8 * HTB, NXCD = 8, WGM = 8;

__host__ __device__ __forceinline__ int lds_byte(int r, int c) { const int st = (r >> 4) * 2 + (c >> 5), rr = r & 15, cc = c & 31, ob = rr * 64 + cc * 2; return st * 1024 + (ob ^ (((ob >> 9) & 1) << 5)); }
__host__ __device__ __forceinline__ void stage_rc(int b, int& R, int& C) { const int st = b / 1024, sb = b % 1024, swz = sb ^ (((sb >> 9) & 1) << 5); R = (st >> 1) * 16 + swz / 64; C = (st & 1) * 32 + (swz % 64) / 2; }
__host__ __device__ __forceinline__ int perm32(int rho) { const int n = rho >> 4, i = rho & 15; return 8 * (i >> 2) + 4 * n + (i & 3); }

struct Unit { int pm, pn; };
struct Gemm { const bf16_t* A; const bf16_t* Bt; int M, N, K; };

struct StaticOrder {
    int nM, nN, nwg, G, c;
    __host__ __device__ void init(int M, int N, int G_, int c_) { nM = M / BM; nN = N / BM; nwg = nM * nN; G = G_; c = c_; }
    __host__ __device__ bool next(int i, Unit& u) const {
        const long L = (long)i * G + c; if (L >= nwg) return false;
        int wgid = (int)L; { const int q = nwg / NXCD, r = nwg % NXCD, xcd = wgid % NXCD, off = wgid / NXCD; wgid = (xcd < r ? xcd * (q + 1) : r * (q + 1) + (xcd - r) * q) + off; }
        const int nig = WGM * nN, gid = wgid / nig, fm = gid * WGM, gsz = (nM - fm) < WGM ? (nM - fm) : WGM;
        u.pm = fm + ((wgid % nig) % gsz); u.pn = (wgid % nig) / gsz; return true;
    }
    __device__ __forceinline__ void a_ready(const Unit&) const {}
    __device__ __forceinline__ void done(const Unit&) const {}
};

__device__ __forceinline__ unsigned cvt_pk_bf16(float lo, float hi) { unsigned r; asm volatile("v_cvt_pk_bf16_f32 %0, %1, %2" : "=v"(r) : "v"(lo), "v"(hi)); return r; }
typedef float f32x2 __attribute__((ext_vector_type(2)));
__device__ __forceinline__ f32x2 gelu_pk(f32x2 v) {
    const f32x2 av = __builtin_elementwise_abs(v), d = av * 0.2316418882f + 1.0f;
    f32x2 t; t.x = __builtin_amdgcn_rcpf(d.x); t.y = __builtin_amdgcn_rcpf(d.y);
    f32x2 q = t * 0.5307027145f + (-0.7265760135f); q = q * t + 0.7107068705f; q = q * t + (-0.142248368f); q = q * t + 0.127414796f; q = q * t;
    const f32x2 s = (v * v) * (-0.72134752044f);
    f32x2 e; e.x = __builtin_amdgcn_exp2f(s.x); e.y = __builtin_amdgcn_exp2f(s.y);
    const f32x2 m = v * (q * e), r = v - m;
    f32x2 o; o.x = v.x < 0.f ? m.x : r.x; o.y = v.y < 0.f ? m.y : r.y; return o;
}

template <int ACT  > struct EpiBf16 {
    static constexpr bool PERM = true, AFTER_DRAIN = false; static_assert(ACT == 0 || ACT == 1, "EpiBf16: ACT is 0 (none) or 1 (gelu_pk)");
    bf16_t* O; int ldc; const float* bias; int split_cols; size_t split_stride; float scale0;
    __device__ __forceinline__ void operator()(const f32x4 (&acc)[2][2][4][2], const Unit& u, int wr, int wc, int fr, int fq) const {
        const int row0 = u.pm * BM + wr * 64 + fr; int colt = u.pn * BM; bf16_t* base = O;
        float sc = 1.f; if (split_cols) { const int t = colt / split_cols; base += (size_t)t * split_stride; colt -= t * split_cols; if (t == 0) sc = scale0; }
        const int col0 = colt + wc * 32 + 8 * fq, bcol0 = u.pn * BM + wc * 32 + 8 * fq;
        f32x4 bv[2][2];
#pragma unroll
        for (int bj = 0; bj < 2; ++bj)
#pragma unroll
            for (int n = 0; n < 2; ++n) bv[bj][n] = bias ? *(const f32x4*)(bias + bcol0 + bj * HALF + 4 * n) : (f32x4){0.f, 0.f, 0.f, 0.f};
#pragma unroll
        for (int ai = 0; ai < 2; ++ai)
#pragma unroll
            for (int m = 0; m < 4; ++m) { bf16_t* rowp = base + (size_t)(row0 + ai * HALF + m * 16) * ldc + col0;
#pragma unroll
                for (int bj = 0; bj < 2; ++bj) { f32x4 v0 = acc[ai][bj][m][0] + bv[bj][0], v1 = acc[ai][bj][m][1] + bv[bj][1];
                    if (ACT == 1) { f32x2 a = gelu_pk((f32x2){v0[0], v0[1]}), b = gelu_pk((f32x2){v0[2], v0[3]}), c = gelu_pk((f32x2){v1[0], v1[1]}), d = gelu_pk((f32x2){v1[2], v1[3]});
                        v0 = (f32x4){a.x, a.y, b.x, b.y}; v1 = (f32x4){c.x, c.y, d.x, d.y}; }
                    v0 = v0 * sc; v1 = v1 * sc; u32x4 w; w.x = cvt_pk_bf16(v0[0], v0[1]); w.y = cvt_pk_bf16(v0[2], v0[3]); w.z = cvt_pk_bf16(v1[0], v1[1]); w.w = cvt_pk_bf16(v1[2], v1[3]);
                    *(u32x4*)(rowp + bj * HALF) = w; } }
    }
};

struct PanelStats {
    unsigned* xbuf;
    unsigned* cnt;
    unsigned* tmo;
    int ntn; float eps;
    unsigned code;
    __device__ __forceinline__ bool run(const f32x4 (&v)[2][2][4][2], const Unit& u, int wr, int wc, int fr, int fq, PG8_LAS unsigned char* lds, int wid, int lane) const {
        typedef float f32x2v __attribute__((ext_vector_type(2)));
        PG8_LAS f32x2v* P = (PG8_LAS f32x2v*)lds;
        PG8_LAS f32x2v* S = (PG8_LAS f32x2v*)(lds + 8192);
        PG8_LAS unsigned* flag = (PG8_LAS unsigned*)(lds + 8192 + 2048);
#pragma unroll
        for (int ai = 0; ai < 2; ++ai)
#pragma unroll
            for (int m = 0; m < 4; ++m) {
                float s = 0.f;
#pragma unroll
                for (int bj = 0; bj < 2; ++bj)
#pragma unroll
                    for (int n = 0; n < 2; ++n) { const f32x4 x = v[ai][bj][m][n]; s += (x[0] + x[1]) + (x[2] + x[3]); }
                s += __shfl_xor(s, 16); s += __shfl_xor(s, 32);
                const float mw = s * (1.0f / 64.0f); float q = 0.f;
#pragma unroll
                for (int bj = 0; bj < 2; ++bj)
#pragma unroll
                    for (int n = 0; n < 2; ++n) { const f32x4 d = v[ai][bj][m][n] - mw; q += (d[0] * d[0] + d[1] * d[1]) + (d[2] * d[2] + d[3] * d[3]); }
                q += __shfl_xor(q, 16); q += __shfl_xor(q, 32);
                if (fq == 0) P[(ai * HALF + wr * 64 + m * 16 + fr) * 4 + wc] = (f32x2v){mw, q};
            }
        asm volatile("s_waitcnt lgkmcnt(0)" ::: "memory"); __builtin_amdgcn_s_barrier(); asm volatile("" ::: "memory");
#if defined(BROKEN_EXCHANGE_NO_WAIT)
#warning BROKEN CONTROL BUILD: the row-statistics exchange does not wait; results are wrong by design
        if (blockIdx.x >= 64) { const long long t0_ = clock64(); while (clock64() - t0_ < 60000) __builtin_amdgcn_s_sleep(8); }
#endif
        const int row = wid * 32 + (lane & 31);
        if (lane < 32) {
            const f32x2v a = P[row * 4 + 0], b = P[row * 4 + 1], c = P[row * 4 + 2], d = P[row * 4 + 3];
            const float mt = (a.x + b.x + c.x + d.x) * 0.25f;
            const float da = a.x - mt, db = b.x - mt, dc = c.x - mt, dd = d.x - mt;
            const float m2 = (a.y + b.y) + (c.y + d.y) + 64.0f * ((da * da + db * db) + (dc * dc + dd * dd));
            unsigned long long* slot = (unsigned long long*)xbuf + ((size_t)(u.pm * BM + row) * 4 + u.pn);
            __hip_atomic_store(slot, ((unsigned long long)__float_as_uint(m2) << 32) | __float_as_uint(mt), __ATOMIC_RELAXED, __HIP_MEMORY_SCOPE_AGENT);
        }
        asm volatile("s_waitcnt vmcnt(0)" ::: "memory");
        if (lane == 0) __hip_atomic_fetch_add(cnt + 64 * u.pm, 1u, __ATOMIC_RELAXED, __HIP_MEMORY_SCOPE_AGENT);
        if (wid == 0) {
            bool dead = false; const unsigned long long t0 = __builtin_amdgcn_s_memrealtime(); const unsigned want = 8u * (unsigned)ntn;
            for (;;) {
#if defined(BROKEN_EXCHANGE_NO_WAIT)
                break;
#endif
                if ((unsigned)__builtin_amdgcn_readfirstlane(__hip_atomic_load(cnt + 64 * u.pm, __ATOMIC_RELAXED, __HIP_MEMORY_SCOPE_AGENT)) >= want) break;
                if (__builtin_amdgcn_s_memrealtime() - t0 > 2000000ull) {
                    if (lane == 0) { unsigned expect = 0u; __hip_atomic_compare_exchange_strong(tmo + 1, &expect, code | (unsigned)(u.pm & 0xff), __ATOMIC_RELAXED, __ATOMIC_RELAXED, __HIP_MEMORY_SCOPE_AGENT);
                                     __hip_atomic_store(tmo, 1u, __ATOMIC_RELAXED, __HIP_MEMORY_SCOPE_AGENT); }
                    dead = true; break; }
                __builtin_amdgcn_s_sleep(2);
            }
            __builtin_amdgcn_fence(__ATOMIC_ACQUIRE, "agent");
            if (lane == 0) flag[0] = dead ? 1u : 0u;
        }
        asm volatile("s_waitcnt vmcnt(0) lgkmcnt(0)" ::: "memory"); __builtin_amdgcn_s_barrier(); asm volatile("" ::: "memory");
        const bool bad = flag[0] != 0u;
        if (lane < 32) {
            const unsigned long long* slot = (const unsigned long long*)xbuf + (size_t)(u.pm * BM + row) * 4; float mt[4], m2[4]; float ms = 0.f;
#pragma unroll
            for (int t = 0; t < 4; ++t) { if (t < ntn) { const unsigned long long w = __hip_atomic_load(slot + t, __ATOMIC_RELAXED, __HIP_MEMORY_SCOPE_AGENT); mt[t] = __uint_as_float((unsigned)w); m2[t] = __uint_as_float((unsigned)(w >> 32)); } else { mt[t] = 0.f; m2[t] = 0.f; } ms += mt[t]; }
            const float mean = ms / (float)ntn; float q = 0.f;
#pragma unroll
            for (int t = 0; t < 4; ++t) if (t < ntn) { const float dm = mt[t] - mean; q += m2[t] + 256.0f * dm * dm; }
            S[row] = (f32x2v){mean, 1.0f / sqrtf(q / (256.0f * (float)ntn) + eps)};
        }
        asm volatile("s_waitcnt lgkmcnt(0)" ::: "memory"); __builtin_amdgcn_s_barrier(); asm volatile("" ::: "memory");
        return bad;
    }
};
struct EpiLnRes {
    static constexpr bool PERM = false, AFTER_DRAIN = true;
    const float* base; float* out; int ldc; const float* bias; PanelStats st; unsigned poison;
    __device__ __forceinline__ void fused(f32x4 (&acc)[2][2][4][2], const Unit& u, int wr, int wc, int fr, int fq, PG8_LAS unsigned char* lds, int wid, int lane) const {
        typedef float f32x2v __attribute__((ext_vector_type(2)));
        const PG8_LAS f32x2v* S = (const PG8_LAS f32x2v*)(lds + 8192);
        const int col0 = u.pn * BM + wc * 32 + 4 * fq;
#pragma unroll
        for (int bj = 0; bj < 2; ++bj)
#pragma unroll
            for (int n = 0; n < 2; ++n) { const f32x4 bv = bias ? *(const f32x4*)(bias + col0 + bj * HALF + n * 16) : (f32x4){0.f, 0.f, 0.f, 0.f};
#pragma unroll
                for (int ai = 0; ai < 2; ++ai)
#pragma unroll
                    for (int m = 0; m < 4; ++m) acc[ai][bj][m][n] += bv; }
        f32x4 pre[4][2][2];
#pragma unroll
        for (int m = 0; m < 4; ++m) { const size_t off = (size_t)(u.pm * BM + wr * 64 + m * 16 + fr) * ldc + col0;
#pragma unroll
            for (int bj = 0; bj < 2; ++bj)
#pragma unroll
                for (int n = 0; n < 2; ++n) pre[m][bj][n] = *(const f32x4*)(base + off + bj * HALF + n * 16); }
        const bool bad = st.run(acc, u, wr, wc, fr, fq, lds, wid, lane) || poison != 0u;
        const float qnan = __builtin_nanf("");
#pragma unroll
        for (int ai = 0; ai < 2; ++ai)
#pragma unroll
            for (int m = 0; m < 4; ++m) { const int r = ai * HALF + wr * 64 + m * 16 + fr; const f32x2v sr = S[r]; const size_t off = (size_t)(u.pm * BM + r) * ldc + col0;
#pragma unroll
                for (int bj = 0; bj < 2; ++bj)
#pragma unroll
                    for (int n = 0; n < 2; ++n) { const f32x4 bs = ai == 0 ? pre[m][bj][n] : *(const f32x4*)(base + off + bj * HALF + n * 16); f32x4 o = bs + (acc[ai][bj][m][n] - sr.x) * sr.y;
                        if (bad) o = (f32x4){qnan, qnan, qnan, qnan}; *(f32x4*)(out + off + bj * HALF + n * 16) = o; }
                if (m & 1) asm volatile("" ::: "memory"); }
    }
};
struct EpiLnResLn {
    static constexpr bool PERM = false, AFTER_DRAIN = true;
    const float* base; float* out; bf16_t* xn; int ldc; const float* bias; PanelStats st1, st2; unsigned poison;
    __device__ __forceinline__ void fused(f32x4 (&acc)[2][2][4][2], const Unit& u, int wr, int wc, int fr, int fq, PG8_LAS unsigned char* lds, int wid, int lane) const {
        typedef float f32x2v __attribute__((ext_vector_type(2))); typedef unsigned u32x2v __attribute__((ext_vector_type(2)));
        const PG8_LAS f32x2v* S = (const PG8_LAS f32x2v*)(lds + 8192);
        const int col0 = u.pn * BM + wc * 32 + 4 * fq;
#pragma unroll
        for (int bj = 0; bj < 2; ++bj)
#pragma unroll
            for (int n = 0; n < 2; ++n) { const f32x4 bv = bias ? *(const f32x4*)(bias + col0 + bj * HALF + n * 16) : (f32x4){0.f, 0.f, 0.f, 0.f};
#pragma unroll
                for (int ai = 0; ai < 2; ++ai)
#pragma unroll
                    for (int m = 0; m < 4; ++m) acc[ai][bj][m][n] += bv; }
        bool bad = st1.run(acc, u, wr, wc, fr, fq, lds, wid, lane) || poison != 0u;
        const float qnan = __builtin_nanf("");
#pragma unroll
        for (int ai = 0; ai < 2; ++ai)
#pragma unroll
            for (int m = 0; m < 4; ++m) { const int r = ai * HALF + wr * 64 + m * 16 + fr; const f32x2v sr = S[r]; const size_t off = (size_t)(u.pm * BM + r) * ldc + col0;
#pragma unroll
                for (int bj = 0; bj < 2; ++bj)
#pragma unroll
                    for (int n = 0; n < 2; ++n) { const f32x4 bs = *(const f32x4*)(base + off + bj * HALF + n * 16); acc[ai][bj][m][n] = bs + (acc[ai][bj][m][n] - sr.x) * sr.y; }
                asm volatile("" : "+v"(acc[ai][0][m][0]), "+v"(acc[ai][0][m][1]), "+v"(acc[ai][1][m][0]), "+v"(acc[ai][1][m][1]));
                if (m & 1) asm volatile("" ::: "memory"); }
        const bool bad1 = bad;
        bad = st2.run(acc, u, wr, wc, fr, fq, lds, wid, lane) || bad;
#pragma unroll
        for (int ai = 0; ai < 2; ++ai)
#pragma unroll
            for (int m = 0; m < 4; ++m) { const int r = ai * HALF + wr * 64 + m * 16 + fr; const f32x2v sr = S[r]; const size_t off = (size_t)(u.pm * BM + r) * ldc + col0;
#pragma unroll
                for (int bj = 0; bj < 2; ++bj)
#pragma unroll
                    for (int n = 0; n < 2; ++n) { const f32x4 x1 = acc[ai][bj][m][n]; *(f32x4*)(out + off + bj * HALF + n * 16) = bad1 ? (f32x4){qnan, qnan, qnan, qnan} : x1;
                        const f32x4 o = (x1 - sr.x) * sr.y; u32x2v w; w.x = cvt_pk_bf16(o[0], o[1]); w.y = cvt_pk_bf16(o[2], o[3]);
                        if (bad) { w.x = 0x7fc07fc0u; w.y = 0x7fc07fc0u; } *(u32x2v*)(xn + off + bj * HALF + n * 16) = w; }
                asm volatile("" ::: "memory"); }
    }
};

template <class Epi, class Sched, bool ALIGN_EPI = false, bool SP2 = false>
__device__ __forceinline__ void gemm_phase(PG8_LAS unsigned char* lds, const Gemm g, const Sched& S, const Epi& E) {
    int tid_ = threadIdx.x; asm volatile("" : "+v"(tid_));
    const int tid = tid_, wid = __builtin_amdgcn_readfirstlane(tid >> 6), lane = tid & 63, wr = wid >> 2, wc = wid & 3, fr = lane & 15, fq = lane >> 4;
    const int K = g.K, nt = K / BK;
    unsigned voffA[2], voffB[2];
#pragma unroll
    for (int i = 0; i < 2; ++i) { int R, C; stage_rc(tid * 16 + i * 8192, R, C); const int Rb = Epi::PERM ? ((R & ~31) + perm32(R & 31)) : R;
        voffA[i] = (unsigned)(R * K + C) * 2u; voffB[i] = (unsigned)(Rb * K + C) * 2u; }
    const size_t kstep = (size_t)(BK * 2);
    const size_t hstep = (size_t)HALF * K * 2;
    const size_t tstep = 2 * hstep;
    const unsigned ldsw = (unsigned)wid * 1024u;
    const int aoff = lds_byte(wr * 64 + fr, fq * 8), boff = lds_byte(wc * 32 + fr, fq * 8);
#define PG8_SA(b, h) (((b) * 2 + (h)) * HTB)
#define PG8_SB(b, h) ((4 + (b) * 2 + (h)) * HTB)
#define PG8_STAGE(bufoff, gbase, voff) do { _Pragma("unroll") for (int _i = 0; _i < 2; ++_i) \
        __builtin_amdgcn_global_load_lds((const unsigned*)((const char*)(gbase) + (voff)[_i]), (PG8_LAS unsigned*)(lds + (bufoff) + ldsw + _i * 8192), 16, 0, 0); } while (0)
#define PG8_LDA(dst, b, h) do { _Pragma("unroll") for (int m = 0; m < 4; ++m) _Pragma("unroll") for (int k = 0; k < 2; ++k) dst[m][k] = *(const PG8_LAS bf16x8*)(lds + PG8_SA(b, h) + aoff + m * 2048 + k * 1024); } while (0)
#define PG8_LDB(dst, b, h) do { _Pragma("unroll") for (int n = 0; n < 2; ++n) _Pragma("unroll") for (int k = 0; k < 2; ++k) dst[n][k] = *(const PG8_LAS bf16x8*)(lds + PG8_SB(b, h) + boff + n * 2048 + k * 1024); } while (0)
#define PG8_MMA(ai, bj, At, Bt) do { __builtin_amdgcn_s_setprio(1); _Pragma("unroll") for (int m = 0; m < 4; ++m) _Pragma("unroll") for (int n = 0; n < 2; ++n) _Pragma("unroll") for (int k = 0; k < 2; ++k) \
        acc[ai][bj][m][n] = __builtin_amdgcn_mfma_f32_16x16x32_bf16(Bt[n][k], At[m][k], acc[ai][bj][m][n], 0, 0, 0); __builtin_amdgcn_s_setprio(0); } while (0)
#define PG8_WAIT_V(n) asm volatile("s_waitcnt vmcnt(" #n ")" ::: "memory")
#define PG8_WAIT_L(n) asm volatile("s_waitcnt lgkmcnt(" #n ")" ::: "memory")
#define PG8_BAR __builtin_amdgcn_s_barrier()
#define PG8_SCHED __builtin_amdgcn_sched_barrier(0)
    Unit cur, nxt; int ui = 0;
    if (!S.next(0, cur)) return;
    f32x4 acc[2][2][4][2];
#pragma unroll
    for (int a = 0; a < 2; ++a)
#pragma unroll
        for (int b = 0; b < 2; ++b)
#pragma unroll
            for (int m = 0; m < 4; ++m)
#pragma unroll
                for (int n = 0; n < 2; ++n) acc[a][b][m][n] = (f32x4){0.f, 0.f, 0.f, 0.f};
    bf16x8 At[4][2], B0[2][2], B1[2][2];
    const char* cA = (const char*)g.A + (size_t)cur.pm * tstep; const char* cB = (const char*)g.Bt + (size_t)cur.pn * tstep;
    S.a_ready(cur);
    if constexpr (SP2) {
        PG8_STAGE(PG8_SB(0, 0), cB, voffB); PG8_STAGE(PG8_SB(0, 1), cB + hstep, voffB); PG8_STAGE(PG8_SA(0, 0), cA, voffA); PG8_STAGE(PG8_SA(0, 1), cA + hstep, voffA);
        if (wr == 1) PG8_BAR;
        PG8_WAIT_V(2); PG8_BAR;
        PG8_STAGE(PG8_SB(1, 0), cB + kstep, voffB); PG8_STAGE(PG8_SA(1, 0), cA + kstep, voffA); PG8_STAGE(PG8_SB(1, 1), cB + hstep + kstep, voffB);
        PG8_WAIT_V(6); PG8_BAR;
    } else {
        PG8_STAGE(PG8_SB(0, 0), cB, voffB); PG8_STAGE(PG8_SA(0, 0), cA, voffA); PG8_STAGE(PG8_SB(0, 1), cB + hstep, voffB); PG8_STAGE(PG8_SA(0, 1), cA + hstep, voffA);
        if (wr == 1) PG8_BAR;
        PG8_WAIT_V(4); PG8_BAR;
        PG8_STAGE(PG8_SB(1, 0), cB + kstep, voffB); PG8_STAGE(PG8_SA(1, 0), cA + kstep, voffA); PG8_STAGE(PG8_SB(1, 1), cB + hstep + kstep, voffB);
        PG8_WAIT_V(6); PG8_BAR;
    }
    for (;;) {
        const bool has_next = S.next(ui + 1, nxt);
        const char* nA = has_next ? (const char*)g.A + (size_t)nxt.pm * tstep : cA; const char* nB = has_next ? (const char*)g.Bt + (size_t)nxt.pn * tstep : cB;
        for (int t = 0; t < nt; t += 2) {
            const bool last = (t == nt - 2);
            const char* a1 = cA + (size_t)(t + 1) * kstep;
            const char* a2 = last ? nA : cA + (size_t)(t + 2) * kstep; const char* b2 = last ? nB : cB + (size_t)(t + 2) * kstep;
            const char* a3 = a2 + kstep; const char* b3 = b2 + kstep;
            if (last && has_next) S.a_ready(nxt);
            if constexpr (SP2) {
            PG8_LDB(B0, 0, 0); PG8_LDB(B1, 0, 1); PG8_SCHED; PG8_LDA(At, 0, 0); PG8_STAGE(PG8_SA(1, 1), a1 + hstep, voffA);
            PG8_WAIT_V(8); PG8_WAIT_L(0); PG8_BAR; PG8_MMA(0, 0, At, B0); PG8_MMA(0, 1, At, B1); PG8_BAR; PG8_SCHED;
            PG8_LDA(At, 0, 1); PG8_STAGE(PG8_SB(0, 0), b2, voffB); PG8_STAGE(PG8_SB(0, 1), b2 + hstep, voffB); PG8_STAGE(PG8_SA(0, 0), a2, voffA);
            PG8_WAIT_V(8); PG8_WAIT_L(0); PG8_BAR; PG8_MMA(1, 0, At, B0); PG8_MMA(1, 1, At, B1); PG8_BAR; PG8_SCHED;
            PG8_LDB(B0, 1, 0); PG8_LDB(B1, 1, 1); PG8_SCHED; PG8_LDA(At, 1, 0); PG8_STAGE(PG8_SA(0, 1), a2 + hstep, voffA);
            PG8_WAIT_V(8); PG8_WAIT_L(0); PG8_BAR; PG8_MMA(0, 0, At, B0); PG8_MMA(0, 1, At, B1); PG8_BAR; PG8_SCHED;
            PG8_LDA(At, 1, 1); PG8_STAGE(PG8_SB(1, 0), b3, voffB); PG8_STAGE(PG8_SB(1, 1), b3 + hstep, voffB); PG8_STAGE(PG8_SA(1, 0), a3, voffA);
            PG8_WAIT_V(8); PG8_WAIT_L(0); PG8_BAR; PG8_MMA(1, 0, At, B0); PG8_MMA(1, 1, At, B1); PG8_BAR; PG8_SCHED;
            } else {
            PG8_LDB(B0, 0, 0); PG8_SCHED; PG8_LDA(At, 0, 0); PG8_STAGE(PG8_SA(1, 1), a1 + hstep, voffA);
            PG8_WAIT_L(8); PG8_BAR; PG8_WAIT_L(0); PG8_MMA(0, 0, At, B0); PG8_BAR; PG8_SCHED;
            PG8_LDB(B1, 0, 1); PG8_STAGE(PG8_SB(0, 0), b2, voffB);
            PG8_BAR; PG8_WAIT_L(0); PG8_MMA(0, 1, At, B1); PG8_BAR;
            PG8_LDA(At, 0, 1); PG8_STAGE(PG8_SA(0, 0), a2, voffA);
            PG8_BAR; PG8_WAIT_L(0); PG8_MMA(1, 0, At, B0); PG8_BAR; PG8_SCHED;
            PG8_STAGE(PG8_SB(0, 1), b2 + hstep, voffB);
            PG8_WAIT_V(6); PG8_BAR; PG8_MMA(1, 1, At, B1); PG8_BAR;
            PG8_LDB(B0, 1, 0); PG8_SCHED; PG8_LDA(At, 1, 0); PG8_STAGE(PG8_SA(0, 1), a2 + hstep, voffA);
            PG8_WAIT_L(8); PG8_BAR; PG8_WAIT_L(0); PG8_MMA(0, 0, At, B0); PG8_BAR; PG8_SCHED;
            PG8_LDB(B1, 1, 1); PG8_STAGE(PG8_SB(1, 0), b3, voffB);
            PG8_BAR; PG8_WAIT_L(0); PG8_MMA(0, 1, At, B1); PG8_BAR;
            PG8_LDA(At, 1, 1); PG8_STAGE(PG8_SA(1, 0), a3, voffA);
            PG8_BAR; PG8_WAIT_L(0); PG8_MMA(1, 0, At, B0); PG8_BAR; PG8_SCHED;
            PG8_STAGE(PG8_SB(1, 1), b3 + hstep, voffB);
            PG8_WAIT_V(6); PG8_BAR; PG8_MMA(1, 1, At, B1); PG8_BAR;
            }
        }
        if constexpr (ALIGN_EPI) { if (wr == 0) PG8_BAR; }
        if constexpr (!Epi::AFTER_DRAIN) { E(acc, cur, wr, wc, fr, fq); S.done(cur); }
        if (!has_next) break;
#pragma unroll
        for (int a = 0; a < 2; ++a)
#pragma unroll
            for (int b = 0; b < 2; ++b)
#pragma unroll
                for (int m = 0; m < 4; ++m)
#pragma unroll
                    for (int n = 0; n < 2; ++n) acc[a][b][m][n] = (f32x4){0.f, 0.f, 0.f, 0.f};
        cur = nxt; cA = nA; cB = nB; ++ui;
        if constexpr (ALIGN_EPI) { if (wr == 1) PG8_BAR; }
    }
    PG8_WAIT_V(0);
    if constexpr (!ALIGN_EPI) { if (wr == 0) PG8_BAR; }
    PG8_BAR;
    if constexpr (Epi::AFTER_DRAIN) { E.fused(acc, cur, wr, wc, fr, fq, lds, wid, lane); S.done(cur); }
#undef PG8_SA
#undef PG8_SB
#undef PG8_STAGE
#undef PG8_LDA
#undef PG8_LDB
#undef PG8_MMA
#undef PG8_WAIT_V
#undef PG8_WAIT_L
#undef PG8_BAR
#undef PG8_SCHED
}
}

namespace pg8 {
typedef __bf16 bf16x2v __attribute__((ext_vector_type(2)));
typedef float f32x2w __attribute__((ext_vector_type(2)));
__device__ __forceinline__ unsigned pk_bf16(float lo, float hi) { f32x2w v = {lo, hi}; bf16x2v b = __builtin_convertvector(v, bf16x2v); return __builtin_bit_cast(unsigned, b); }
template <int ACT> struct EpiBf16A {
    static constexpr bool PERM = true, AFTER_DRAIN = false;
    bf16_t* O; int ldc;
    __device__ __forceinline__ void operator()(const f32x4 (&acc)[2][2][4][2], const Unit& u, int wr, int wc, int fr, int fq) const {
        const int row0 = u.pm * BM + wr * 64 + fr; const int col0 = u.pn * BM + wc * 32 + 8 * fq;
#pragma unroll
        for (int ai = 0; ai < 2; ++ai)
#pragma unroll
            for (int m = 0; m < 4; ++m) { bf16_t* rowp = O + (size_t)(row0 + ai * HALF + m * 16) * ldc + col0;
#pragma unroll
                for (int bj = 0; bj < 2; ++bj) { f32x4 v0 = acc[ai][bj][m][0], v1 = acc[ai][bj][m][1];
                    if (ACT == 1) {
#pragma unroll
                        for (int j = 0; j < 4; ++j) { const float a = fmaxf(v0[j], 0.f), b = fmaxf(v1[j], 0.f); v0[j] = a * a; v1[j] = b * b; } }
                    u32x4 w; w.x = pk_bf16(v0[0], v0[1]); w.y = pk_bf16(v0[2], v0[3]); w.z = pk_bf16(v1[0], v1[1]); w.w = pk_bf16(v1[2], v1[3]);
                    *(u32x4*)(rowp + bj * HALF) = w; } }
    }
};
struct EpiF32A {
    static constexpr bool PERM = false, AFTER_DRAIN = false;
    float* C; int ldc;
    __device__ __forceinline__ void operator()(const f32x4 (&acc)[2][2][4][2], const Unit& u, int wr, int wc, int fr, int fq) const {
        const int row0 = u.pm * BM + wr * 64 + fr, col0 = u.pn * BM + wc * 32 + 4 * fq;
#pragma unroll
        for (int ai = 0; ai < 2; ++ai)
#pragma unroll
            for (int m = 0; m < 4; ++m) { float* rowp = C + (size_t)(row0 + ai * HALF + m * 16) * ldc + col0;
#pragma unroll
                for (int bj = 0; bj < 2; ++bj)
#pragma unroll
                    for (int n = 0; n < 2; ++n) *(f32x4*)(rowp + bj * HALF + n * 16) = acc[ai][bj][m][n]; }
    }
};
}

#define GAS __attribute__((address_space(1)))
#define LAS __attribute__((address_space(3)))
typedef unsigned short bf16;
typedef unsigned v4u __attribute__((ext_vector_type(4)));
typedef unsigned v2u __attribute__((ext_vector_type(2)));
typedef float f32x4 __attribute__((ext_vector_type(4)));
typedef float f32x16 __attribute__((ext_vector_type(16)));
typedef short bf16x8 __attribute__((ext_vector_type(8)));
typedef short s16x4 __attribute__((ext_vector_type(4)));
typedef GAS unsigned gu32;
typedef GAS unsigned long long gu64;
#define RLX_AGENT __ATOMIC_RELAXED, __HIP_MEMORY_SCOPE_AGENT
#define LDS_WAIT() asm volatile("s_waitcnt lgkmcnt(0)" ::: "memory")
#define VM_WAIT() asm volatile("s_waitcnt vmcnt(0)" ::: "memory")
__device__ __forceinline__ unsigned pk2(float lo, float hi) { return pg8::pk_bf16(lo, hi); }
__device__ __forceinline__ bf16 f2bf(float f) { return (bf16)(pk2(f, 0.f) & 0xffffu); }
__device__ __forceinline__ float bf2f(bf16 h) { return __uint_as_float((unsigned)h << 16); }
__device__ __forceinline__ float bflo(unsigned w) { return __uint_as_float(w << 16); }
__device__ __forceinline__ float bfhi(unsigned w) { return __uint_as_float(w & 0xffff0000u); }

#define XB_TMO      128
#define XB_XCNT(j)  (256  + 64 * (j))
#define XB_XSUB(j)  (1280 + 64 * (j))
#define XB_XGEN(j)  (2304 + 64 * (j))
#define XB_TOP      3328
#define XB_TOPGEN   3392
#define XCD_BAR_WORDS 3456
#define XB_SPIN_CAP (1u << 18)

__device__ __forceinline__ unsigned xb_ld(unsigned* p)              { return __hip_atomic_load(p, __ATOMIC_RELAXED, __HIP_MEMORY_SCOPE_AGENT); }
__device__ __forceinline__ unsigned xb_add(unsigned* p, unsigned v) { return __hip_atomic_fetch_add(p, v, __ATOMIC_RELAXED, __HIP_MEMORY_SCOPE_AGENT); }
__device__ __forceinline__ unsigned xb_xcc_id() { return (unsigned)__builtin_amdgcn_s_getreg((3 << 11) | 20) & 0xFu; }
#define XB_SPIN(cond, bar) do { unsigned _sp = 0; while (cond) { __builtin_amdgcn_s_sleep(1); \
    if ((++_sp & 255u) == 0u) { if (xb_ld(&(bar)[XB_TMO])) break; if (_sp > XB_SPIN_CAP) { atomicAdd(&(bar)[XB_TMO], 1u); break; } } } } while (0)

struct XcdBarrier {
    unsigned* bar; unsigned x;
    volatile LAS unsigned* st;
};

__device__ __forceinline__ XcdBarrier xcd_barrier_post(unsigned* bar, volatile LAS unsigned* st) {
    XcdBarrier b; b.bar = bar; b.x = xb_xcc_id(); b.st = st;
    if (threadIdx.x == 0) (void)xb_add(&bar[XB_XCNT(b.x)], 1u);
    return b;
}
__device__ __forceinline__ void xcd_barrier_complete(unsigned* bar, unsigned x, unsigned& nloc, unsigned& nx) {
    const unsigned G = gridDim.x * gridDim.y * gridDim.z;
    unsigned sum, cnt, mine, sp = 0u;
    for (;;) {
        sum = 0u; cnt = 0u; mine = 0u;
#pragma unroll
        for (unsigned j = 0; j < 16; ++j) { const unsigned c = xb_ld(&bar[XB_XCNT(j)]); sum += c; cnt += (c > 0u) ? 1u : 0u; mine = (j == x) ? c : mine; }
        if (sum == G) break;
        __builtin_amdgcn_s_sleep(1);
        if ((++sp & 255u) == 0u) { if (xb_ld(&bar[XB_TMO])) break; if (sp > XB_SPIN_CAP) { atomicAdd(&bar[XB_TMO], 1u); break; } }
    }
    nloc = mine > 0u ? mine : 1u; nx = cnt > 0u ? cnt : 1u;
}

__device__ __forceinline__ void xcd_barrier(const XcdBarrier& b) {
    asm volatile("s_waitcnt vmcnt(0)" ::: "memory");
    __syncthreads();
    if (threadIdx.x == 0) {
        unsigned* bar = b.bar;
        __builtin_amdgcn_s_waitcnt(0);
        unsigned nloc = b.st[0], nx = b.st[1];
        if (nloc == 0u) { xcd_barrier_complete(bar, b.x, nloc, nx); b.st[0] = nloc; b.st[1] = nx; }
        const unsigned old = xb_add(&bar[XB_XSUB(b.x)], 1u);
        const unsigned gen = old / nloc;
        if (old + 1u == (gen + 1u) * nloc) {
            __builtin_amdgcn_fence(__ATOMIC_RELEASE, "agent");
            asm volatile("s_waitcnt vmcnt(0)" ::: "memory");
            const unsigned og = xb_add(&bar[XB_TOP], 1u);
            const unsigned tg = og / nx;
            if (og + 1u == (tg + 1u) * nx) xb_add(&bar[XB_TOPGEN], 1u);
            else XB_SPIN(xb_ld(&bar[XB_TOPGEN]) == tg, bar);
            __builtin_amdgcn_fence(__ATOMIC_ACQUIRE, "agent");
            xb_add(&bar[XB_XGEN(b.x)], 1u);
            asm volatile("s_waitcnt vmcnt(0)" ::: "memory");
        } else {
            XB_SPIN(xb_ld(&bar[XB_XGEN(b.x)]) == gen, bar);
            __builtin_amdgcn_fence(__ATOMIC_ACQUIRE, "agent");
            asm volatile("s_waitcnt vmcnt(0)" ::: "memory");
        }
    }
    __syncthreads();
}

constexpr int NWAVES = 8, NTHR = 512;
constexpr int BATCH = 8, T = 2048, D = 1024, M = BATCH * T, NMEM = 256, MMEM = BATCH * NMEM, FF = 4096, DEPTH = 4;
constexpr int AB_IN = 2576, GDN_IN = 4112, NIN_E = 2816, NIN_O = 4096;
constexpr float EPS = 1e-6f;
enum InIdx { I_X = 0, I_MEM, I_MIX_PRE_G, I_MIX_POST_G, I_AB_W_IN, I_GK_W2, I_GK_B, I_GLA_NORM_G, I_LRU_CONV_W, I_LRU_CONV_B, I_LRU_W_A, I_LRU_B_A, I_LRU_W_X, I_LRU_B_X,
             I_LRU_LAMBDA, I_AB_W_OUT, I_GDN_W_IN, I_GDN_CONV_W, I_GDN_A_LOG, I_GDN_DT_BIAS, I_GDN_NORM_G, I_GDN_W_OUT, I_XA_PRE_G, I_XA_MEM_G, I_XA_POST_G, I_XA_W_Q,
             I_XA_W_KV, I_XA_W_O, I_MLP_PRE_G, I_MLP_POST_G, I_MLP_W1, I_MLP_W2, N_IN };

constexpr size_t KiB = 1u << 10, MiB = 1u << 20;
constexpr size_t WS_CTL = 0, CTL_ZERO_BYTES = 65536;
constexpr size_t WS_BA = 1 * MiB;
constexpr size_t WS_SCAL = 2 * MiB;
constexpr size_t WS_HALO = 3 * MiB;
constexpr size_t WS_LRUW = 7 * MiB + 768 * KiB;
constexpr size_t WS_W = 8 * MiB + 512 * KiB;
constexpr size_t WL_E = 27 * MiB + 512 * KiB, WL_O = 30 * MiB + 128 * KiB;
constexpr size_t WS_KALL = WS_W + 2 * WL_E + 2 * WL_O;
constexpr size_t WS_VT = WS_KALL + 16 * MiB;
constexpr size_t WS_ACT = WS_VT + 16 * MiB;
constexpr size_t WS_R = WS_ACT + 32 * MiB;
constexpr size_t WS_AQK = WS_R + 128 * MiB;
constexpr size_t WS_END = WS_AQK + 16 * MiB;
constexpr size_t WS_WK = WS_R, WS_WV = WS_R + 8 * MiB, WS_MEMN = WS_R + 16 * MiB, WS_QO = WS_R + 64 * MiB;
constexpr int CW_BAR = 4096;
constexpr int RING_BYTES = 131072, LDS_BYTES = 163840, LDSCTL_OFF = LDS_BYTES - 1024, MISC_OFF = LDSCTL_OFF + 320;
enum WOff { WO_IN = 0, WO_OUT, WO_Q, WO_O, WO_W1, WO_W2, WO_BA };

struct Args { const float* in[N_IN]; float* out; unsigned char* ws; int ph_lo, ph_hi; };

__device__ __forceinline__ float wave_sum(float v) {
#pragma unroll
    for (int o = 1; o < 64; o <<= 1) v += __shfl_xor(v, o);
    return v;
}
__device__ __forceinline__ float sigmoidf_(float x) { return 1.0f / (1.0f + __expf(-x)); }
__device__ __forceinline__ float siluf_(float x) { return x / (1.0f + __expf(-x)); }
__device__ __forceinline__ float softplusf_(float x) { return fmaxf(x, 0.f) + log1pf(__expf(-fabsf(x))); }
__device__ __forceinline__ float gelu_tanh(float x) { const float u = 0.7978845608028654f * (x + 0.044715f * x * x * x); return 0.5f * x * (1.0f + tanhf(u)); }

struct Job { const float* W; int ldw, c0, ncols, k_lo, Kr; bf16* WT; int dstK, r0; const float* gain; int gmask; float sc; };
__device__ __forceinline__ bf16* wl(unsigned char* ws, int i, int which) {
    const size_t lbase = WS_W + (size_t)(i >> 1) * (WL_E + WL_O) + ((i & 1) ? WL_E : 0);
    const size_t win = (i & 1) ? 8 * MiB : 5 * MiB + 512 * KiB;
    size_t off = 0;
    if (which == WO_OUT) off = win; else if (which == WO_Q) off = win + 2 * MiB; else if (which == WO_O) off = win + 4 * MiB;
    else if (which == WO_W1) off = win + 6 * MiB; else if (which == WO_W2) off = win + 14 * MiB; else if (which == WO_BA) off = win + 22 * MiB;
    return (bf16*)(ws + lbase + off);
}
__device__ __forceinline__ void get_job(const Args& a, int jid, Job& J) {
    const int i = jid / 10, s = jid % 10, j = i >> 1; const bool even = !(i & 1);
    unsigned char* ws = a.ws;
    J.c0 = 0; J.k_lo = 0; J.Kr = 1024; J.dstK = 1024; J.r0 = 0; J.gain = nullptr; J.gmask = 1023; J.sc = 1.f; J.ncols = 1024; J.ldw = 1024; J.W = nullptr; J.WT = nullptr;
    if (jid >= DEPTH * 10) {
        const int s2 = jid - DEPTH * 10, jl = s2 >> 3, gate = (s2 >> 2) & 1, n = s2 & 3;
        J.W = (gate ? a.in[I_LRU_W_X] : a.in[I_LRU_W_A]) + (size_t)(jl * 4 + n) * 16384; J.ldw = 128; J.ncols = 128; J.Kr = 128; J.dstK = 128;
        J.WT = (bf16*)(ws + WS_LRUW) + (size_t)((jl * 2 + gate) * 4 + n) * 16384; return;
    }
    switch (s) {
    case 0: J.W = even ? a.in[I_AB_W_IN] + (size_t)j * 1024 * AB_IN : a.in[I_GDN_W_IN] + (size_t)j * 1024 * GDN_IN; J.ldw = even ? AB_IN : GDN_IN; J.ncols = even ? 1536 : 4096;
            J.WT = wl(ws, i, WO_IN); J.gain = a.in[I_MIX_PRE_G] + i * 1024; break;
    case 1: J.W = a.in[I_AB_W_IN] + (size_t)j * 1024 * AB_IN; J.ldw = AB_IN; J.c0 = 1552; J.ncols = even ? 1024 : 0; J.WT = wl(ws, i, WO_IN); J.r0 = 1536; J.gain = a.in[I_MIX_PRE_G] + i * 1024; break;
    case 2: J.W = even ? a.in[I_AB_W_OUT] + (size_t)j * 1024 * 1024 : a.in[I_GDN_W_OUT] + (size_t)j * 1024 * 1024; J.Kr = 512; J.WT = wl(ws, i, WO_OUT);
            J.gain = even ? a.in[I_GLA_NORM_G] + j * 128 : a.in[I_GDN_NORM_G] + j * 128; J.gmask = 127; break;
    case 3: J.W = even ? a.in[I_AB_W_OUT] + (size_t)j * 1024 * 1024 : a.in[I_GDN_W_OUT] + (size_t)j * 1024 * 1024; J.k_lo = 512; J.Kr = 512; J.WT = wl(ws, i, WO_OUT);
            J.gain = even ? nullptr : a.in[I_GDN_NORM_G] + j * 128; J.gmask = 127; break;
    case 4: J.W = a.in[I_XA_W_Q] + (size_t)i * 1024 * 1024; J.WT = wl(ws, i, WO_Q); J.gain = a.in[I_XA_PRE_G] + i * 1024; J.sc = 0.0625f; break;
    case 5: J.W = a.in[I_XA_W_KV] + (size_t)i * 1024 * 2048; J.ldw = 2048; J.WT = (bf16*)(ws + WS_WK); J.r0 = i * 1024; J.gain = a.in[I_XA_MEM_G] + i * 1024; break;
    case 6: J.W = a.in[I_XA_W_KV] + (size_t)i * 1024 * 2048; J.ldw = 2048; J.c0 = 1024; J.WT = (bf16*)(ws + WS_WV); J.r0 = i * 1024; J.gain = a.in[I_XA_MEM_G] + i * 1024; break;
    case 7: J.W = a.in[I_XA_W_O] + (size_t)i * 1024 * 1024; J.WT = wl(ws, i, WO_O); break;
    case 8: J.W = a.in[I_MLP_W1] + (size_t)i * 1024 * 4096; J.ldw = 4096; J.ncols = 4096; J.WT = wl(ws, i, WO_W1); J.gain = a.in[I_MLP_PRE_G] + i * 1024; break;
    default: J.W = a.in[I_MLP_W2] + (size_t)i * 4096 * 1024; J.Kr = 4096; J.dstK = 4096; J.WT = wl(ws, i, WO_W2); break;
    }
}
__device__ __forceinline__ void transpose_item(const Job& J, LAS float* scr, int item, int lane) {
    const int nblk = J.ncols / 32, kb = item / nblk, nb = item % nblk, k0 = J.k_lo + 64 * kb, n0 = 32 * nb;
#pragma unroll 8
    for (int i = 0; i < 32; ++i) { const int kk = 2 * i + (lane >> 5); const int k = k0 + kk;
        float v = J.W[(size_t)k * J.ldw + J.c0 + n0 + (lane & 31)];
        const float g = J.gain ? J.gain[k & J.gmask] : 1.0f;
        scr[kk * 33 + (lane & 31)] = v * g * J.sc; }
    LDS_WAIT(); asm volatile("" ::: "memory");
    const int c = lane & 7;
#pragma unroll
    for (int jj = 0; jj < 4; ++jj) { const int n = (lane >> 3) + 8 * jj; const LAS float* s = scr + (8 * c) * 33 + n;
        v4u o; o.x = pk2(s[0 * 33], s[1 * 33]); o.y = pk2(s[2 * 33], s[3 * 33]); o.z = pk2(s[4 * 33], s[5 * 33]); o.w = pk2(s[6 * 33], s[7 * 33]);
        *(GAS v4u*)(J.WT + (size_t)(J.r0 + n0 + n) * J.dstK + k0 + 8 * c) = o; }
    LDS_WAIT(); asm volatile("" ::: "memory");
}
__device__ __forceinline__ void rms_row_to_bf16(const float* xrow, bf16* orow, int lane) {
    const GAS f32x4* xr = (const GAS f32x4*)xrow + lane;
    f32x4 v[4]; float s = 0.f;
#pragma unroll
    for (int j = 0; j < 4; ++j) { v[j] = xr[64 * j]; s += (v[j].x * v[j].x + v[j].y * v[j].y) + (v[j].z * v[j].z + v[j].w * v[j].w); }
    const float r = 1.0f / sqrtf(wave_sum(s) * (1.f / 1024.f) + EPS);
    GAS v2u* o8 = (GAS v2u*)orow + lane;
#pragma unroll
    for (int j = 0; j < 4; ++j) { v2u w; w.x = pk2(v[j].x * r, v[j].y * r); w.y = pk2(v[j].z * r, v[j].w * r); o8[64 * j] = w; }
}
__device__ __forceinline__ void phase_prologue(const Args& a, LAS unsigned char* lds, int bid, int G, int wave, int lane, int tid) {
    LAS float* scr = (LAS float*)(lds + wave * 16384);
    const int gw = bid * NWAVES + wave, NGW = G * NWAVES;
    {
        int jid = 0; Job J; get_job(a, 0, J); int jstart = 0, jn = (J.Kr / 64) * (J.ncols / 32);
        constexpr int NJOBS = DEPTH * 10 + 16;
        for (int it = gw;; it += NGW) {
            while (jid < NJOBS && it >= jstart + jn) { jstart += jn; ++jid; if (jid < NJOBS) { get_job(a, jid, J); jn = (J.Kr / 64) * (J.ncols / 32); } }
            if (jid >= NJOBS) break;
            transpose_item(J, scr, it - jstart, lane);
        }
    }
    for (int m = gw; m < M + MMEM; m += NGW) {
        if (m < M) rms_row_to_bf16(a.in[I_X] + (size_t)m * D, (bf16*)(a.ws + WS_ACT) + (size_t)m * D, lane);
        else rms_row_to_bf16(a.in[I_MEM] + (size_t)(m - M) * D, (bf16*)(a.ws + WS_MEMN) + (size_t)(m - M) * D, lane);
    }
    for (int it = gw; it < 2 * 256 * 16; it += NGW) {
        const int j = it / 4096, n = (it / 16) & 255, k = (it & 15) * 64 + lane, i = 2 * j;
        const float* wrow = a.in[I_AB_W_IN] + (size_t)j * 1024 * AB_IN + (size_t)k * AB_IN + 1536;
        const float* w2 = a.in[I_GK_W2] + j * 16 * 256 + n;
        float s = 0.f;
#pragma unroll
        for (int r = 0; r < 16; ++r) s += wrow[r] * w2[r * 256];
        s *= a.in[I_MIX_PRE_G][i * 1024 + k];
        wl(a.ws, i, WO_IN)[(size_t)(2560 + n) * 1024 + k] = f2bf(s);
    }
    for (int it = gw * 64 + lane; it < 2 * 16 * 1024; it += NGW * 64) {
        const int j = it / 16384, o = (it / 1024) & 15, k = it & 1023, i = 2 * j + 1;
        ((float*)wl(a.ws, i, WO_BA))[o * 1024 + k] = a.in[I_GDN_W_IN][(size_t)j * 1024 * GDN_IN + (size_t)k * GDN_IN + 4096 + o] * a.in[I_MIX_PRE_G][i * 1024 + k];
    }
    (void)tid;
}

template <bool MBF16>
__device__ __forceinline__ void phase_res(const void* mptr, const float* base, const float* gpost, float* out, bf16* xn, int gw, int NGW, int lane) {
    for (int row = gw; row < M; row += NGW) {
        f32x4 mv[4], hv[4], gv[4];
#pragma unroll
        for (int j = 0; j < 4; ++j) {
            const int idx = 4 * lane + 256 * j;
            if (MBF16) { const v2u w = *(const GAS v2u*)((const bf16*)mptr + (size_t)row * D + idx); mv[j] = (f32x4){bflo(w.x), bfhi(w.x), bflo(w.y), bfhi(w.y)}; }
            else mv[j] = *(const GAS f32x4*)((const float*)mptr + (size_t)row * D + idx);
            hv[j] = *(const GAS f32x4*)(base + (size_t)row * D + idx);
            gv[j] = *(const GAS f32x4*)(gpost + idx);
        }
        float s = 0.f;
#pragma unroll
        for (int j = 0; j < 4; ++j) s += (mv[j].x * mv[j].x + mv[j].y * mv[j].y) + (mv[j].z * mv[j].z + mv[j].w * mv[j].w);
        const float r1 = 1.0f / sqrtf(wave_sum(s) * (1.f / 1024.f) + EPS);
        float s2 = 0.f;
#pragma unroll
        for (int j = 0; j < 4; ++j) { hv[j] = hv[j] + mv[j] * gv[j] * r1; s2 += (hv[j].x * hv[j].x + hv[j].y * hv[j].y) + (hv[j].z * hv[j].z + hv[j].w * hv[j].w); }
        const float r2 = 1.0f / sqrtf(wave_sum(s2) * (1.f / 1024.f) + EPS);
#pragma unroll
        for (int j = 0; j < 4; ++j) {
            const int idx = 4 * lane + 256 * j;
            *(GAS f32x4*)(out + (size_t)row * D + idx) = hv[j];
            v2u w; w.x = pk2(hv[j].x * r2, hv[j].y * r2); w.y = pk2(hv[j].z * r2, hv[j].w * r2);
            *(GAS v2u*)(xn + (size_t)row * D + idx) = w;
        }
    }
}

__device__ __forceinline__ void phase_ba(const bf16* xn, const float* Wba, float* BA, LAS unsigned char* lds, int bid, int G, int wave, int lane, int tid) {
    LAS float* sw = (LAS float*)lds;
    for (int i = tid; i < 16 * 1024 / 4; i += NTHR) ((LAS f32x4*)sw)[i] = ((const GAS f32x4*)Wba)[i];
    __syncthreads();
    const int gw = bid * NWAVES + wave, NGW = G * NWAVES;
    for (int row = gw; row < M; row += NGW) {
        const v4u w0 = *(const GAS v4u*)(xn + (size_t)row * D + 8 * lane), w1 = *(const GAS v4u*)(xn + (size_t)row * D + 512 + 8 * lane);
        float xv[16] = {bflo(w0.x), bfhi(w0.x), bflo(w0.y), bfhi(w0.y), bflo(w0.z), bfhi(w0.z), bflo(w0.w), bfhi(w0.w),
                        bflo(w1.x), bfhi(w1.x), bflo(w1.y), bfhi(w1.y), bflo(w1.z), bfhi(w1.z), bflo(w1.w), bfhi(w1.w)};
        float res = 0.f;
#pragma unroll 1
        for (int o = 0; o < 16; ++o) {
            const LAS f32x4* p0 = (const LAS f32x4*)(sw + o * 1024 + 8 * lane); const LAS f32x4* p1 = (const LAS f32x4*)(sw + o * 1024 + 512 + 8 * lane);
            const f32x4 a0 = p0[0], a1 = p0[1], b0 = p1[0], b1 = p1[1];
            float s = xv[0] * a0.x + xv[1] * a0.y + xv[2] * a0.z + xv[3] * a0.w + xv[4] * a1.x + xv[5] * a1.y + xv[6] * a1.z + xv[7] * a1.w
                    + xv[8] * b0.x + xv[9] * b0.y + xv[10] * b0.z + xv[11] * b0.w + xv[12] * b1.x + xv[13] * b1.y + xv[14] * b1.z + xv[15] * b1.w;
            s = wave_sum(s);
            res = (lane == o) ? s : res;
        }
        if (lane < 16) BA[(size_t)row * 16 + lane] = res;
    }
    __syncthreads();
}

__device__ __forceinline__ void gla_seq_unit(const Args& a, int jl, int b, int h, const bf16* proj, bf16* mixed, LAS unsigned char* lds, int tid) {
    LAS float* sq = (LAS float*)lds; LAS float* sk = sq + 64; LAS float* se = sk + 64; LAS float* red = se + 64; LAS float* wss = red + 4 * 128;
    const int c = tid & 127, kq = tid >> 7, d0 = kq * 16, lane = tid & 63, wave = tid >> 6;
    float S[16];
#pragma unroll
    for (int i = 0; i < 16; ++i) S[i] = 0.f;
    const float gkb = (tid < 64) ? a.in[I_GK_B][jl * 256 + h * 64 + tid] : 0.f;
    const bf16* prow = proj + (size_t)b * T * NIN_E;
    bf16 nq = 0, nk = 0, ng = 0, nv, ngo = 0;
    if (tid < 64) { nq = prow[h * 64 + tid]; nk = prow[256 + h * 64 + tid]; ng = prow[2560 + h * 64 + tid]; }
    nv = prow[512 + h * 128 + c]; if (kq == 0) ngo = prow[1024 + h * 128 + c];
    for (int t = 0; t < T; ++t) {
        if (tid < 64) { const float x = bf2f(ng) + gkb; const float gk = -softplusf_(-x) * (1.f / 16.f); sq[tid] = bf2f(nq) * 0.125f; sk[tid] = bf2f(nk); se[tid] = __expf(gk); }
        const float v = bf2f(nv), go = bf2f(ngo);
        if (t + 1 < T) { const bf16* pn = prow + (size_t)(t + 1) * NIN_E;
            if (tid < 64) { nq = pn[h * 64 + tid]; nk = pn[256 + h * 64 + tid]; ng = pn[2560 + h * 64 + tid]; }
            nv = pn[512 + h * 128 + c]; if (kq == 0) ngo = pn[1024 + h * 128 + c]; }
        __syncthreads();
        float part = 0.f;
#pragma unroll
        for (int i = 0; i < 16; ++i) { S[i] = se[d0 + i] * S[i] + sk[d0 + i] * v; part += sq[d0 + i] * S[i]; }
        red[kq * 128 + c] = part;
        __syncthreads();
        float o = 0.f;
        if (kq == 0) { o = (red[c] + red[128 + c]) + (red[256 + c] + red[384 + c]); const float ss = wave_sum(o * o); if (lane == 0) wss[wave] = ss; }
        __syncthreads();
        if (kq == 0) { const float tot = wss[0] + wss[1]; const float r = 1.0f / sqrtf(tot * (1.f / 128.f) + EPS);
            mixed[(size_t)(b * T + t) * D + h * 128 + c] = f2bf(o * r * siluf_(go)); }
    }
    __syncthreads();
}
__device__ __forceinline__ void lru_seq_unit(const Args& a, int jl, int b, int n, const bf16* proj, bf16* mixed, LAS unsigned char* lds, int tid) {
    LAS float* sxr = (LAS float*)lds; LAS float* sig = sxr + 128;
    const bool act = tid < 256; const int j = tid & 127, gsel = (tid >> 7) & 1, ch = n * 128 + j;
    float w[128];
    {
        const float* wp = (gsel ? a.in[I_LRU_W_X] : a.in[I_LRU_W_A]) + ((size_t)(jl * 4 + n) * 128) * 128 + j;
#pragma unroll
        for (int i = 0; i < 128; ++i) w[i] = act ? wp[i * 128] : 0.f;
    }
    const float bias = (gsel ? a.in[I_LRU_B_X] : a.in[I_LRU_B_A])[jl * 512 + ch];
    const float cw0 = a.in[I_LRU_CONV_W][(jl * 4 + 0) * 512 + ch], cw1 = a.in[I_LRU_CONV_W][(jl * 4 + 1) * 512 + ch], cw2 = a.in[I_LRU_CONV_W][(jl * 4 + 2) * 512 + ch], cw3 = a.in[I_LRU_CONV_W][(jl * 4 + 3) * 512 + ch];
    const float cb = a.in[I_LRU_CONV_B][jl * 512 + ch];
    const float sp8 = 8.0f * softplusf_(-a.in[I_LRU_LAMBDA][jl * 512 + ch]);
    float x1 = 0.f, x2 = 0.f, x3 = 0.f, hst = 0.f;
    const bf16* prow = proj + (size_t)b * T * NIN_E;
    bf16 nx = 0, ngt = 0;
    if (tid < 128) { nx = prow[1536 + ch]; ngt = prow[2048 + ch]; }
    for (int t = 0; t < T; ++t) {
        float xr = 0.f, gate = 0.f;
        if (tid < 128) { const float x0 = bf2f(nx); gate = bf2f(ngt); xr = cw0 * x3 + cw1 * x2 + cw2 * x1 + cw3 * x0 + cb; x3 = x2; x2 = x1; x1 = x0; sxr[tid] = xr;
            if (t + 1 < T) { const bf16* pn = prow + (size_t)(t + 1) * NIN_E; nx = pn[1536 + ch]; ngt = pn[2048 + ch]; } }
        __syncthreads();
        float dot = bias;
        if (act) {
#pragma unroll
            for (int i4 = 0; i4 < 32; ++i4) { const f32x4 xv = ((const LAS f32x4*)sxr)[i4]; dot += xv.x * w[4 * i4] + xv.y * w[4 * i4 + 1] + xv.z * w[4 * i4 + 2] + xv.w * w[4 * i4 + 3]; }
        }
        const float sg = sigmoidf_(dot);
        if (act && gsel == 1) sig[j] = sg;
        __syncthreads();
        if (tid < 128) { const float ig = sig[j]; const float log_a = -sp8 * sg; const float av = __expf(log_a); const float u = sqrtf(-expm1f(2.0f * log_a)) * (ig * xr);
            hst = av * hst + u; mixed[(size_t)(b * T + t) * D + 512 + ch] = f2bf(hst * gelu_tanh(gate)); }
    }
    __syncthreads();
}
__device__ __forceinline__ void gdn_seq_unit(const Args& a, int jl, int b, int h, const bf16* proj, const float* BA, bf16* mixed, LAS unsigned char* lds, int tid) {
    LAS float* sq = (LAS float*)lds; LAS float* sk = sq + 128; LAS float* sv = sk + 128; LAS float* red = sv + 128; LAS float* red2 = red + 512; LAS float* wss = red2 + 512; LAS float* wss2 = wss + 8;
    const int c = tid & 127, kq = tid >> 7, d0 = kq * 32, lane = tid & 63, wave = tid >> 6;
    float S[32];
#pragma unroll
    for (int i = 0; i < 32; ++i) S[i] = 0.f;
    const int col = (kq < 3 ? kq : 3) * 1024 + h * 128 + c;
    float cw0 = 0.f, cw1 = 0.f, cw2 = 0.f, cw3 = 0.f;
    if (kq < 3) { const float* cwp = a.in[I_GDN_CONV_W] + (size_t)jl * 4 * 3072 + col; cw0 = cwp[0]; cw1 = cwp[3072]; cw2 = cwp[2 * 3072]; cw3 = cwp[3 * 3072]; }
    const float Aneg = -__expf(a.in[I_GDN_A_LOG][jl * 8 + h]), dtb = a.in[I_GDN_DT_BIAS][jl * 8 + h];
    float x1 = 0.f, x2 = 0.f, x3 = 0.f;
    const bf16* prow = proj + (size_t)b * T * NIN_O; const float* barow = BA + (size_t)b * T * 16;
    bf16 nx = prow[col]; float nb = barow[h], na = barow[8 + h];
    for (int t = 0; t < T; ++t) {
        const float x0 = bf2f(nx); const float beta = sigmoidf_(nb); const float eg = __expf(Aneg * softplusf_(na + dtb));
        if (t + 1 < T) { nx = prow[(size_t)(t + 1) * NIN_O + col]; nb = barow[(t + 1) * 16 + h]; na = barow[(t + 1) * 16 + 8 + h]; }
        float y = 0.f;
        if (kq < 3) { y = cw0 * x3 + cw1 * x2 + cw2 * x1 + cw3 * x0; x3 = x2; x2 = x1; x1 = x0; y = siluf_(y); }
        if (kq == 0) sq[c] = y; else if (kq == 1) sk[c] = y; else if (kq == 2) sv[c] = y;
        { const float ss = wave_sum(y * y); if (lane == 0) wss[wave] = ss; }
        __syncthreads();
        const float nqf = (1.0f / sqrtf(wss[0] + wss[1] + EPS)) * 0.08838834764831845f, nkf = 1.0f / sqrtf(wss[2] + wss[3] + EPS);
        float part = 0.f;
#pragma unroll
        for (int i = 0; i < 32; ++i) { S[i] *= eg; part += sk[d0 + i] * S[i]; }
        red[kq * 128 + c] = part * nkf;
        __syncthreads();
        const float kS = (red[c] + red[128 + c]) + (red[256 + c] + red[384 + c]);
        const float vnew = beta * (sv[c] - kS) * nkf;
        float opart = 0.f;
#pragma unroll
        for (int i = 0; i < 32; ++i) { S[i] += sk[d0 + i] * vnew; opart += sq[d0 + i] * S[i]; }
        red2[kq * 128 + c] = opart * nqf;
        __syncthreads();
        float o = 0.f;
        if (kq == 3) { o = (red2[c] + red2[128 + c]) + (red2[256 + c] + red2[384 + c]); const float ss = wave_sum(o * o); if (lane == 0) wss2[wave - 6] = ss; }
        __syncthreads();
        if (kq == 3) { const float tot = wss2[0] + wss2[1]; const float r = 1.0f / sqrtf(tot * (1.f / 128.f) + EPS);
            mixed[(size_t)(b * T + t) * D + h * 128 + c] = f2bf(o * r * siluf_(x0)); }
    }
    __syncthreads();
}

#define MFMA32(a_, b_, c_) __builtin_amdgcn_mfma_f32_32x32x16_bf16((a_), (b_), (c_), 0, 0, 0)
__device__ __forceinline__ bf16x8 pack8(const f32x16& x, int s) {
    v4u p; p.x = pk2(x[8 * s], x[8 * s + 1]); p.y = pk2(x[8 * s + 2], x[8 * s + 3]); p.z = pk2(x[8 * s + 4], x[8 * s + 5]); p.w = pk2(x[8 * s + 6], x[8 * s + 7]);
    return __builtin_bit_cast(bf16x8, p);
}
__device__ __forceinline__ void attn_unit(int l, int pm, int h, bf16* QO, const bf16* Kall, const bf16* Vt, int wave, int lane) {
    const int b = pm >> 3, r = lane & 31, hh = lane >> 5, row = pm * 256 + wave * 32 + r;
    bf16* qrow = QO + (size_t)row * D + h * 256;
    bf16x8 qf[16];
#pragma unroll
    for (int s = 0; s < 16; ++s) qf[s] = *(const GAS bf16x8*)(qrow + 16 * s + 8 * hh);
    f32x16 st[8];
    const bf16* kbase = Kall + (size_t)(b * 256 + r) * 4096 + l * 1024 + h * 256 + 8 * hh;
#pragma unroll
    for (int kb = 0; kb < 8; ++kb) {
        f32x16 acc;
#pragma unroll
        for (int i = 0; i < 16; ++i) acc[i] = 0.f;
#pragma unroll
        for (int s = 0; s < 16; ++s) { const bf16x8 kf = *(const GAS bf16x8*)(kbase + (size_t)(32 * kb) * 4096 + 16 * s); acc = MFMA32(kf, qf[s], acc); }
        st[kb] = acc;
    }
    float mx = -3.0e38f;
#pragma unroll
    for (int kb = 0; kb < 8; ++kb)
#pragma unroll
        for (int i = 0; i < 16; ++i) mx = fmaxf(mx, st[kb][i]);
    mx = fmaxf(mx, __shfl_xor(mx, 32));
    float sum = 0.f;
#pragma unroll
    for (int kb = 0; kb < 8; ++kb)
#pragma unroll
        for (int i = 0; i < 16; ++i) { const float p = __expf(st[kb][i] - mx); st[kb][i] = p; sum += p; }
    sum += __shfl_xor(sum, 32);
    const float inv = 1.0f / sum;
    bf16x8 pf[8][2];
#pragma unroll
    for (int kb = 0; kb < 8; ++kb) { pf[kb][0] = pack8(st[kb], 0); pf[kb][1] = pack8(st[kb], 1); }
    const bf16* vbase = Vt + (size_t)(l * 1024 + h * 256 + r) * MMEM + b * 256 + 4 * hh;
#pragma unroll
    for (int db = 0; db < 8; ++db) {
        f32x16 y;
#pragma unroll
        for (int i = 0; i < 16; ++i) y[i] = 0.f;
#pragma unroll
        for (int kb = 0; kb < 8; ++kb)
#pragma unroll
            for (int s = 0; s < 2; ++s) {
                const bf16* vp = vbase + (size_t)(32 * db) * MMEM + 32 * kb + 16 * s;
                const s16x4 lo = *(const GAS s16x4*)vp, hi = *(const GAS s16x4*)(vp + 8);
                const bf16x8 va = __builtin_shufflevector(lo, hi, 0, 1, 2, 3, 4, 5, 6, 7);
                y = MFMA32(va, pf[kb][s], y);
            }
#pragma unroll
        for (int g = 0; g < 4; ++g) { v2u w; w.x = pk2(y[4 * g] * inv, y[4 * g + 1] * inv); w.y = pk2(y[4 * g + 2] * inv, y[4 * g + 3] * inv);
            *(GAS v2u*)(qrow + 32 * db + 8 * g + 4 * hh) = w; }
    }
}


namespace pg8 {
struct EpiGdnIn {
    static constexpr bool PERM = true, AFTER_DRAIN = false;
    bf16_t* P; bf16_t* halo;
    __device__ __forceinline__ void operator()(const f32x4 (&acc)[2][2][4][2], const Unit& u, int wr, int wc, int fr, int fq) const {
        const int row0 = u.pm * BM + wr * 64 + fr; const int t = u.pn >> 2; const int col0 = (u.pn & 3) * BM + wc * 32 + 8 * fq;
        bf16_t* base = P + (size_t)t * ((size_t)16384 * 1024);
#pragma unroll
        for (int ai = 0; ai < 2; ++ai)
#pragma unroll
            for (int m = 0; m < 4; ++m) { const int row = row0 + ai * HALF + m * 16; bf16_t* rowp = base + (size_t)row * 1024 + col0;
#pragma unroll
                for (int bj = 0; bj < 2; ++bj) { const f32x4 v0 = acc[ai][bj][m][0], v1 = acc[ai][bj][m][1];
                    u32x4 w; w.x = pk_bf16(v0[0], v0[1]); w.y = pk_bf16(v0[2], v0[3]); w.z = pk_bf16(v1[0], v1[1]); w.w = pk_bf16(v1[2], v1[3]);
                    *(u32x4*)(rowp + bj * HALF) = w;
                    if (m == 3 && t < 3 && fr >= 13) *(u32x4*)(halo + (((size_t)t * 257 + (row >> 6) + 1) * 3 + (fr - 13)) * 1024 + col0 + bj * HALF) = w; } }
    }
};
}

__device__ __forceinline__ int crow(int reg, int hh) { return (reg & 3) + 8 * (reg >> 2) + 4 * hh; }
__device__ __forceinline__ s16x4 tr4(const LAS unsigned char* img, int RS, int rowbase, int col0, int lane) {
    const int blk = (lane >> 4) & 1, q = (lane & 15) >> 2, p = lane & 3;
    return __builtin_amdgcn_ds_read_tr16_b64_v4i16((LAS s16x4*)(img + (rowbase + q) * RS + (col0 + 16 * blk + 4 * p) * 2));
}
__device__ __forceinline__ bf16x8 cat8(s16x4 lo, s16x4 hi) { return __builtin_shufflevector(lo, hi, 0, 1, 2, 3, 4, 5, 6, 7); }
__device__ __forceinline__ bf16x8 ldperm(const LAS unsigned char* p) { return cat8(*(const LAS s16x4*)p, *(const LAS s16x4*)(p + 16)); }

constexpr int RS128 = 272, RS64 = 144;
constexpr int GA_QI = 0, GA_KI = 17408, GA_RK = 34816, GA_RV = 67584, GA_MM = 100352, GA_SC = 116736;
constexpr size_t PSZ = (size_t)M * 1024;

#ifdef PROBE_SUB
#define PT_(id, x) do { if (PROBE_SUB == (id)) { x; } } while (0)
#else
#define PT_(id, x) do { } while (0)
#endif
__device__ __forceinline__ void gdn_a_unit(const Args& a, int jl, int unit, unsigned char* ws, LAS unsigned char* lds, int tid, unsigned long long& pacc) {
    unsigned long long pt0 = 0; (void)pt0;
    const int lane = tid & 63, wave = __builtin_amdgcn_readfirstlane(tid >> 6);
    const int b = unit >> 8, h = (unit >> 5) & 7, n = unit & 31;
    const int rowbase = b * T + n * 64, gcidx = b * 32 + n;
    bf16* Pq = (bf16*)(ws + WS_R); const bf16* halo = (const bf16*)(ws + WS_HALO);
    LAS float* SCb = (LAS float*)(lds + GA_SC); LAS float* SCg = SCb + 64;
    if (wave == 0) {
        const float* ba = (const float*)(ws + WS_BA) + (size_t)(rowbase + lane) * 16;
        const float beta = sigmoidf_(ba[h]);
        const float Aneg = -__expf(a.in[I_GDN_A_LOG][jl * 8 + h]), dtb = a.in[I_GDN_DT_BIAS][jl * 8 + h];
        float g = Aneg * softplusf_(ba[8 + h] + dtb);
#pragma unroll
        for (int o = 1; o < 64; o <<= 1) { const float v = __shfl_up(g, o); if (lane >= o) g += v; }
        const float gl = __shfl(g, 63);
        SCb[lane] = beta; SCg[lane] = g;
        float* sc = (float*)(ws + WS_SCAL) + (size_t)unit * 128; sc[lane] = __expf(g); sc[64 + lane] = __expf(gl - g);
    }
    __syncthreads();
    PT_(1, pt0 = __builtin_amdgcn_s_memrealtime());
#pragma unroll
    for (int m = 0; m < 6; ++m) {
        const int x = m >> 1, tok = (tid >> 4) + 32 * (m & 1), grp = tid & 15, col = h * 128 + grp * 8;
        v4u rawv[4];
        {
            const bf16* Px = Pq + (size_t)x * PSZ;
#pragma unroll
            for (int kk = 0; kk < 4; ++kk) {
                const int tt = tok - 3 + kk;
                v4u raw = {0u, 0u, 0u, 0u};
                if (tt >= 0) raw = *(const GAS v4u*)(Px + (size_t)(rowbase + tt) * 1024 + col);
                else if (n > 0) raw = *(const GAS v4u*)(halo + (((size_t)x * 257 + gcidx) * 3 + (tt + 3)) * 1024 + col);
                rawv[kk] = raw;
            }
        }
        float y[8];
#pragma unroll
        for (int c = 0; c < 8; ++c) y[c] = 0.f;
#pragma unroll
        for (int kk = 0; kk < 4; ++kk) {
            const v4u raw = rawv[kk];
            const float* cwp = a.in[I_GDN_CONV_W] + (size_t)(jl * 4 + kk) * 3072 + x * 1024 + col;
            const f32x4 c0 = *(const GAS f32x4*)cwp, c1 = *(const GAS f32x4*)(cwp + 4);
            y[0] += c0.x * bflo(raw.x); y[1] += c0.y * bfhi(raw.x); y[2] += c0.z * bflo(raw.y); y[3] += c0.w * bfhi(raw.y);
            y[4] += c1.x * bflo(raw.z); y[5] += c1.y * bfhi(raw.z); y[6] += c1.z * bflo(raw.w); y[7] += c1.w * bfhi(raw.w);
        }
        float ss = 0.f;
#pragma unroll
        for (int c = 0; c < 8; ++c) { y[c] = siluf_(y[c]); ss += y[c] * y[c]; }
        if (x < 2) {
            ss += __shfl_xor(ss, 1); ss += __shfl_xor(ss, 2); ss += __shfl_xor(ss, 4); ss += __shfl_xor(ss, 8);
            const float rr = (1.0f / sqrtf(ss + EPS)) * (x == 0 ? 0.08838834764831845f : 1.0f);
#pragma unroll
            for (int c = 0; c < 8; ++c) y[c] *= rr;
            v4u w; w.x = pk2(y[0], y[1]); w.y = pk2(y[2], y[3]); w.z = pk2(y[4], y[5]); w.w = pk2(y[6], y[7]);
            *(LAS v4u*)(lds + (x == 0 ? GA_QI : GA_KI) + tok * RS128 + grp * 16) = w;
        }
        if (x >= 1) {
            const float f = (x == 1) ? SCb[tok] * __expf(SCg[tok]) : SCb[tok];
            LAS f32x4* dst = (LAS f32x4*)(lds + (x == 1 ? GA_RK : GA_RV) + (tok * 128 + grp * 8) * 4);
            dst[0] = (f32x4){y[0] * f, y[1] * f, y[2] * f, y[3] * f}; dst[1] = (f32x4){y[4] * f, y[5] * f, y[6] * f, y[7] * f};
        }
    }
    __syncthreads();
    PT_(1, pacc += __builtin_amdgcn_s_memrealtime() - pt0);
    PT_(2, pt0 = __builtin_amdgcn_s_memrealtime());
    {
        const int which = wave >> 2, it = (wave >> 1) & 1, jt = wave & 1, r = lane & 31, hh = lane >> 5;
        if (!(it == 0 && jt == 1)) {
            f32x16 acc;
#pragma unroll
            for (int i = 0; i < 16; ++i) acc[i] = 0.f;
            const LAS unsigned char* Ap = lds + (which ? GA_QI : GA_KI) + (32 * it + r) * RS128 + 16 * hh;
            const LAS unsigned char* Bp = lds + GA_KI + (32 * jt + r) * RS128 + 16 * hh;
#pragma unroll
            for (int s = 0; s < 8; ++s) acc = MFMA32(*(const LAS bf16x8*)(Ap + 32 * s), *(const LAS bf16x8*)(Bp + 32 * s), acc);
            const int tj = 32 * jt + r; const float gj = SCg[tj];
            LAS float* MMp = (LAS float*)(lds + GA_MM); bf16* aq = (bf16*)(ws + WS_AQK) + (size_t)unit * 4096;
#pragma unroll
            for (int i = 0; i < 16; ++i) {
                const int ti = 32 * it + crow(i, hh); const float e = __expf(SCg[ti] - gj);
                if (which == 0) MMp[ti * 64 + tj] = (tj < ti) ? SCb[ti] * acc[i] * e : 0.f;
                else aq[ti * 64 + tj] = f2bf((tj <= ti) ? acc[i] * e : 0.f);
            }
        }
    }
    __syncthreads();
    PT_(2, pacc += __builtin_amdgcn_s_memrealtime() - pt0);
    PT_(3, pt0 = __builtin_amdgcn_s_memrealtime());
    if (wave < 4) {
        const int c = (wave & 1) * 64 + lane;
        const LAS float* rhs = (const LAS float*)(lds + (wave < 2 ? GA_RK : GA_RV)) + c;
        int zoff = 0; asm volatile("" : "+v"(zoff));
        const LAS float* MMp = (const LAS float*)(lds + GA_MM) + zoff;
        float t[64];
#pragma unroll
        for (int i = 0; i < 64; ++i) t[i] = 0.f;
#pragma unroll
        for (int i = 0; i < 64; ++i) {
            float p0 = 0.f, p1 = 0.f, p2 = 0.f, p3 = 0.f;
#pragma unroll
            for (int j4 = 0; j4 < (i + 3) / 4; ++j4) { const f32x4 mq = *(const LAS f32x4*)(MMp + i * 64 + 4 * j4);
                p0 += mq.x * t[4 * j4]; if (4 * j4 + 1 < i) p1 += mq.y * t[4 * j4 + 1]; if (4 * j4 + 2 < i) p2 += mq.z * t[4 * j4 + 2]; if (4 * j4 + 3 < i) p3 += mq.w * t[4 * j4 + 3]; }
            t[i] = rhs[i * 128] - ((p0 + p1) + (p2 + p3));
        }
        if (wave < 2) {
            bf16* wn = (bf16*)(ws + WS_ACT) + (size_t)unit * 8192 + c;
#pragma unroll
            for (int i = 0; i < 64; ++i) wn[i * 128] = f2bf(-t[i]);
        } else {
            const int w = c >> 5, r = c & 31;
#pragma unroll
            for (int it = 0; it < 2; ++it)
#pragma unroll
                for (int hh = 0; hh < 2; ++hh) {
                    const int o = ((w * 2 + it) * 64 + hh * 32 + r) * 32;
                    unsigned char* dst = (unsigned char*)(Pq + 2 * PSZ) + ((size_t)(rowbase + (o >> 8)) * 1024 + h * 128) * 2 + (o & 255);
                    v4u w0, w1;
                    w0.x = pk2(t[32 * it + crow(0, hh)], t[32 * it + crow(1, hh)]); w0.y = pk2(t[32 * it + crow(2, hh)], t[32 * it + crow(3, hh)]);
                    w0.z = pk2(t[32 * it + crow(4, hh)], t[32 * it + crow(5, hh)]); w0.w = pk2(t[32 * it + crow(6, hh)], t[32 * it + crow(7, hh)]);
                    w1.x = pk2(t[32 * it + crow(8, hh)], t[32 * it + crow(9, hh)]); w1.y = pk2(t[32 * it + crow(10, hh)], t[32 * it + crow(11, hh)]);
                    w1.z = pk2(t[32 * it + crow(12, hh)], t[32 * it + crow(13, hh)]); w1.w = pk2(t[32 * it + crow(14, hh)], t[32 * it + crow(15, hh)]);
                    *(GAS v4u*)dst = w0; *(GAS v4u*)(dst + 16) = w1;
                }
        }
    } else {
        const int lt = tid - 256;
#pragma unroll
        for (int k = 0; k < 8; ++k) {
            const int cidx = lt + 256 * k, x = cidx >> 10, row = (cidx >> 4) & 63, ch = cidx & 15;
            const v4u v = *(const LAS v4u*)(lds + (x ? GA_KI : GA_QI) + row * RS128 + ch * 16);
            *(GAS v4u*)(Pq + (size_t)x * PSZ + (size_t)(rowbase + row) * 1024 + h * 128 + ch * 8) = v;
        }
    }
    __syncthreads();
    PT_(3, pacc += __builtin_amdgcn_s_memrealtime() - pt0);
}

constexpr int GB_QI = 0, GB_KI = 17408, GB_WI = 34816, GB_AI = 52224, GB_OB0 = 61440, GB_OB1 = 78848, GB_SC = 96256, GB_UB = 96768;
__device__ __forceinline__ void gdn_b_unit(int bh, unsigned char* ws, LAS unsigned char* lds, int tid) {
    const int lane = tid & 63, wave = __builtin_amdgcn_readfirstlane(tid >> 6), r = lane & 31, hh = lane >> 5;
    const int b = bh >> 3, h = bh & 7;
    bf16* Pq = (bf16*)(ws + WS_R); bf16* Pk = Pq + PSZ; bf16* Pv = Pq + 2 * PSZ; bf16* Pz = Pq + 3 * PSZ;
    const bf16* Wn = (const bf16*)(ws + WS_ACT); const bf16* Aq = (const bf16*)(ws + WS_AQK); const float* Sc = (const float*)(ws + WS_SCAL);
    const bool comp = wave < 4;
    int lt = tid & 255;
    f32x16 S[4];
#pragma unroll
    for (int dt = 0; dt < 4; ++dt)
#pragma unroll
        for (int i = 0; i < 16; ++i) S[dt][i] = 0.f;
    v4u pq[4], pk[4], pw[4], pa[2], pu[4], zc[4], zn[4]; f32x4 psc = {0.f, 0.f, 0.f, 0.f};
#define GB_LOAD(nn) do { const int un_ = bh * 32 + (nn); const size_t rb_ = (size_t)(b * T + (nn) * 64); \
        _Pragma("unroll") for (int k = 0; k < 4; ++k) { const int ci = lt + 256 * k, row = ci >> 4, ch = ci & 15; \
            pq[k] = *(const GAS v4u*)(Pq + (rb_ + row) * 1024 + h * 128 + ch * 8); pk[k] = *(const GAS v4u*)(Pk + (rb_ + row) * 1024 + h * 128 + ch * 8); \
            pw[k] = *(const GAS v4u*)(Wn + (size_t)un_ * 8192 + row * 128 + ch * 8); } \
        _Pragma("unroll") for (int k = 0; k < 2; ++k) { const int ci = lt + 256 * k, row = ci >> 3, ch = ci & 7; pa[k] = *(const GAS v4u*)(Aq + (size_t)un_ * 4096 + row * 64 + ch * 8); } \
        _Pragma("unroll") for (int k = 0; k < 4; ++k) { const int o_ = (lt + 256 * k) * 16; pu[k] = *(const GAS v4u*)((const unsigned char*)Pv + ((rb_ + (o_ >> 8)) * 1024 + h * 128) * 2 + (o_ & 255)); } \
        if (lt < 32) psc = *(const GAS f32x4*)(Sc + (size_t)un_ * 128 + lt * 4); } while (0)
#define GB_STORE() do { \
        _Pragma("unroll") for (int k = 0; k < 4; ++k) { const int ci = lt + 256 * k, row = ci >> 4, ch = ci & 15; \
            *(LAS v4u*)(lds + GB_QI + row * RS128 + ch * 16) = pq[k]; *(LAS v4u*)(lds + GB_KI + row * RS128 + ch * 16) = pk[k]; *(LAS v4u*)(lds + GB_WI + row * RS128 + ch * 16) = pw[k]; } \
        _Pragma("unroll") for (int k = 0; k < 2; ++k) { const int ci = lt + 256 * k, row = ci >> 3, ch = ci & 7; *(LAS v4u*)(lds + GB_AI + row * RS64 + ch * 16) = pa[k]; } \
        _Pragma("unroll") for (int k = 0; k < 4; ++k) *(LAS v4u*)(lds + GB_UB + (lt + 256 * k) * 16) = pu[k]; \
        if (lt < 32) *(LAS f32x4*)(lds + GB_SC + lt * 16) = psc; } while (0)
#define GB_LOADZ(dst, nn) do { const bf16* zp_ = Pz + (size_t)(b * T + (nn) * 64 + (lt >> 2)) * 1024 + h * 128 + (lt & 3) * 32; \
        _Pragma("unroll") for (int k = 0; k < 4; ++k) dst[k] = *(const GAS v4u*)(zp_ + 8 * k); } while (0)
#define GB_EPI(zr, nn) do { const int tok_ = lt >> 2, qt_ = lt & 3; const LAS unsigned char* ob_ = lds + (((nn) & 1) ? GB_OB1 : GB_OB0) + tok_ * RS128 + qt_ * 64; \
        v4u ov_[4]; float ss_ = 0.f; \
        _Pragma("unroll") for (int k = 0; k < 4; ++k) { ov_[k] = *(const LAS v4u*)(ob_ + 16 * k); \
            ss_ += bflo(ov_[k].x) * bflo(ov_[k].x) + bfhi(ov_[k].x) * bfhi(ov_[k].x) + bflo(ov_[k].y) * bflo(ov_[k].y) + bfhi(ov_[k].y) * bfhi(ov_[k].y) \
                 + bflo(ov_[k].z) * bflo(ov_[k].z) + bfhi(ov_[k].z) * bfhi(ov_[k].z) + bflo(ov_[k].w) * bflo(ov_[k].w) + bfhi(ov_[k].w) * bfhi(ov_[k].w); } \
        ss_ += __shfl_xor(ss_, 1); ss_ += __shfl_xor(ss_, 2); \
        const float rr_ = 1.0f / sqrtf(ss_ * (1.f / 128.f) + EPS); \
        bf16* op_ = Pz + (size_t)(b * T + (nn) * 64 + tok_) * 1024 + h * 128 + qt_ * 32; \
        _Pragma("unroll") for (int k = 0; k < 4; ++k) { v4u w_; \
            w_.x = pk2(bflo(ov_[k].x) * rr_ * siluf_(bflo(zr[k].x)), bfhi(ov_[k].x) * rr_ * siluf_(bfhi(zr[k].x))); \
            w_.y = pk2(bflo(ov_[k].y) * rr_ * siluf_(bflo(zr[k].y)), bfhi(ov_[k].y) * rr_ * siluf_(bfhi(zr[k].y))); \
            w_.z = pk2(bflo(ov_[k].z) * rr_ * siluf_(bflo(zr[k].z)), bfhi(ov_[k].z) * rr_ * siluf_(bfhi(zr[k].z))); \
            w_.w = pk2(bflo(ov_[k].w) * rr_ * siluf_(bflo(zr[k].w)), bfhi(ov_[k].w) * rr_ * siluf_(bfhi(zr[k].w))); \
            *(GAS v4u*)(op_ + 8 * k) = w_; } } while (0)
    if (comp) {
        const int w = wave;
        for (int n = 0; n < 32; ++n) {
            __syncthreads();
            int lane_o = lane; asm volatile("" : "+v"(lane_o)); const int r = lane_o & 31, hh = lane_o >> 5, lane = lane_o;
            bf16x8 Sb[4][2];
#pragma unroll
            for (int dt = 0; dt < 4; ++dt) { Sb[dt][0] = pack8(S[dt], 0); Sb[dt][1] = pack8(S[dt], 1); }
            const LAS float* scp = (const LAS float*)(lds + GB_SC);
            bf16x8 Vb[2][2], Vb2[2][2];
            LAS unsigned char* ob = lds + ((n & 1) ? GB_OB1 : GB_OB0);
#pragma unroll
            for (int it = 0; it < 2; ++it) {
                f32x16 Vn;
                {
                    const LAS unsigned char* up = lds + GB_UB + ((w * 2 + it) * 64 + lane) * 32;
                    const v4u u0 = *(const LAS v4u*)up, u1 = *(const LAS v4u*)(up + 16);
                    Vn[0] = bflo(u0.x); Vn[1] = bfhi(u0.x); Vn[2] = bflo(u0.y); Vn[3] = bfhi(u0.y); Vn[4] = bflo(u0.z); Vn[5] = bfhi(u0.z); Vn[6] = bflo(u0.w); Vn[7] = bfhi(u0.w);
                    Vn[8] = bflo(u1.x); Vn[9] = bfhi(u1.x); Vn[10] = bflo(u1.y); Vn[11] = bfhi(u1.y); Vn[12] = bflo(u1.z); Vn[13] = bfhi(u1.z); Vn[14] = bflo(u1.w); Vn[15] = bfhi(u1.w);
                }
#pragma unroll
                for (int dt = 0; dt < 4; ++dt)
#pragma unroll
                    for (int s = 0; s < 2; ++s) Vn = MFMA32(ldperm(lds + GB_WI + (32 * it + r) * RS128 + (32 * dt + 16 * s + 4 * hh) * 2), Sb[dt][s], Vn);
                Vb[it][0] = pack8(Vn, 0); Vb[it][1] = pack8(Vn, 1);
#pragma unroll
                for (int g = 0; g < 4; ++g) { const f32x4 e4 = *(const LAS f32x4*)(scp + 64 + 32 * it + 8 * g + 4 * hh);
                    Vn[4 * g] *= e4.x; Vn[4 * g + 1] *= e4.y; Vn[4 * g + 2] *= e4.z; Vn[4 * g + 3] *= e4.w; }
                Vb2[it][0] = pack8(Vn, 0); Vb2[it][1] = pack8(Vn, 1);
                f32x16 O;
#pragma unroll
                for (int i = 0; i < 16; ++i) O[i] = 0.f;
#pragma unroll
                for (int dt = 0; dt < 4; ++dt)
#pragma unroll
                    for (int s = 0; s < 2; ++s) O = MFMA32(ldperm(lds + GB_QI + (32 * it + r) * RS128 + (32 * dt + 16 * s + 4 * hh) * 2), Sb[dt][s], O);
#pragma unroll
                for (int g = 0; g < 4; ++g) { const f32x4 e4 = *(const LAS f32x4*)(scp + 32 * it + 8 * g + 4 * hh);
                    O[4 * g] *= e4.x; O[4 * g + 1] *= e4.y; O[4 * g + 2] *= e4.z; O[4 * g + 3] *= e4.w; }
#pragma unroll
                for (int jt = 0; jt <= it; ++jt)
#pragma unroll
                    for (int s = 0; s < 2; ++s) O = MFMA32(ldperm(lds + GB_AI + (32 * it + r) * RS64 + (32 * jt + 16 * s + 4 * hh) * 2), Vb[jt][s], O);
#pragma unroll
                for (int i = 0; i < 16; ++i) *(LAS bf16*)(ob + (32 * it + crow(i, hh)) * RS128 + (32 * w + r) * 2) = f2bf(O[i]);
                __builtin_amdgcn_sched_barrier(0);
            }
            const float decay = scp[63];
#pragma unroll
            for (int dt = 0; dt < 4; ++dt) {
#pragma unroll
                for (int i = 0; i < 16; ++i) S[dt][i] *= decay;
#pragma unroll
                for (int it = 0; it < 2; ++it)
#pragma unroll
                    for (int s = 0; s < 2; ++s) {
                        const int rowb = 32 * it + 16 * s + 4 * hh;
                        S[dt] = MFMA32(cat8(tr4(lds + GB_KI, RS128, rowb, 32 * dt, lane), tr4(lds + GB_KI, RS128, rowb + 8, 32 * dt, lane)), Vb2[it][s], S[dt]);
                    }
                __builtin_amdgcn_sched_barrier(0);
            }
            __syncthreads();
        }
    } else {
#pragma unroll
        for (int k = 0; k < 4; ++k) zn[k] = (v4u){0u, 0u, 0u, 0u};
        GB_LOAD(0); GB_STORE();
        for (int n = 0; n < 32; ++n) {
            __syncthreads();
            asm volatile("" : "+v"(lt));
#pragma unroll
            for (int k = 0; k < 4; ++k) zc[k] = zn[k];
            if (n + 1 < 32) GB_LOAD(n + 1);
            GB_LOADZ(zn, n);
            if (n >= 1) GB_EPI(zc, n - 1);
            __syncthreads();
            if (n + 1 < 32) GB_STORE();
        }
    }
    __syncthreads();
    if (!comp) GB_EPI(zn, 31);
    __syncthreads();
#undef GB_LOAD
#undef GB_STORE
#undef GB_LOADZ
#undef GB_EPI
}

constexpr size_t WS_GQT = WS_R + 88 * MiB;
constexpr size_t WS_GKB = WS_R + 96 * MiB;
constexpr size_t WS_GOI = WS_R + 104 * MiB;
constexpr size_t WS_XR = WS_R + 120 * MiB;
constexpr int EA_QT = 0, EA_KH = 9216, EA_VI = 18432, EA_PFX = 35840;
__device__ __forceinline__ void gla_a_unit(const Args& a, int jl, int unit, unsigned char* ws, LAS unsigned char* lds, int tid) {
    asm volatile("" : "+v"(tid));
    const int lane = tid & 63, wave = __builtin_amdgcn_readfirstlane(tid >> 6), r = lane & 31, hh = lane >> 5;
    const int b = unit >> 7, h = (unit >> 5) & 3, n = unit & 31;
    const size_t rowbase = (size_t)b * T + n * 64;
    const bf16* proj = (const bf16*)(ws + WS_R);
    LAS float* PFX = (LAS float*)(lds + EA_PFX);
    {
        const int d = lane; const float gkb = a.in[I_GK_B][jl * 256 + h * 64 + d];
        float c[8]; float run = 0.f; float qv[8], kv[8];
#pragma unroll
        for (int e = 0; e < 8; ++e) {
            const bf16* pr = proj + (rowbase + 8 * wave + e) * NIN_E;
            const float x = bf2f(pr[2560 + h * 64 + d]) + gkb;
            run += -softplusf_(-x) * (1.f / 16.f); c[e] = run;
            qv[e] = bf2f(pr[h * 64 + d]); kv[e] = bf2f(pr[256 + h * 64 + d]);
        }
        PFX[wave * 64 + d] = run;
        __syncthreads();
        float pre = 0.f, tot = 0.f;
#pragma unroll
        for (int w2 = 0; w2 < 8; ++w2) { const float v = PFX[w2 * 64 + d]; tot += v; if (w2 < wave) pre += v; }
        bf16* qg = (bf16*)(ws + WS_GQT) + (size_t)unit * 4096; bf16* kg = (bf16*)(ws + WS_GKB) + (size_t)unit * 4096;
#pragma unroll
        for (int e = 0; e < 8; ++e) {
            const int tok = 8 * wave + e; const float bb = pre + c[e];
            const bf16 qt = f2bf(qv[e] * 0.125f * __expf(bb)), kh = f2bf(kv[e] * __expf(-bb)), kb = f2bf(kv[e] * __expf(tot - bb));
            *(LAS bf16*)(lds + EA_QT + tok * RS64 + d * 2) = qt; *(LAS bf16*)(lds + EA_KH + tok * RS64 + d * 2) = kh;
            qg[tok * 64 + d] = qt; kg[tok * 64 + d] = kb;
        }
        if (wave == 0) ((float*)(ws + WS_SCAL))[(size_t)unit * 64 + d] = __expf(tot);
    }
#pragma unroll
    for (int k = 0; k < 2; ++k) { const int ci = tid + 512 * k, row = ci >> 4, ch = ci & 15;
        *(LAS v4u*)(lds + EA_VI + row * RS128 + ch * 16) = *(const GAS v4u*)(proj + (rowbase + row) * NIN_E + 512 + h * 128 + ch * 8); }
    __syncthreads();
    {
        const int it = wave >> 2, dvt = wave & 3;
        f32x16 O;
#pragma unroll
        for (int i = 0; i < 16; ++i) O[i] = 0.f;
#pragma unroll
        for (int jt = 0; jt < 2; ++jt) {
            if (jt <= it) {
                f32x16 X;
#pragma unroll
                for (int i = 0; i < 16; ++i) X[i] = 0.f;
#pragma unroll
                for (int s = 0; s < 4; ++s) X = MFMA32(*(const LAS bf16x8*)(lds + EA_KH + (32 * jt + r) * RS64 + (16 * s + 8 * hh) * 2), *(const LAS bf16x8*)(lds + EA_QT + (32 * it + r) * RS64 + (16 * s + 8 * hh) * 2), X);
#pragma unroll
                for (int i = 0; i < 16; ++i) X[i] = (32 * jt + crow(i, hh) <= 32 * it + r) ? X[i] : 0.f;
#pragma unroll
                for (int s = 0; s < 2; ++s) {
                    const int rowb = 32 * jt + 16 * s + 4 * hh;
                    O = MFMA32(pack8(X, s), cat8(tr4(lds + EA_VI, RS128, rowb, 32 * dvt, lane), tr4(lds + EA_VI, RS128, rowb + 8, 32 * dvt, lane)), O);
                }
            }
        }
        v4u w0, w1;
        w0.x = pk2(O[0], O[1]); w0.y = pk2(O[2], O[3]); w0.z = pk2(O[4], O[5]); w0.w = pk2(O[6], O[7]);
        w1.x = pk2(O[8], O[9]); w1.y = pk2(O[10], O[11]); w1.z = pk2(O[12], O[13]); w1.w = pk2(O[14], O[15]);
        unsigned char* dst = ws + WS_GOI + ((size_t)unit * 8 + it * 4 + dvt) * 2048 + lane * 32;
        *(GAS v4u*)dst = w0; *(GAS v4u*)(dst + 16) = w1;
    }
    __syncthreads();
}
__device__ __forceinline__ void lru_conv_unit(const Args& a, int jl, int unit, unsigned char* ws, int tid) {
    const int b = unit >> 7, tile = (unit >> 2) & 31, n = unit & 3;
    const bf16* proj = (const bf16*)(ws + WS_R); bf16* xr = (bf16*)(ws + WS_XR);
#pragma unroll
    for (int m = 0; m < 2; ++m) {
        const int tok = (tid >> 4) + 32 * m, grp = tid & 15, ch = n * 128 + grp * 8;
        float y[8];
        { const f32x4 c0 = *(const GAS f32x4*)(a.in[I_LRU_CONV_B] + jl * 512 + ch), c1 = *(const GAS f32x4*)(a.in[I_LRU_CONV_B] + jl * 512 + ch + 4);
          y[0] = c0.x; y[1] = c0.y; y[2] = c0.z; y[3] = c0.w; y[4] = c1.x; y[5] = c1.y; y[6] = c1.z; y[7] = c1.w; }
#pragma unroll
        for (int kk = 0; kk < 4; ++kk) {
            const int ts = tile * 64 + tok - 3 + kk;
            v4u raw = {0u, 0u, 0u, 0u};
            if (ts >= 0) raw = *(const GAS v4u*)(proj + ((size_t)b * T + ts) * NIN_E + 1536 + ch);
            const float* cwp = a.in[I_LRU_CONV_W] + (size_t)(jl * 4 + kk) * 512 + ch;
            const f32x4 c0 = *(const GAS f32x4*)cwp, c1 = *(const GAS f32x4*)(cwp + 4);
            y[0] += c0.x * bflo(raw.x); y[1] += c0.y * bfhi(raw.x); y[2] += c0.z * bflo(raw.y); y[3] += c0.w * bfhi(raw.y);
            y[4] += c1.x * bflo(raw.z); y[5] += c1.y * bfhi(raw.z); y[6] += c1.z * bflo(raw.w); y[7] += c1.w * bfhi(raw.w);
        }
        v4u w; w.x = pk2(y[0], y[1]); w.y = pk2(y[2], y[3]); w.z = pk2(y[4], y[5]); w.w = pk2(y[6], y[7]);
        *(GAS v4u*)(xr + ((size_t)b * T + tile * 64 + tok) * 512 + ch) = w;
    }
}

constexpr int EB_QI = 0, EB_KI = 9216, EB_VI = 18432, EB_EB = 35840, EB_OB0 = 36864, EB_OB1 = 54272, EB_UB = 71680;
__device__ __forceinline__ void gla_b_unit(int bh, unsigned char* ws, LAS unsigned char* lds, int tid) {
    asm volatile("" : "+v"(tid));
    const int lane = tid & 63, wave = __builtin_amdgcn_readfirstlane(tid >> 6), r = lane & 31, hh = lane >> 5;
    const int b = bh >> 2, h = bh & 3;
    const bf16* proj = (const bf16*)(ws + WS_R); bf16* mixed = (bf16*)(ws + WS_ACT);
    const bf16* Qg = (const bf16*)(ws + WS_GQT); const bf16* Kg = (const bf16*)(ws + WS_GKB); const float* Eb = (const float*)(ws + WS_SCAL);
    const bool comp = wave < 4;
    int lt = tid & 255;
#define EB_LOAD(nn) do { const int un_ = bh * 32 + (nn); const size_t rb_ = (size_t)b * T + (nn) * 64; \
        _Pragma("unroll") for (int k = 0; k < 2; ++k) { const int ci = lt + 256 * k; pq[k] = *(const GAS v4u*)(Qg + (size_t)un_ * 4096 + ci * 8); pk[k] = *(const GAS v4u*)(Kg + (size_t)un_ * 4096 + ci * 8); } \
        _Pragma("unroll") for (int k = 0; k < 4; ++k) { const int ci = lt + 256 * k, row = ci >> 4, ch = ci & 15; pv[k] = *(const GAS v4u*)(proj + (rb_ + row) * NIN_E + 512 + h * 128 + ch * 8); } \
        _Pragma("unroll") for (int k = 0; k < 4; ++k) pu[k] = *(const GAS v4u*)(ws + WS_GOI + (size_t)un_ * 16384 + (lt + 256 * k) * 16); \
        if (lt < 16) psc = *(const GAS f32x4*)(Eb + (size_t)un_ * 64 + lt * 4); } while (0)
#define EB_STORE() do { \
        _Pragma("unroll") for (int k = 0; k < 2; ++k) { const int ci = lt + 256 * k, row = ci >> 3, ch = ci & 7; *(LAS v4u*)(lds + EB_QI + row * RS64 + ch * 16) = pq[k]; *(LAS v4u*)(lds + EB_KI + row * RS64 + ch * 16) = pk[k]; } \
        _Pragma("unroll") for (int k = 0; k < 4; ++k) { const int ci = lt + 256 * k, row = ci >> 4, ch = ci & 15; *(LAS v4u*)(lds + EB_VI + row * RS128 + ch * 16) = pv[k]; } \
        _Pragma("unroll") for (int k = 0; k < 4; ++k) *(LAS v4u*)(lds + EB_UB + (lt + 256 * k) * 16) = pu[k]; \
        if (lt < 16) *(LAS f32x4*)(lds + EB_EB + lt * 16) = psc; } while (0)
#define EB_LOADZ(dst, nn) do { const bf16* zp_ = proj + ((size_t)b * T + (nn) * 64 + (lt >> 2)) * NIN_E + 1024 + h * 128 + (lt & 3) * 32; \
        _Pragma("unroll") for (int k = 0; k < 4; ++k) dst[k] = *(const GAS v4u*)(zp_ + 8 * k); } while (0)
#define EB_EPI(zr, nn) do { const int tok_ = lt >> 2, qt_ = lt & 3; const LAS unsigned char* ob_ = lds + (((nn) & 1) ? EB_OB1 : EB_OB0) + tok_ * RS128 + qt_ * 64; \
        v4u ov_[4]; float ss_ = 0.f; \
        _Pragma("unroll") for (int k = 0; k < 4; ++k) { ov_[k] = *(const LAS v4u*)(ob_ + 16 * k); \
            ss_ += bflo(ov_[k].x) * bflo(ov_[k].x) + bfhi(ov_[k].x) * bfhi(ov_[k].x) + bflo(ov_[k].y) * bflo(ov_[k].y) + bfhi(ov_[k].y) * bfhi(ov_[k].y) \
                 + bflo(ov_[k].z) * bflo(ov_[k].z) + bfhi(ov_[k].z) * bfhi(ov_[k].z) + bflo(ov_[k].w) * bflo(ov_[k].w) + bfhi(ov_[k].w) * bfhi(ov_[k].w); } \
        ss_ += __shfl_xor(ss_, 1); ss_ += __shfl_xor(ss_, 2); \
        const float rr_ = 1.0f / sqrtf(ss_ * (1.f / 128.f) + EPS); \
        bf16* op_ = mixed + ((size_t)b * T + (nn) * 64 + tok_) * 1024 + h * 128 + qt_ * 32; \
        _Pragma("unroll") for (int k = 0; k < 4; ++k) { v4u w_; \
            w_.x = pk2(bflo(ov_[k].x) * rr_ * siluf_(bflo(zr[k].x)), bfhi(ov_[k].x) * rr_ * siluf_(bfhi(zr[k].x))); \
            w_.y = pk2(bflo(ov_[k].y) * rr_ * siluf_(bflo(zr[k].y)), bfhi(ov_[k].y) * rr_ * siluf_(bfhi(zr[k].y))); \
            w_.z = pk2(bflo(ov_[k].z) * rr_ * siluf_(bflo(zr[k].z)), bfhi(ov_[k].z) * rr_ * siluf_(bfhi(zr[k].z))); \
            w_.w = pk2(bflo(ov_[k].w) * rr_ * siluf_(bflo(zr[k].w)), bfhi(ov_[k].w) * rr_ * siluf_(bfhi(zr[k].w))); \
            *(GAS v4u*)(op_ + 8 * k) = w_; } } while (0)
    if (comp) {
        const int w = wave;
        f32x16 S[2];
#pragma unroll
        for (int dt = 0; dt < 2; ++dt)
#pragma unroll
            for (int i = 0; i < 16; ++i) S[dt][i] = 0.f;
        for (int n = 0; n < 32; ++n) {
            __syncthreads();
            int lane_o = lane; asm volatile("" : "+v"(lane_o)); const int r = lane_o & 31, hh = lane_o >> 5, lane = lane_o;
            bf16x8 Sb[2][2];
#pragma unroll
            for (int dt = 0; dt < 2; ++dt) { Sb[dt][0] = pack8(S[dt], 0); Sb[dt][1] = pack8(S[dt], 1); }
            LAS unsigned char* ob = lds + ((n & 1) ? EB_OB1 : EB_OB0);
#pragma unroll
            for (int it = 0; it < 2; ++it) {
                const LAS unsigned char* up = lds + EB_UB + ((it * 4 + w) * 64 + lane) * 32;
                const v4u u0 = *(const LAS v4u*)up, u1 = *(const LAS v4u*)(up + 16);
                f32x16 O;
                O[0] = bflo(u0.x); O[1] = bfhi(u0.x); O[2] = bflo(u0.y); O[3] = bfhi(u0.y); O[4] = bflo(u0.z); O[5] = bfhi(u0.z); O[6] = bflo(u0.w); O[7] = bfhi(u0.w);
                O[8] = bflo(u1.x); O[9] = bfhi(u1.x); O[10] = bflo(u1.y); O[11] = bfhi(u1.y); O[12] = bflo(u1.z); O[13] = bfhi(u1.z); O[14] = bflo(u1.w); O[15] = bfhi(u1.w);
#pragma unroll
                for (int dt = 0; dt < 2; ++dt)
#pragma unroll
                    for (int s = 0; s < 2; ++s) O = MFMA32(ldperm(lds + EB_QI + (32 * it + r) * RS64 + (32 * dt + 16 * s + 4 * hh) * 2), Sb[dt][s], O);
#pragma unroll
                for (int i = 0; i < 16; ++i) *(LAS bf16*)(ob + (32 * it + crow(i, hh)) * RS128 + (32 * w + r) * 2) = f2bf(O[i]);
            }
            const LAS float* ebp = (const LAS float*)(lds + EB_EB);
#pragma unroll
            for (int dt = 0; dt < 2; ++dt) {
#pragma unroll
                for (int g = 0; g < 4; ++g) { const f32x4 e4 = *(const LAS f32x4*)(ebp + 32 * dt + 8 * g + 4 * hh);
                    S[dt][4 * g] *= e4.x; S[dt][4 * g + 1] *= e4.y; S[dt][4 * g + 2] *= e4.z; S[dt][4 * g + 3] *= e4.w; }
#pragma unroll
                for (int ks = 0; ks < 4; ++ks) {
                    const int rowb = 16 * ks + 8 * hh;
                    S[dt] = MFMA32(cat8(tr4(lds + EB_KI, RS64, rowb, 32 * dt, lane), tr4(lds + EB_KI, RS64, rowb + 4, 32 * dt, lane)),
                                   cat8(tr4(lds + EB_VI, RS128, rowb, 32 * w, lane), tr4(lds + EB_VI, RS128, rowb + 4, 32 * w, lane)), S[dt]);
                }
            }
            __syncthreads();
        }
    } else {
        v4u pq[2], pk[2], pv[4], pu[4], zc[4], zn[4]; f32x4 psc = {0.f, 0.f, 0.f, 0.f};
#pragma unroll
        for (int k = 0; k < 4; ++k) zn[k] = (v4u){0u, 0u, 0u, 0u};
        EB_LOAD(0); EB_STORE();
        for (int n = 0; n < 32; ++n) {
            __syncthreads();
            asm volatile("" : "+v"(lt));
#pragma unroll
            for (int k = 0; k < 4; ++k) zc[k] = zn[k];
            if (n + 1 < 32) EB_LOAD(n + 1);
            EB_LOADZ(zn, n);
            if (n >= 1) EB_EPI(zc, n - 1);
            __syncthreads();
            if (n + 1 < 32) EB_STORE();
        }
        __syncthreads();
        EB_EPI(zn, 31);
    }
    if (comp) __syncthreads();
    __syncthreads();
#undef EB_LOAD
#undef EB_STORE
#undef EB_LOADZ
#undef EB_EPI
}

constexpr int LR_XI = 0, LR_XF = 17408, LR_GR = 25600, LR_SEG = 41984, LR_CAR = 46080;
__device__ __forceinline__ void lru_unit(const Args& a, int jl, int unit, unsigned char* ws, LAS unsigned char* lds, int tid) {
    asm volatile("" : "+v"(tid));
    const int lane = tid & 63, wave = __builtin_amdgcn_readfirstlane(tid >> 6), r = lane & 31, hh = lane >> 5;
    const int b = unit >> 4, n = (unit >> 2) & 3, cq = unit & 3;
    const int chin0 = n * 128, cho0 = n * 128 + cq * 32;
    const bf16* proj = (const bf16*)(ws + WS_R); const bf16* xrg = (const bf16*)(ws + WS_XR); bf16* mixed = (bf16*)(ws + WS_ACT);
    const int gate = (wave >> 1) & 1, tt = wave & 1;
    bf16x8 Bf[8];
    {
        const bf16* wt = (const bf16*)(ws + WS_LRUW) + ((size_t)((jl * 2 + gate) * 4 + n) * 128 + cq * 32 + r) * 128 + 8 * hh;
#pragma unroll
        for (int s = 0; s < 8; ++s) Bf[s] = *(const GAS bf16x8*)(wt + 16 * s);
    }
    const float bias = (gate ? a.in[I_LRU_B_X] : a.in[I_LRU_B_A])[jl * 512 + cho0 + r];
    const int c = tid & 31, seg = tid >> 5;
    const float sp8 = 8.0f * softplusf_(-a.in[I_LRU_LAMBDA][jl * 512 + cho0 + c]);
    const int ctok = tid >> 3, cg4 = (tid & 7) * 4;
    f32x4 cw[4];
#pragma unroll
    for (int kk = 0; kk < 4; ++kk) cw[kk] = *(const GAS f32x4*)(a.in[I_LRU_CONV_W] + (size_t)(jl * 4 + kk) * 512 + cho0 + cg4);
    const f32x4 cb = *(const GAS f32x4*)(a.in[I_LRU_CONV_B] + jl * 512 + cho0 + cg4);
    LAS float* XF = (LAS float*)(lds + LR_XF); LAS float* GR = (LAS float*)(lds + LR_GR); LAS float* SEG = (LAS float*)(lds + LR_SEG); LAS float* CAR = (LAS float*)(lds + LR_CAR);
    if (tid < 32) CAR[tid] = 0.f;
    for (int tile = 0; tile < 32; ++tile) {
        const size_t rowbase = (size_t)b * T + tile * 64;
#pragma unroll
        for (int k = 0; k < 2; ++k) { const int ci = tid + 512 * k, row = ci >> 4, ch = ci & 15;
            *(LAS v4u*)(lds + LR_XI + row * RS128 + ch * 16) = *(const GAS v4u*)(xrg + (rowbase + row) * 512 + chin0 + ch * 8); }
        {
            f32x4 y = cb;
#pragma unroll
            for (int kk = 0; kk < 4; ++kk) {
                const int ts = tile * 64 + ctok - 3 + kk;
                v2u raw = {0u, 0u};
                if (ts >= 0) raw = *(const GAS v2u*)(proj + ((size_t)b * T + ts) * NIN_E + 1536 + cho0 + cg4);
                y.x += cw[kk].x * bflo(raw.x); y.y += cw[kk].y * bfhi(raw.x); y.z += cw[kk].z * bflo(raw.y); y.w += cw[kk].w * bfhi(raw.y);
            }
            *(LAS f32x4*)(XF + ctok * 32 + cg4) = y;
        }
        __syncthreads();
        if (wave < 4) {
            f32x16 acc;
#pragma unroll
            for (int i = 0; i < 16; ++i) acc[i] = 0.f;
#pragma unroll
            for (int s = 0; s < 8; ++s) acc = MFMA32(*(const LAS bf16x8*)(lds + LR_XI + (32 * tt + r) * RS128 + (16 * s + 8 * hh) * 2), Bf[s], acc);
#pragma unroll
            for (int i = 0; i < 16; ++i) GR[(gate * 64 + 32 * tt + crow(i, hh)) * 32 + r] = sigmoidf_(acc[i] + bias);
        }
        __syncthreads();
        float av[4], uv[4]; float P = 1.f, H = 0.f;
#pragma unroll
        for (int e = 0; e < 4; ++e) {
            const int t = 4 * seg + e;
            const float rg = GR[t * 32 + c], ig = GR[(64 + t) * 32 + c], xv = XF[t * 32 + c];
            const float la = -sp8 * rg; av[e] = __expf(la);
            const float x2 = 2.0f * la;
            const float om = -x2 * (1.0f + x2 * (0.5f + x2 * (0.16666667f + x2 * (0.041666668f + x2 * (0.008333334f + x2 * 0.0013888889f)))));
            uv[e] = sqrtf(om) * (ig * xv);
            H = av[e] * H + uv[e]; P *= av[e];
        }
        SEG[(seg * 32 + c) * 2] = P; SEG[(seg * 32 + c) * 2 + 1] = H;
        __syncthreads();
        float hin = CAR[c];
        for (int s2 = 0; s2 < seg; ++s2) hin = SEG[(s2 * 32 + c) * 2] * hin + SEG[(s2 * 32 + c) * 2 + 1];
#pragma unroll
        for (int e = 0; e < 4; ++e) {
            const int t = 4 * seg + e;
            hin = av[e] * hin + uv[e];
            const float gt = bf2f(proj[(rowbase + t) * NIN_E + 2048 + cho0 + c]);
            const float u2 = 0.7978845608028654f * (gt + 0.044715f * gt * gt * gt);
            const float th = 1.0f - 2.0f / (1.0f + __expf(2.0f * u2));
            mixed[(rowbase + t) * 1024 + 512 + cho0 + c] = f2bf(hin * 0.5f * gt * (1.0f + th));
        }
        __syncthreads();
        if (seg == 15) CAR[c] = hin;
    }
    __syncthreads();
}

constexpr int RS256 = 528;
__device__ __forceinline__ void attn_unit2(int l, int pm, int h, bf16* QO, const bf16* Kall, const bf16* Vt, LAS unsigned char* lds, int tid) {
    const int lane = tid & 63, wave = __builtin_amdgcn_readfirstlane(tid >> 6);
    const int b = pm >> 3, r = lane & 31, hh = lane >> 5, row = pm * 256 + wave * 32 + r;
    bf16* qrow = QO + (size_t)row * D + h * 256;
    {
        const bf16* ksrc = Kall + (size_t)(b * 256 + (tid >> 5)) * 4096 + l * 1024 + h * 256 + (tid & 31) * 8;
        LAS unsigned char* kdst = lds + (tid >> 5) * RS256 + (tid & 31) * 16;
#pragma unroll 1
        for (int k0 = 0; k0 < 4; ++k0) {
            v4u t[4];
#pragma unroll
            for (int k = 0; k < 4; ++k) t[k] = *(const GAS v4u*)(ksrc + (size_t)(16 * k) * 4096);
#pragma unroll
            for (int k = 0; k < 4; ++k) *(LAS v4u*)(kdst + (16 * k) * RS256) = t[k];
            ksrc += (size_t)64 * 4096; kdst += 64 * RS256;
        }
    }
    bf16x8 qf[16];
#pragma unroll
    for (int s = 0; s < 16; ++s) qf[s] = *(const GAS bf16x8*)(qrow + 16 * s + 8 * hh);
    __syncthreads();
    f32x16 st[8];
#pragma unroll
    for (int kb = 0; kb < 8; ++kb) {
        f32x16 acc;
#pragma unroll
        for (int i = 0; i < 16; ++i) acc[i] = 0.f;
#pragma unroll
        for (int s = 0; s < 16; ++s) { acc = MFMA32(*(const LAS bf16x8*)(lds + (32 * kb + r) * RS256 + (16 * s + 8 * hh) * 2), qf[s], acc); if ((s & 3) == 3) __builtin_amdgcn_sched_barrier(0); }
        st[kb] = acc;
    }
    float mx = -3.0e38f;
#pragma unroll
    for (int kb = 0; kb < 8; ++kb)
#pragma unroll
        for (int i = 0; i < 16; ++i) mx = fmaxf(mx, st[kb][i]);
    mx = fmaxf(mx, __shfl_xor(mx, 32));
    float sum = 0.f;
#pragma unroll
    for (int kb = 0; kb < 8; ++kb)
#pragma unroll
        for (int i = 0; i < 16; ++i) { const float p = __expf(st[kb][i] - mx); st[kb][i] = p; sum += p; }
    sum += __shfl_xor(sum, 32);
    const float inv = 1.0f / sum;
    bf16x8 pf[8][2];
#pragma unroll
    for (int kb = 0; kb < 8; ++kb) { pf[kb][0] = pack8(st[kb], 0); pf[kb][1] = pack8(st[kb], 1); }
    __syncthreads();
    {
        const bf16* vsrc = Vt + (size_t)(l * 1024 + h * 256 + (tid >> 5)) * MMEM + b * 256 + (tid & 31) * 8;
        LAS unsigned char* vdst = lds + (tid >> 5) * RS256 + (tid & 31) * 16;
#pragma unroll 1
        for (int k0 = 0; k0 < 4; ++k0) {
            v4u t[4];
#pragma unroll
            for (int k = 0; k < 4; ++k) t[k] = *(const GAS v4u*)(vsrc + (size_t)(16 * k) * MMEM);
#pragma unroll
            for (int k = 0; k < 4; ++k) *(LAS v4u*)(vdst + (16 * k) * RS256) = t[k];
            vsrc += (size_t)64 * MMEM; vdst += 64 * RS256;
        }
    }
    __syncthreads();
#pragma unroll
    for (int db = 0; db < 8; ++db) {
        f32x16 y;
#pragma unroll
        for (int i = 0; i < 16; ++i) y[i] = 0.f;
#pragma unroll
        for (int kb = 0; kb < 8; ++kb)
#pragma unroll
            for (int s = 0; s < 2; ++s) {
                const LAS unsigned char* vp = lds + (32 * db + r) * RS256 + (32 * kb + 16 * s + 4 * hh) * 2;
                y = MFMA32(cat8(*(const LAS s16x4*)vp, *(const LAS s16x4*)(vp + 16)), pf[kb][s], y);
                if (s == 1 && (kb & 1)) __builtin_amdgcn_sched_barrier(0);
            }
#pragma unroll
        for (int g = 0; g < 4; ++g) { v2u w; w.x = pk2(y[4 * g] * inv, y[4 * g + 1] * inv); w.y = pk2(y[4 * g + 2] * inv, y[4 * g + 3] * inv);
            *(GAS v2u*)(qrow + 32 * db + 8 * g + 4 * hh) = w; }
    }
    __syncthreads();
}
#ifndef EN_MASK
#define EN_MASK 0xFFFF
#endif
#define EN(k) (((EN_MASK) >> (k)) & 1)
enum Kind { K_PRO = 0, K_KV = 1, K_IN = 2, K_MIXA = 3, K_MIXB = 4, K_OUT = 5, K_RES1 = 6, K_Q = 7, K_ATT = 8, K_O = 9, K_RES2 = 10, K_UP = 11, K_DOWN = 12, K_RES3 = 13 };
constexpr int PPL = 12, NPH = 2 + PPL * DEPTH;

__global__ void __launch_bounds__(NTHR, 2) mk_fwd(Args a) {
    extern __shared__ __attribute__((aligned(16))) unsigned char lds_raw[];
    LAS unsigned char* lds = (LAS unsigned char*)lds_raw;
    volatile LAS unsigned* MISC = (volatile LAS unsigned*)(lds + MISC_OFF);
    const int tid0 = threadIdx.x;
    const int G = gridDim.x, bid = blockIdx.x;
    unsigned char* ws = a.ws;
    for (int u = tid0; u < (LDS_BYTES - LDSCTL_OFF) / 4; u += NTHR) ((LAS unsigned*)(lds + LDSCTL_OFF))[u] = 0u;
    __syncthreads();
    const int lo = a.ph_lo, hi = a.ph_hi;
    XcdBarrier bar; bar.bar = (unsigned*)(ws + WS_CTL) + CW_BAR; bar.x = 0; bar.st = nullptr;
    if (hi - lo > 1) bar = xcd_barrier_post((unsigned*)(ws + WS_CTL) + CW_BAR, MISC + 8);
    const int NGW = G * NWAVES;

    unsigned long long probe_acc = 0ull, probe_sub = 0ull; (void)probe_acc; (void)probe_sub;
    for (int ph = lo; ph < hi; ++ph) {
#ifdef PROBE_MASK
        const unsigned long long probe_t0 = __builtin_amdgcn_s_memrealtime();
#endif
        int tid = threadIdx.x; asm volatile("" : "+v"(tid));
        const int lane = tid & 63, wave = __builtin_amdgcn_readfirstlane(tid >> 6), gw = bid * NWAVES + wave;
        int kind, l;
        if (ph == 0) { kind = K_PRO; l = 0; } else if (ph == 1) { kind = K_KV; l = 0; } else { const int r = ph - 2; l = r / PPL; kind = 2 + r % PPL; }
        const bool even = !(l & 1); const int jl = l >> 1;
        bf16* ACT = (bf16*)(ws + WS_ACT);
        if (EN(K_PRO) && kind == K_PRO) {
            phase_prologue(a, lds, bid, G, wave, lane, tid);
        } else if (EN(K_IN) && kind == K_IN && !even) {
            phase_ba(ACT, (const float*)wl(ws, l, WO_BA), (float*)(ws + WS_BA), lds, bid, G, wave, lane, tid);
            pg8::Gemm g{ACT, wl(ws, l, WO_IN), M, NIN_O, 1024}; pg8::StaticOrder S; S.init(M, NIN_O, G, bid);
            pg8::EpiGdnIn E{(bf16*)(ws + WS_R), (bf16*)(ws + WS_HALO)};
            pg8::gemm_phase<pg8::EpiGdnIn, pg8::StaticOrder, true, true>(lds, g, S, E);
        } else if (EN(K_KV) && (kind == K_KV || kind == K_IN || kind == K_Q)) {
            const int nrep = (kind == K_KV) ? 2 : 1;
            for (int rep = 0; rep < nrep; ++rep) {
                const bf16* A; const bf16* Bt; int Mg, Ng; bf16* O;
                if (kind == K_KV) {
                    if (rep == 0) { A = (const bf16*)(ws + WS_MEMN); Bt = (const bf16*)(ws + WS_WK); Mg = MMEM; Ng = 4096; O = (bf16*)(ws + WS_KALL); }
                    else { A = (const bf16*)(ws + WS_WV); Bt = (const bf16*)(ws + WS_MEMN); Mg = 4096; Ng = MMEM; O = (bf16*)(ws + WS_VT); }
                } else if (kind == K_IN) { A = ACT; Bt = wl(ws, l, WO_IN); Mg = M; Ng = NIN_E; O = (bf16*)(ws + WS_R); }
                else { A = ACT; Bt = wl(ws, l, WO_Q); Mg = M; Ng = 1024; O = (bf16*)(ws + WS_QO); }
                pg8::Gemm g{A, Bt, Mg, Ng, 1024}; pg8::StaticOrder S; S.init(Mg, Ng, G, bid);
                pg8::EpiBf16A<0> E{O, Ng};
                pg8::gemm_phase<pg8::EpiBf16A<0>, pg8::StaticOrder, true, true>(lds, g, S, E);
            }
        } else if (EN(K_DOWN) && kind == K_DOWN) {
            pg8::Gemm g{(const bf16*)(ws + WS_R), wl(ws, l, WO_W2), M, 1024, FF}; pg8::StaticOrder S; S.init(M, 1024, G, bid);
            pg8::EpiBf16A<0> E{ACT, 1024};
            pg8::gemm_phase<pg8::EpiBf16A<0>, pg8::StaticOrder, true, true>(lds, g, S, E);
        } else if (EN(K_UP) && kind == K_UP) {
            pg8::Gemm g{ACT, wl(ws, l, WO_W1), M, FF, 1024}; pg8::StaticOrder S; S.init(M, FF, G, bid);
            pg8::EpiBf16A<1> E{(bf16*)(ws + WS_R), FF};
            pg8::gemm_phase<pg8::EpiBf16A<1>, pg8::StaticOrder, true, true>(lds, g, S, E);
        } else if (EN(K_OUT) && (kind == K_OUT || kind == K_O)) {
            const bf16* A = (kind == K_OUT) ? (even ? ACT : (const bf16*)(ws + WS_R) + 3 * PSZ) : (const bf16*)(ws + WS_QO); const bf16* Bt = (kind == K_OUT) ? wl(ws, l, WO_OUT) : wl(ws, l, WO_O);
            pg8::Gemm g{A, Bt, M, 1024, 1024}; pg8::StaticOrder S; S.init(M, 1024, G, bid);
            pg8::EpiF32A E{(float*)(ws + WS_R), 1024};
            pg8::gemm_phase<pg8::EpiF32A, pg8::StaticOrder, true, true>(lds, g, S, E);
        } else if (EN(K_RES1) && (kind == K_RES1 || kind == K_RES2)) {
            const float* base = (kind == K_RES1 && l == 0) ? a.in[I_X] : a.out;
            const float* gp = ((kind == K_RES1) ? a.in[I_MIX_POST_G] : a.in[I_XA_POST_G]) + l * 1024;
            phase_res<false>(ws + WS_R, base, gp, a.out, ACT, gw, NGW, lane);
        } else if (EN(K_RES3) && kind == K_RES3) {
            phase_res<true>(ACT, a.out, a.in[I_MLP_POST_G] + l * 1024, a.out, ACT, gw, NGW, lane);
        } else if (EN(K_MIXA) && kind == K_MIXA) {
            if (even) {
                for (int u = bid; u < 2048; u += G) { if (u < 1024) gla_a_unit(a, jl, u, ws, lds, tid); else lru_conv_unit(a, jl, u - 1024, ws, tid); }
            } else {
                for (int u = bid; u < 2048; u += G) gdn_a_unit(a, jl, u, ws, lds, tid, probe_sub);
            }
        } else if (EN(K_MIXB) && kind == K_MIXB) {
#ifndef EN2
#define EN2 7
#endif
            if (even) { for (int u = bid; u < 160; u += G) { if (u < 128) { if (EN2 & 1) lru_unit(a, jl, u, ws, lds, tid); } else { if (EN2 & 2) gla_b_unit(u - 128, ws, lds, tid); } } }
            else { if (EN2 & 4) for (int u = bid; u < 64; u += G) gdn_b_unit(u, ws, lds, tid); }
        } else if (EN(K_ATT) && kind == K_ATT) {
            for (int u = bid; u < 256; u += G) attn_unit2(l, u >> 2, u & 3, (bf16*)(ws + WS_QO), (const bf16*)(ws + WS_KALL), (const bf16*)(ws + WS_VT), lds, tid);
        }
        if (ph + 1 < hi) xcd_barrier(bar);
#ifdef PROBE_MASK
        if ((((PROBE_MASK) >> kind) & 1) && ((((PROBE_MASK) >> (16 + (l & 1))) & 1) == 0)) probe_acc += __builtin_amdgcn_s_memrealtime() - probe_t0;
#endif
    }
#ifdef PROBE_MASK
    __syncthreads();
    if (bid == 0 && threadIdx.x == 0) { asm volatile("s_waitcnt vmcnt(0)" ::: "memory"); a.out[0] += (float)probe_acc * 0.0025f + (float)probe_sub * 0.0025f; }
#endif
}

#ifndef MK_PER_PHASE
#define MK_PER_PHASE 0
#endif
extern "C" void kernel_launch(void* const* d_in, const int* in_sizes, int n_in, void* d_out, int out_size, void* d_ws, size_t ws_size, hipStream_t stream) {
    static int grid = 0;
    if (grid == 0) {
        if (n_in != N_IN || out_size != M * D || ws_size < WS_END) { fprintf(stderr, "kernel_launch: unexpected shapes (n_in %d out %d ws %zu)\n", n_in, out_size, ws_size); grid = -1; return; }
        int dev = 0, cus = 0, per_cu = 0;
        if (hipGetDevice(&dev) != hipSuccess || hipDeviceGetAttribute(&cus, hipDeviceAttributeMultiprocessorCount, dev) != hipSuccess) { grid = -1; return; }
        if (hipFuncSetAttribute((const void*)mk_fwd, hipFuncAttributeMaxDynamicSharedMemorySize, LDS_BYTES) != hipSuccess) { fprintf(stderr, "kernel_launch: hipFuncSetAttribute failed\n"); grid = -1; return; }
        if (hipOccupancyMaxActiveBlocksPerMultiprocessor(&per_cu, (const void*)mk_fwd, NTHR, LDS_BYTES) != hipSuccess || per_cu < 1) { fprintf(stderr, "kernel_launch: occupancy query says %d blocks per CU\n", per_cu); }
        (void)hipGetLastError();
        grid = cus;
    }
    if (grid < 0) return;
    (void)in_sizes;
    if (hipMemsetAsync((char*)d_ws + WS_CTL, 0, CTL_ZERO_BYTES, stream) != hipSuccess) { fprintf(stderr, "kernel_launch: memset failed\n"); return; }
    Args a{};
    for (int i = 0; i < N_IN; ++i) a.in[i] = (const float*)d_in[i];
    a.out = (float*)d_out; a.ws = (unsigned char*)d_ws;
#if MK_PER_PHASE
    for (int ph = 0; ph < NPH; ++ph) { a.ph_lo = ph; a.ph_hi = ph + 1; hipLaunchKernelGGL(mk_fwd, dim3(grid), dim3(NTHR), LDS_BYTES, stream, a); }
#else
    a.ph_lo = 0; a.ph_hi = NPH;
    hipLaunchKernelGGL(mk_fwd, dim3(grid), dim3(NTHR), LDS_BYTES, stream, a);
#endif
}
```
